# Optimizing an MI355X kernel written in HIP

```python
import jax, jax.numpy as jnp
from jax import lax
import numpy as np

D_MODEL = 2048
BATCH = 16
SEQ = 256
DEPTH = 2
DEC_BATCH = 8
DEC_SEQ = 1024
PAST_LEN = 512

GRID_W = 64
A_WIDTH = 1024
A_HEADS = 8
A_DK = A_WIDTH // A_HEADS
A_DV = A_WIDTH // A_HEADS
B_WIDTH = 1024
B_GROUPS = 4
B_CHUNK = 128
C_GROUPS = 4
SCAN_CHUNK = 64
D_FF = 5632
CONV_W = 3
N_HGRN_LAYERS = (DEPTH + 1) // 2
IN_WIDTH_0 = 5 * A_WIDTH + 2 * B_WIDTH
IN_SPLITS = (A_WIDTH, 2 * A_WIDTH, 3 * A_WIDTH, 4 * A_WIDTH, 5 * A_WIDTH, 5 * A_WIDTH + B_WIDTH)
EPS = 1e-6

kernel_name = 'hybrid_hgrn2_gmlp_fnet_convffn_diffusion_step'


def _rmsnorm(x, g):
    xf = x.astype(jnp.float32)
    y = xf * lax.rsqrt(jnp.mean(xf * xf, axis=-1, keepdims=True) + EPS)
    return (y * g.astype(jnp.float32)).astype(x.dtype)


def _gla_scan(q, k, v, logf, s0):
    bsz, n, h, _ = q.shape
    dv = v.shape[-1]
    nc = n // SCAN_CHUNK

    def blocks(t):
        return t.reshape(bsz, nc, SCAN_CHUNK, h, t.shape[-1]).transpose(1, 0, 3, 2, 4)

    q, k, v, logf = blocks(q), blocks(k), blocks(v), blocks(logf)
    b = jnp.cumsum(logf, axis=3)
    mid = SCAN_CHUNK // 2
    ref = b[:, :, :, mid - 1:mid, :]
    b_last = b[:, :, :, -1:, :]
    scores = jnp.einsum('nbhik,nbhjk->nbhij', q * jnp.exp(b - ref), k * jnp.exp(ref - b))
    lower = jnp.tril(jnp.ones((SCAN_CHUNK, SCAN_CHUNK), dtype=bool))
    scores = jnp.where(lower, scores, 0.0)
    o_intra = jnp.einsum('nbhij,nbhjv->nbhiv', scores, v)
    q_in = q * jnp.exp(b)
    k_out = k * jnp.exp(b_last - b)
    decay = jnp.exp(b_last[:, :, :, 0, :])

    def step(S, xs):
        qc, kc, vc, dc = xs
        o = jnp.einsum('bhik,bhkv->bhiv', qc, S)
        S = dc[..., None] * S + jnp.einsum('bhjk,bhjv->bhkv', kc, vc)
        return S, o

    s_final, o_inter = lax.scan(step, s0, (q_in, k_out, v, decay))
    o = (o_intra + o_inter).transpose(1, 0, 3, 2, 4).reshape(bsz, n, h, dv)
    return o, s_final


def _mixers_ab(h, w_in, lb_f, lb_b, gnorm, vnorm, ws, bs, w_out, s0):
    bsz, n, _ = h.shape
    f32 = jnp.float32
    proj = h @ w_in
    qa, fzf, fzb, ia, ga, ub, vb = jnp.split(proj, IN_SPLITS, axis=-1)

    def heads(t):
        return t.astype(f32).reshape(bsz, n, A_HEADS, -1)

    q = heads(jax.nn.silu(qa)) * (A_DK ** -0.5)
    v = heads(ia)

    def gates(fz, lb):
        lbh = lb.reshape(A_HEADS, A_DK)
        f = lbh + (1.0 - lbh) * jax.nn.sigmoid(heads(fz))
        return 1.0 - f, jnp.log(f)

    k_f, lf_f = gates(fzf, lb_f)
    k_b, lf_b = gates(fzb, lb_b)
    s0 = s0.astype(f32)
    o_fwd, s_fwd = _gla_scan(q, k_f, v, lf_f, s0[:, 0])
    o_rev, s_bwd = _gla_scan(jnp.flip(q, 1), jnp.flip(k_b, 1), jnp.flip(v, 1), jnp.flip(lf_b, 1), s0[:, 1])
    o_rec = _rmsnorm(o_fwd + jnp.flip(o_rev, 1), gnorm)
    out_a = (o_rec.reshape(bsz, n, A_WIDTH) * jax.nn.silu(ga.astype(f32))).astype(h.dtype)

    u = jax.nn.gelu(ub)
    vv = jax.nn.gelu(vb)
    nck = n // B_CHUNK
    cg = B_WIDTH // B_GROUPS
    vv = _rmsnorm(vv.reshape(bsz, nck, B_CHUNK, B_GROUPS, cg), vnorm.reshape(B_GROUPS, cg))
    mixed = jnp.einsum('gpq,bnqgc->bnpgc', ws, vv) + bs.T[:, :, None]
    out_b = u * mixed.reshape(bsz, n, B_WIDTH)

    out = jnp.concatenate([out_a, out_b], axis=-1) @ w_out
    return out, jnp.stack([s_fwd, s_bwd], axis=1)


def _fourier_mix(h):
    bsz, n, d = h.shape
    hf = h.astype(jnp.float32).reshape(bsz, n, C_GROUPS, d // C_GROUPS)
    return jnp.fft.fftn(hf, axes=(1, 3), norm='ortho').real.reshape(bsz, n, d).astype(h.dtype)


def _conv_ffn(h, w_up, cw, cb, w_down, n_rows):
    bsz, n, _ = h.shape
    up = (h @ w_up).reshape(bsz, n_rows, n // n_rows, 2 * D_FF)
    pad = jnp.pad(up, ((0, 0), (0, 0), (1, 1), (0, 0)))
    conv = pad[:, :, :-2] * cw[0] + pad[:, :, 1:-1] * cw[1] + pad[:, :, 2:] * cw[2] + cb
    gate, val = jnp.split(conv.reshape(bsz, n, 2 * D_FF), 2, axis=-1)
    return (jax.nn.silu(gate) * val) @ w_down


def setup_inputs(seed: int = 0) -> dict:
    key = jax.random.key(seed)
    ks = iter(jax.random.split(key, 48))

    def nrm(shape, scale):
        return scale * jax.random.normal(next(ks), shape, jnp.float32)

    def gain(shape):
        return 1.0 + 0.01 * jax.random.normal(next(ks), shape, jnp.float32)

    d = D_MODEL
    inp = {}
    inp['x_prompt'] = nrm((BATCH, SEQ, d), 1.0)
    inp['x_sample'] = nrm((DEC_BATCH, DEC_SEQ, d), 1.0)
    inp['state_l0_hgrn'] = nrm((DEC_BATCH, 2, A_HEADS, A_DK, A_DV), 0.5)
    inp['c'] = nrm((DEC_BATCH, d), 1.0)
    inp['c_ctx'] = nrm((d,), 1.0)
    inp['mod_w_0'] = nrm((d, 6 * d), 0.5 * d ** -0.5)
    inp['mod_b_0'] = nrm((6 * d,), 0.01)
    inp['norm1_0'] = gain((d,))
    inp['w_in_0'] = nrm((d, IN_WIDTH_0), d ** -0.5)
    inp['hgrn_lb'] = nrm((2, N_HGRN_LAYERS + 1, A_WIDTH), 1.0)
    inp['hgrn_gnorm_0'] = gain((A_DV,))
    inp['gmlp_vnorm_0'] = gain((B_WIDTH,))
    inp['gmlp_ws_0'] = nrm((B_GROUPS, B_CHUNK, B_CHUNK), B_CHUNK ** -0.5)
    inp['gmlp_bs_0'] = nrm((B_GROUPS, B_CHUNK), 0.1)
    inp['w_out_0'] = nrm((A_WIDTH + B_WIDTH, d), (A_WIDTH + B_WIDTH) ** -0.5)
    inp['norm2_0'] = gain((d,))
    inp['ffn_up_0'] = nrm((d, 2 * D_FF), d ** -0.5)
    inp['ffn_conv_w_0'] = nrm((CONV_W, 2 * D_FF), CONV_W ** -0.5)
    inp['ffn_conv_b_0'] = nrm((2 * D_FF,), 0.01)
    inp['ffn_down_0'] = nrm((D_FF, d), D_FF ** -0.5)
    inp['mod_w_1'] = nrm((d, 6 * d), 0.5 * d ** -0.5)
    inp['mod_b_1'] = nrm((6 * d,), 0.01)
    inp['norm1_1'] = gain((d,))
    inp['w_out_1'] = nrm((d, d), d ** -0.5)
    inp['norm2_1'] = gain((d,))
    inp['ffn_up_1'] = nrm((d, 2 * D_FF), d ** -0.5)
    inp['ffn_conv_w_1'] = nrm((CONV_W, 2 * D_FF), CONV_W ** -0.5)
    inp['ffn_conv_b_1'] = nrm((2 * D_FF,), 0.01)
    inp['ffn_down_1'] = nrm((D_FF, d), D_FF ** -0.5)
    inp['final_norm'] = gain((d,))
    return inp


def reference(x_prompt, x_sample, state_l0_hgrn, c, c_ctx,
              mod_w_0, mod_b_0, norm1_0, w_in_0, hgrn_lb, hgrn_gnorm_0, gmlp_vnorm_0, gmlp_ws_0, gmlp_bs_0,
              w_out_0, norm2_0, ffn_up_0, ffn_conv_w_0, ffn_conv_b_0, ffn_down_0,
              mod_w_1, mod_b_1, norm1_1, w_out_1, norm2_1, ffn_up_1, ffn_conv_w_1, ffn_conv_b_1, ffn_down_1,
              final_norm):
    layers = [
        {'mod_w': mod_w_0, 'mod_b': mod_b_0, 'norm1': norm1_0, 'norm2': norm2_0, 'up': ffn_up_0,
         'cw': ffn_conv_w_0, 'cb': ffn_conv_b_0, 'down': ffn_down_0, 'w_in': w_in_0, 'gnorm': hgrn_gnorm_0,
         'vnorm': gmlp_vnorm_0, 'ws': gmlp_ws_0, 'bs': gmlp_bs_0, 'w_out': w_out_0},
        {'mod_w': mod_w_1, 'mod_b': mod_b_1, 'norm1': norm1_1, 'norm2': norm2_1, 'up': ffn_up_1,
         'cw': ffn_conv_w_1, 'cb': ffn_conv_b_1, 'down': ffn_down_1, 'w_out': w_out_1},
    ]
    lb_all = jnp.cumsum(jax.nn.softmax(hgrn_lb.astype(jnp.float32), axis=1), axis=1)

    def run_trunk(x, cond, s0_list, n_rows):
        states = []
        for l in range(DEPTH):
            p = layers[l]
            mod = (jax.nn.silu(cond) @ p['mod_w'] + p['mod_b'])[:, None, :]
            sh1, sc1, g1, sh2, sc2, g2 = jnp.split(mod, 6, axis=-1)
            h = _rmsnorm(x, p['norm1']) * (1.0 + sc1) + sh1
            if l % 2 == 0:
                j = l // 2
                mix, s = _mixers_ab(h, p['w_in'], lb_all[0, j], lb_all[1, j], p['gnorm'], p['vnorm'],
                                    p['ws'], p['bs'], p['w_out'], s0_list[j])
                states.append(s)
            else:
                mix = _fourier_mix(h) @ p['w_out']
            x = x + g1 * mix
            h = _rmsnorm(x, p['norm2']) * (1.0 + sc2) + sh2
            x = x + g2 * _conv_ffn(h, p['up'], p['cw'], p['cb'], p['down'], n_rows)
        return _rmsnorm(x, final_norm), states

    zero_state = jnp.zeros((x_prompt.shape[0], 2, A_HEADS, A_DK, A_DV), jnp.float32)
    y_prompt, ctx_states = run_trunk(x_prompt, c_ctx[None, :], [zero_state] * N_HGRN_LAYERS, 1)
    state_l0_hgrn_new = ctx_states[0].astype(x_prompt.dtype)

    n_rows = x_sample.shape[1] // GRID_W
    y_sample, _ = run_trunk(x_sample, c, [state_l0_hgrn], n_rows)
    return (y_prompt, y_sample, state_l0_hgrn_new)
```

```cpp
#include <hip/hip_runtime.h>
#include <hip/hip_cooperative_groups.h>
#include <cstdio>
#include <cstdint>
namespace cg = cooperative_groups;

#ifndef MK_FUSED
#define MK_FUSED 1
#endif

#define LAS __attribute__((address_space(3)))
typedef unsigned short bf16_t;
typedef short bf16x8 __attribute__((ext_vector_type(8)));
typedef float f32x4 __attribute__((ext_vector_type(4)));
typedef float f32x2 __attribute__((ext_vector_type(2)));
typedef unsigned u32x4 __attribute__((ext_vector_type(4)));
typedef unsigned u32x2 __attribute__((ext_vector_type(2)));

constexpr int D = 2048, T = 12288, TCTX = 4096;
constexpr int DFF = 5632, DFF2 = 11264, INW = 7168, AW = 1024;
constexpr int NPH = 17;
constexpr int NT = 512;

constexpr size_t WS_CTL = 0;
constexpr size_t WS_MOD = 65536;
constexpr size_t WS_WIN = WS_MOD + (size_t)2 * 9 * 12288 * 4;
constexpr size_t WS_WOUT0 = WS_WIN + (size_t)INW * D * 2;
constexpr size_t WS_WUP0 = WS_WOUT0 + (size_t)D * D * 2;
constexpr size_t WS_WDN0 = WS_WUP0 + (size_t)DFF2 * D * 2;
constexpr size_t WS_WOUT1 = WS_WDN0 + (size_t)D * DFF * 2;
constexpr size_t WS_WUP1 = WS_WOUT1 + (size_t)D * D * 2;
constexpr size_t WS_WDN1 = WS_WUP1 + (size_t)DFF2 * D * 2;
constexpr size_t WS_DFTC = WS_WDN1 + (size_t)D * DFF * 2;
constexpr size_t WS_DFT256 = WS_DFTC + (size_t)1024 * 512 * 2;
constexpr size_t WS_DFT1024 = WS_DFT256 + (size_t)256 * 512 * 2;
constexpr size_t WS_H = WS_DFT1024 + (size_t)1024 * 2048 * 2;
constexpr size_t WS_CAT = WS_H + (size_t)T * D * 2;
constexpr size_t WS_R1 = WS_CAT + (size_t)T * D * 2;
constexpr size_t WS_Q = WS_R1;
constexpr size_t WS_V = WS_Q + (size_t)T * AW * 2;
constexpr size_t WS_GA = WS_V + (size_t)T * AW * 2;
constexpr size_t WS_U = WS_GA + (size_t)T * AW * 2;
constexpr size_t WS_VV = WS_U + (size_t)T * AW * 2;
constexpr size_t WS_LF = WS_VV + (size_t)T * AW * 2;
constexpr size_t WS_OF = WS_LF + (size_t)T * 2048 * 4;
constexpr size_t WS_OB = WS_OF + (size_t)T * AW * 4;
constexpr size_t WS_R1_END = WS_OB + (size_t)T * AW * 4;
constexpr size_t WS_ACT = WS_R1;
constexpr size_t WS_PQT = WS_R1;
constexpr size_t WS_END = WS_R1_END;
static_assert(WS_ACT + (size_t)T * DFF * 2 <= WS_R1_END && WS_PQT + (size_t)2048 * 2 * T * 2 <= WS_R1_END, "aliases fit");

constexpr int LDS_BYTES = 147456;
constexpr int LDS_XCH = 131072;

__device__ __forceinline__ unsigned f2bf(float f) { unsigned u = __builtin_bit_cast(unsigned, f); return (u + 0x7fffu + ((u >> 16) & 1u)) >> 16; }
__device__ __forceinline__ unsigned pk2(float lo, float hi) { unsigned r; asm("v_cvt_pk_bf16_f32 %0, %1, %2" : "=v"(r) : "v"(lo), "v"(hi)); return r; }
__device__ __forceinline__ float bflo(unsigned w) { return __builtin_bit_cast(float, w << 16); }
__device__ __forceinline__ float bfhi(unsigned w) { return __builtin_bit_cast(float, w & 0xffff0000u); }
__device__ __forceinline__ float bf2f(bf16_t b) { return __builtin_bit_cast(float, (unsigned)b << 16); }
__device__ __forceinline__ float wave_sum(float v) {
#pragma unroll
    for (int o = 1; o < 64; o <<= 1) v += __shfl_xor(v, o);
    return v;
}
__device__ __forceinline__ float fast_sigmoid(float x) { return __builtin_amdgcn_rcpf(1.0f + __expf(-x)); }
__device__ __forceinline__ float silu_f(float x) { return x * fast_sigmoid(x); }
__device__ __forceinline__ float gelu_tanh_f(float x) { const float u = 1.5957691216057308f * (x + 0.044715f * x * x * x); return x * fast_sigmoid(u); }
__device__ __forceinline__ int row_bi(int pm) { return pm < 16 ? 0 : 1 + ((pm - 16) >> 2); }
#define LDS_WAIT() asm volatile("s_waitcnt lgkmcnt(0)" ::: "memory")

namespace pg8 {
constexpr int BM = 256, BK = 64, HALF = 128, HTB = HALF * BK * 2, NXCD = 8, WGM = 8;
__device__ __forceinline__ int lds_byte(int r, int c) { const int st = (r >> 4) * 2 + (c >> 5), rr = r & 15, cc = c & 31, ob = rr * 64 + cc * 2; return st * 1024 + (ob ^ (((ob >> 9) & 1) << 5)); }
__device__ __forceinline__ void stage_rc(int b, int& R, int& C) { const int st = b / 1024, sb = b % 1024, swz = sb ^ (((sb >> 9) & 1) << 5); R = (st >> 1) * 16 + swz / 64; C = (st & 1) * 32 + (swz % 64) / 2; }
__device__ __forceinline__ int perm32(int rho) { const int n = rho >> 4, i = rho & 15; return 8 * (i >> 2) + 4 * n + (i & 3); }
__device__ __forceinline__ int permA_conv(int R) { return 8 * (16 * (R >> 6) + (R & 15)) + ((R >> 4) & 3); }

struct Unit { const char* A; const char* B; int e0, e1, e2, e3; };

__device__ __forceinline__ void tile_order(int L, int nM, int nN, int& pm, int& pn) {
    const int nwg = nM * nN; int wgid = L;
    { const int q = nwg / NXCD, r = nwg % NXCD, xcd = wgid % NXCD, off = wgid / NXCD; wgid = (xcd < r ? xcd * (q + 1) : r * (q + 1) + (xcd - r) * q) + off; }
    const int nig = WGM * nN, gid = wgid / nig, fm = gid * WGM, gsz = (nM - fm) < WGM ? (nM - fm) : WGM;
    pm = fm + ((wgid % nig) % gsz); pn = (wgid % nig) / gsz;
}

template <class Epi, class Sched, bool SP2, int PERMA>
__device__ __forceinline__ void gemm_phase(LAS unsigned char* lds, const int lda, const int ldb, const int nt, const size_t hstepA, const size_t hstepB, const Sched& S, const Epi& E) {
    const int tid = threadIdx.x, wid = __builtin_amdgcn_readfirstlane(tid >> 6), lane = tid & 63, wr = wid >> 2, wc = wid & 3, fr = lane & 15, fq = lane >> 4;
    unsigned voffA[2], voffB[2];
#pragma unroll
    for (int i = 0; i < 2; ++i) { int R, C; stage_rc(tid * 16 + i * 8192, R, C); const int Ra = PERMA ? permA_conv(R) : R; const int Rb = (R & ~31) + perm32(R & 31);
        voffA[i] = (unsigned)(Ra * lda + C) * 2u; voffB[i] = (unsigned)(Rb * ldb + C) * 2u; }
    const size_t kstep = (size_t)(BK * 2);
    const unsigned ldsw = (unsigned)wid * 1024u;
    const int aoff = lds_byte(wr * 64 + fr, fq * 8), boff = lds_byte(wc * 32 + fr, fq * 8);
#define PG8_SA(b, h) (((b) * 2 + (h)) * HTB)
#define PG8_SB(b, h) ((4 + (b) * 2 + (h)) * HTB)
#define PG8_STAGE(bufoff, gbase, voff) do { _Pragma("unroll") for (int _i = 0; _i < 2; ++_i) \
        __builtin_amdgcn_global_load_lds((const unsigned*)((const char*)(gbase) + (voff)[_i]), (LAS unsigned*)(lds + (bufoff) + ldsw + _i * 8192), 16, 0, 0); } while (0)
#define PG8_LDA(dst, b, h) do { _Pragma("unroll") for (int m = 0; m < 4; ++m) _Pragma("unroll") for (int k = 0; k < 2; ++k) dst[m][k] = *(const LAS bf16x8*)(lds + PG8_SA(b, h) + aoff + m * 2048 + k * 1024); } while (0)
#define PG8_LDB(dst, b, h) do { _Pragma("unroll") for (int n = 0; n < 2; ++n) _Pragma("unroll") for (int k = 0; k < 2; ++k) dst[n][k] = *(const LAS bf16x8*)(lds + PG8_SB(b, h) + boff + n * 2048 + k * 1024); } while (0)
#define PG8_MMA(ai, bj, At, Bt) do { __builtin_amdgcn_s_setprio(1); _Pragma("unroll") for (int m = 0; m < 4; ++m) _Pragma("unroll") for (int n = 0; n < 2; ++n) _Pragma("unroll") for (int k = 0; k < 2; ++k) \
        acc[ai][bj][m][n] = __builtin_amdgcn_mfma_f32_16x16x32_bf16(Bt[n][k], At[m][k], acc[ai][bj][m][n], 0, 0, 0); __builtin_amdgcn_s_setprio(0); } while (0)
#define PG8_WAIT_V(n) asm volatile("s_waitcnt vmcnt(" #n ")" ::: "memory")
#define PG8_WAIT_L(n) asm volatile("s_waitcnt lgkmcnt(" #n ")" ::: "memory")
#define PG8_BAR __builtin_amdgcn_s_barrier()
#define PG8_SCHED __builtin_amdgcn_sched_barrier(0)
    Unit cur, nxt; int ui = 0;
    if (!S.next(0, cur)) return;
    f32x4 acc[2][2][4][2];
#pragma unroll
    for (int a = 0; a < 2; ++a)
#pragma unroll
        for (int b = 0; b < 2; ++b)
#pragma unroll
            for (int m = 0; m < 4; ++m)
#pragma unroll
                for (int n = 0; n < 2; ++n) acc[a][b][m][n] = (f32x4){0.f, 0.f, 0.f, 0.f};
    bf16x8 At[4][2], B0[2][2], B1[2][2];
    const char* cA = cur.A; const char* cB = cur.B;
    if constexpr (SP2) {
        PG8_STAGE(PG8_SB(0, 0), cB, voffB); PG8_STAGE(PG8_SB(0, 1), cB + hstepB, voffB); PG8_STAGE(PG8_SA(0, 0), cA, voffA); PG8_STAGE(PG8_SA(0, 1), cA + hstepA, voffA);
        if (wr == 1) PG8_BAR;
        PG8_WAIT_V(2); PG8_BAR;
        PG8_STAGE(PG8_SB(1, 0), cB + kstep, voffB); PG8_STAGE(PG8_SA(1, 0), cA + kstep, voffA); PG8_STAGE(PG8_SB(1, 1), cB + hstepB + kstep, voffB);
        PG8_WAIT_V(6); PG8_BAR;
    } else {
        PG8_STAGE(PG8_SB(0, 0), cB, voffB); PG8_STAGE(PG8_SA(0, 0), cA, voffA); PG8_STAGE(PG8_SB(0, 1), cB + hstepB, voffB); PG8_STAGE(PG8_SA(0, 1), cA + hstepA, voffA);
        if (wr == 1) PG8_BAR;
        PG8_WAIT_V(4); PG8_BAR;
        PG8_STAGE(PG8_SB(1, 0), cB + kstep, voffB); PG8_STAGE(PG8_SA(1, 0), cA + kstep, voffA); PG8_STAGE(PG8_SB(1, 1), cB + hstepB + kstep, voffB);
        PG8_WAIT_V(6); PG8_BAR;
    }
    for (;;) {
        const bool has_next = S.next(ui + 1, nxt);
        const char* nA = has_next ? nxt.A : cA; const char* nB = has_next ? nxt.B : cB;
        for (int t = 0; t < nt; t += 2) {
            const bool last = (t == nt - 2);
            const char* a1 = cA + (size_t)(t + 1) * kstep;
            const char* a2 = last ? nA : cA + (size_t)(t + 2) * kstep; const char* b2 = last ? nB : cB + (size_t)(t + 2) * kstep;
            const char* a3 = a2 + kstep; const char* b3 = b2 + kstep;
            if constexpr (SP2) {
            PG8_LDB(B0, 0, 0); PG8_LDB(B1, 0, 1); PG8_SCHED; PG8_LDA(At, 0, 0); PG8_STAGE(PG8_SA(1, 1), a1 + hstepA, voffA);
            PG8_WAIT_V(8); PG8_WAIT_L(0); PG8_BAR; PG8_MMA(0, 0, At, B0); PG8_MMA(0, 1, At, B1); PG8_BAR; PG8_SCHED;
            PG8_LDA(At, 0, 1); PG8_STAGE(PG8_SB(0, 0), b2, voffB); PG8_STAGE(PG8_SB(0, 1), b2 + hstepB, voffB); PG8_STAGE(PG8_SA(0, 0), a2, voffA);
            PG8_WAIT_V(8); PG8_WAIT_L(0); PG8_BAR; PG8_MMA(1, 0, At, B0); PG8_MMA(1, 1, At, B1); PG8_BAR; PG8_SCHED;
            PG8_LDB(B0, 1, 0); PG8_LDB(B1, 1, 1); PG8_SCHED; PG8_LDA(At, 1, 0); PG8_STAGE(PG8_SA(0, 1), a2 + hstepA, voffA);
            PG8_WAIT_V(8); PG8_WAIT_L(0); PG8_BAR; PG8_MMA(0, 0, At, B0); PG8_MMA(0, 1, At, B1); PG8_BAR; PG8_SCHED;
            PG8_LDA(At, 1, 1); PG8_STAGE(PG8_SB(1, 0), b3, voffB); PG8_STAGE(PG8_SB(1, 1), b3 + hstepB, voffB); PG8_STAGE(PG8_SA(1, 0), a3, voffA);
            PG8_WAIT_V(8); PG8_WAIT_L(0); PG8_BAR; PG8_MMA(1, 0, At, B0); PG8_MMA(1, 1, At, B1); PG8_BAR; PG8_SCHED;
            } else {
            PG8_LDB(B0, 0, 0); PG8_SCHED; PG8_LDA(At, 0, 0); PG8_STAGE(PG8_SA(1, 1), a1 + hstepA, voffA);
            PG8_WAIT_L(8); PG8_BAR; PG8_WAIT_L(0); PG8_MMA(0, 0, At, B0); PG8_BAR; PG8_SCHED;
            PG8_LDB(B1, 0, 1); PG8_STAGE(PG8_SB(0, 0), b2, voffB);
            PG8_BAR; PG8_WAIT_L(0); PG8_MMA(0, 1, At, B1); PG8_BAR;
            PG8_LDA(At, 0, 1); PG8_STAGE(PG8_SA(0, 0), a2, voffA);
            PG8_BAR; PG8_WAIT_L(0); PG8_MMA(1, 0, At, B0); PG8_BAR; PG8_SCHED;
            PG8_STAGE(PG8_SB(0, 1), b2 + hstepB, voffB);
            PG8_WAIT_V(6); PG8_BAR; PG8_MMA(1, 1, At, B1); PG8_BAR;
            PG8_LDB(B0, 1, 0); PG8_SCHED; PG8_LDA(At, 1, 0); PG8_STAGE(PG8_SA(0, 1), a2 + hstepA, voffA);
            PG8_WAIT_L(8); PG8_BAR; PG8_WAIT_L(0); PG8_MMA(0, 0, At, B0); PG8_BAR; PG8_SCHED;
            PG8_LDB(B1, 1, 1); PG8_STAGE(PG8_SB(1, 0), b3, voffB);
            PG8_BAR; PG8_WAIT_L(0); PG8_MMA(0, 1, At, B1); PG8_BAR;
            PG8_LDA(At, 1, 1); PG8_STAGE(PG8_SA(1, 0), a3, voffA);
            PG8_BAR; PG8_WAIT_L(0); PG8_MMA(1, 0, At, B0); PG8_BAR; PG8_SCHED;
            PG8_STAGE(PG8_SB(1, 1), b3 + hstepB, voffB);
            PG8_WAIT_V(6); PG8_BAR; PG8_MMA(1, 1, At, B1); PG8_BAR;
            }
        }
        if (wr == 0) PG8_BAR;
        E(acc, cur, wr, wc, fr, fq);
        if (!has_next) break;
#pragma unroll
        for (int a = 0; a < 2; ++a)
#pragma unroll
            for (int b = 0; b < 2; ++b)
#pragma unroll
                for (int m = 0; m < 4; ++m)
#pragma unroll
                    for (int n = 0; n < 2; ++n) acc[a][b][m][n] = (f32x4){0.f, 0.f, 0.f, 0.f};
        cur = nxt; cA = nA; cB = nB; ++ui;
        if (wr == 1) PG8_BAR;
    }
    PG8_WAIT_V(0);
    PG8_BAR;
#undef PG8_SA
#undef PG8_SB
#undef PG8_STAGE
#undef PG8_LDA
#undef PG8_LDB
#undef PG8_MMA
#undef PG8_WAIT_V
#undef PG8_WAIT_L
#undef PG8_BAR
#undef PG8_SCHED
}
}
using pg8::Unit;
typedef f32x4 Acc[2][2][4][2];

struct SchedDense {
    int nM, nN, G, c; const char* A; const char* B; size_t astep, bstep;
    __device__ __forceinline__ bool next(int i, Unit& u) const {
        const long L = (long)i * G + c; if (L >= (long)nM * nN) return false;
        int pm, pn; pg8::tile_order((int)L, nM, nN, pm, pn);
        u.A = A + (size_t)pm * astep; u.B = B + (size_t)pn * bstep; u.e0 = pm; u.e1 = pn; u.e2 = 0; u.e3 = 0; return true;
    }
};
struct SchedF1 {
    int G, c; const char* A; const char* B;
    __device__ __forceinline__ bool next(int i, Unit& u) const {
        const long L = (long)i * G + c; if (L >= 16 * 48) return false;
        int pmm, pn; pg8::tile_order((int)L, 16, 48, pmm, pn);
        const int g = pmm >> 2, pmd = pmm & 3;
        u.A = A + (size_t)pmd * 256 * 512 * 2; u.B = B + ((size_t)pn * 256 * D + (size_t)g * 512) * 2; u.e0 = pmd; u.e1 = pn; u.e2 = g; u.e3 = 0; return true;
    }
};
struct SchedF2 {
    int G, c, smp; const char* A; const char* B;
    __device__ __forceinline__ bool next(int i, Unit& u) const {
        const long L = (long)i * G + c;
        if (smp) { if (L >= 256) return false; const int l = (int)L, pn2 = l & 1, pm = (l >> 1) & 3, g = (l >> 3) & 3, s = l >> 5;
            u.A = A + (size_t)pm * 256 * 2048 * 2; u.B = B + (((size_t)(g * 512 + pn2 * 256)) * (2 * T) + 2 * (size_t)(TCTX + 1024 * s)) * 2;
            u.e0 = (TCTX + 1024 * s + 256 * pm) >> 8; u.e1 = g * 2 + pn2; u.e2 = 0; u.e3 = 0; return true; }
        if (L >= 128) return false; const int l = (int)L, pn2 = l & 1, g = (l >> 1) & 3, s = l >> 3;
        u.A = A; u.B = B + (((size_t)(g * 512 + pn2 * 256)) * (2 * T) + 2 * (size_t)(256 * s)) * 2;
        u.e0 = s; u.e1 = g * 2 + pn2; u.e2 = 0; u.e3 = 0; return true;
    }
};

struct EpiInProj {
    bf16_t *Q, *V, *GA, *U, *VV; float* LF; const float* lbraw;
    __device__ __forceinline__ void operator()(Acc& acc, const Unit& u, int wr, int wc, int fr, int fq) const {
        const int pm = u.e0, pn = u.e1, seg = pn >> 2;
        const int row0 = pm * 256 + wr * 64 + fr, cs0 = (pn & 3) * 256 + wc * 32 + 8 * fq;
#pragma unroll
        for (int bj = 0; bj < 2; ++bj) {
            const int col = cs0 + bj * 128;
            if (seg == 1 || seg == 2) {
                const float* l0 = lbraw + (seg - 1) * 2048 + col;
                float lb[8];
#pragma unroll
                for (int j = 0; j < 8; ++j) lb[j] = fast_sigmoid(l0[j] - l0[1024 + j]);
#pragma unroll
                for (int ai = 0; ai < 2; ++ai)
#pragma unroll
                    for (int m = 0; m < 4; ++m) {
                        const int row = row0 + ai * 128 + m * 16;
                        f32x4 o0, o1;
#pragma unroll
                        for (int e = 0; e < 4; ++e) { o0[e] = __logf(lb[e] + (1.f - lb[e]) * fast_sigmoid(acc[ai][bj][m][0][e])); o1[e] = __logf(lb[4 + e] + (1.f - lb[4 + e]) * fast_sigmoid(acc[ai][bj][m][1][e])); }
                        float* p = LF + (size_t)row * 2048 + (seg - 1) * 1024 + col;
                        *(f32x4*)p = o0; *(f32x4*)(p + 4) = o1;
                    }
            } else {
                bf16_t* base = seg == 0 ? Q : seg == 3 ? V : seg == 4 ? GA : seg == 5 ? U : VV;
#pragma unroll
                for (int ai = 0; ai < 2; ++ai)
#pragma unroll
                    for (int m = 0; m < 4; ++m) {
                        const int row = row0 + ai * 128 + m * 16;
                        f32x4 v0 = acc[ai][bj][m][0], v1 = acc[ai][bj][m][1];
                        if (seg == 0) {
#pragma unroll
                            for (int e = 0; e < 4; ++e) { v0[e] = silu_f(v0[e]) * 0.08838834764831845f; v1[e] = silu_f(v1[e]) * 0.08838834764831845f; }
                        } else if (seg == 4) {
#pragma unroll
                            for (int e = 0; e < 4; ++e) { v0[e] = silu_f(v0[e]); v1[e] = silu_f(v1[e]); }
                        } else if (seg >= 5) {
#pragma unroll
                            for (int e = 0; e < 4; ++e) { v0[e] = gelu_tanh_f(v0[e]); v1[e] = gelu_tanh_f(v1[e]); }
                        }
                        u32x4 w; w.x = pk2(v0[0], v0[1]); w.y = pk2(v0[2], v0[3]); w.z = pk2(v1[0], v1[1]); w.w = pk2(v1[2], v1[3]);
                        *(u32x4*)(base + (size_t)row * 1024 + col) = w;
                    }
            }
        }
    }
};
struct EpiResid {
    const float* xin0; const float* xin1; float* xout; const float* gate;
    __device__ __forceinline__ void operator()(Acc& acc, const Unit& u, int wr, int wc, int fr, int fq) const {
        const int pm = u.e0, pn = u.e1;
        const int row0 = pm * 256 + wr * 64 + fr, col0 = pn * 256 + wc * 32 + 8 * fq;
        const float* g = gate + (size_t)row_bi(pm) * 12288 + col0;
        const float* xin = pm < 16 ? xin0 : xin1 - (size_t)TCTX * D;
#pragma unroll
        for (int bj = 0; bj < 2; ++bj) {
            const f32x4 g0 = *(const f32x4*)(g + bj * 128), g1 = *(const f32x4*)(g + bj * 128 + 4);
#pragma unroll
            for (int ai = 0; ai < 2; ++ai)
#pragma unroll
                for (int m = 0; m < 4; ++m) {
                    const size_t off = (size_t)(row0 + ai * 128 + m * 16) * D + col0 + bj * 128;
                    const f32x4 x0 = *(const f32x4*)(xin + off), x1 = *(const f32x4*)(xin + off + 4);
                    *(f32x4*)(xout + off) = x0 + g0 * acc[ai][bj][m][0]; *(f32x4*)(xout + off + 4) = x1 + g1 * acc[ai][bj][m][1];
                }
        }
    }
};
__device__ __forceinline__ float dpp_shr1(float src, float old) { return __builtin_bit_cast(float, __builtin_amdgcn_update_dpp(__builtin_bit_cast(int, old), __builtin_bit_cast(int, src), 0x111, 0xf, 0xf, false)); }
__device__ __forceinline__ float dpp_shl1(float src, float old) { return __builtin_bit_cast(float, __builtin_amdgcn_update_dpp(__builtin_bit_cast(int, old), __builtin_bit_cast(int, src), 0x101, 0xf, 0xf, false)); }
struct EpiConv {
    bf16_t* ACT; const float* cw; const float* cb; LAS float* xch;
    __device__ __forceinline__ void operator()(Acc& acc, const Unit& u, int wr, int wc, int fr, int fq) const {
        const int pm = u.e0, pn = u.e1; const bool ctx = pm < 16;
        LAS float* mine = xch + (wr * 4 + wc) * 64; const LAS float* other = xch + ((wr ^ 1) * 4 + wc) * 64;
        if (wr == 0) { if (fr == 15) {
#pragma unroll
            for (int bj = 0; bj < 2; ++bj)
#pragma unroll
                for (int n = 0; n < 2; ++n) *(LAS f32x4*)(mine + ((bj * 2 + n) * 4 + fq) * 4) = acc[1][bj][3][n]; } }
        else { if (fr == 0) {
#pragma unroll
            for (int bj = 0; bj < 2; ++bj)
#pragma unroll
                for (int n = 0; n < 2; ++n) *(LAS f32x4*)(mine + ((bj * 2 + n) * 4 + fq) * 4) = acc[0][bj][0][n]; } }
        LDS_WAIT(); __builtin_amdgcn_s_barrier(); asm volatile("" ::: "memory");
        f32x4 halo[2][2];
#pragma unroll
        for (int bj = 0; bj < 2; ++bj)
#pragma unroll
            for (int n = 0; n < 2; ++n) { halo[bj][n] = *(const LAS f32x4*)(other + ((bj * 2 + n) * 4 + fq) * 4); if (!ctx) halo[bj][n] = (f32x4){0.f, 0.f, 0.f, 0.f}; }
        LDS_WAIT();
        const bool zl = !ctx && fr == 8, zr = !ctx && fr == 7;
        const int wcol0 = 128 * pn + 32 * wc + 8 * fq;
#pragma unroll
        for (int bj = 0; bj < 2; ++bj)
#pragma unroll
            for (int n = 0; n < 2; ++n) {
                const float* wp = cw + bj * DFF + wcol0 + 4 * n;
                const f32x4 w0 = *(const f32x4*)wp, w1 = *(const f32x4*)(wp + DFF2), w2 = *(const f32x4*)(wp + 2 * DFF2), bb = *(const f32x4*)(cb + bj * DFF + wcol0 + 4 * n);
#pragma unroll
                for (int e = 0; e < 4; ++e) {
                    float x[8];
#pragma unroll
                    for (int j = 0; j < 8; ++j) x[j] = acc[j >> 2][bj][j & 3][n][e];
                    float left = dpp_shr1(x[7], wr == 1 ? halo[bj][n][e] : 0.f);
                    float right = dpp_shl1(x[0], wr == 0 ? halo[bj][n][e] : 0.f);
                    if (zl) left = 0.f; if (zr) right = 0.f;
#pragma unroll
                    for (int j = 0; j < 8; ++j) {
                        const float xm = j == 0 ? left : x[j - 1], xp = j == 7 ? right : x[j + 1];
                        acc[j >> 2][bj][j & 3][n][e] = w0[e] * xm + w1[e] * x[j] + w2[e] * xp + bb[e];
                    }
                }
            }
#pragma unroll
        for (int ai = 0; ai < 2; ++ai)
#pragma unroll
            for (int m = 0; m < 4; ++m) {
                const int tok = pm * 256 + 8 * (16 * wr + fr) + 4 * ai + m;
                f32x4 o0, o1;
#pragma unroll
                for (int e = 0; e < 4; ++e) { o0[e] = silu_f(acc[ai][0][m][0][e]) * acc[ai][1][m][0][e]; o1[e] = silu_f(acc[ai][0][m][1][e]) * acc[ai][1][m][1][e]; }
                u32x4 w; w.x = pk2(o0[0], o0[1]); w.y = pk2(o0[2], o0[3]); w.z = pk2(o1[0], o1[1]); w.w = pk2(o1[2], o1[3]);
                *(u32x4*)(ACT + (size_t)tok * DFF + wcol0) = w;
            }
    }
};
struct EpiF1 {
    bf16_t* PQT;
    __device__ __forceinline__ void operator()(Acc& acc, const Unit& u, int wr, int wc, int fr, int fq) const {
        const int pmd = u.e0, pn = u.e1, g = u.e2, which = pmd >> 1;
        int sb2, N, n0;
        if (pn < 16) { sb2 = 2 * 256 * pn; N = 256; n0 = 0; } else { const int s = (pn - 16) >> 2; sb2 = 2 * (TCTX + 1024 * s); N = 1024; n0 = ((pn - 16) & 3) * 256; }
        const int c0 = g * 512 + (pmd & 1) * 256 + wr * 64 + fr;
        bf16_t* base = PQT + (size_t)sb2 + which * N + n0 + wc * 32 + 8 * fq;
#pragma unroll
        for (int ai = 0; ai < 2; ++ai)
#pragma unroll
            for (int m = 0; m < 4; ++m) {
                bf16_t* rowp = base + (size_t)(c0 + ai * 128 + m * 16) * (2 * T);
#pragma unroll
                for (int bj = 0; bj < 2; ++bj) { const f32x4 v0 = acc[ai][bj][m][0], v1 = acc[ai][bj][m][1];
                    u32x4 w; w.x = pk2(v0[0], v0[1]); w.y = pk2(v0[2], v0[3]); w.z = pk2(v1[0], v1[1]); w.w = pk2(v1[2], v1[3]);
                    *(u32x4*)(rowp + bj * 128) = w; }
            }
    }
};
struct EpiBf16 {
    bf16_t* O; int ldo;
    __device__ __forceinline__ void operator()(Acc& acc, const Unit& u, int wr, int wc, int fr, int fq) const {
        const int row0 = u.e0 * 256 + wr * 64 + fr, col0 = u.e1 * 256 + wc * 32 + 8 * fq;
#pragma unroll
        for (int ai = 0; ai < 2; ++ai)
#pragma unroll
            for (int m = 0; m < 4; ++m) {
                bf16_t* rowp = O + (size_t)(row0 + ai * 128 + m * 16) * ldo + col0;
#pragma unroll
                for (int bj = 0; bj < 2; ++bj) { const f32x4 v0 = acc[ai][bj][m][0], v1 = acc[ai][bj][m][1];
                    u32x4 w; w.x = pk2(v0[0], v0[1]); w.y = pk2(v0[2], v0[3]); w.z = pk2(v1[0], v1[1]); w.w = pk2(v1[2], v1[3]);
                    *(u32x4*)(rowp + bj * 128) = w; }
            }
    }
};

struct Args { const float* in[30]; float* out; unsigned char* ws; int ph_lo, ph_hi; };

__device__ __forceinline__ void p0_transpose_item(const float* W, int K, int N, bf16_t* WT, LAS float* scr, int item, int lane, int up) {
    const int nblk = N / 32, kb = item / nblk, nb = item % nblk, k0 = 64 * kb, n0 = 32 * nb;
#pragma unroll 8
    for (int i = 0; i < 32; ++i) { const int kk = 2 * i + (lane >> 5); scr[kk * 33 + (lane & 31)] = W[(size_t)(k0 + kk) * N + n0 + (lane & 31)]; }
    LDS_WAIT(); asm volatile("" ::: "memory");
    const int c = lane & 7;
#pragma unroll
    for (int j = 0; j < 4; ++j) { const int n = (lane >> 3) + 8 * j; const LAS float* s = scr + (8 * c) * 33 + n;
        u32x4 o; o.x = pk2(s[0 * 33], s[1 * 33]); o.y = pk2(s[2 * 33], s[3 * 33]); o.z = pk2(s[4 * 33], s[5 * 33]); o.w = pk2(s[6 * 33], s[7 * 33]);
        int nn = n0 + n;
        if (up) { const int bjj = nn >= DFF ? 1 : 0, cgc = nn - bjj * DFF; nn = (cgc >> 7) * 256 + bjj * 128 + (cgc & 127); }
        *(u32x4*)(WT + (size_t)nn * K + k0 + 8 * c) = o; }
    LDS_WAIT(); asm volatile("" ::: "memory");
}
__device__ __forceinline__ void phase_prologue(const Args& a, LAS unsigned char* lds, int vcu, int G) {
    const int tid = threadIdx.x, lane = tid & 63, wave = __builtin_amdgcn_readfirstlane(tid >> 6);
    unsigned char* ws = a.ws;
    if (vcu < 192) {
        const int l = vcu / 96, n0 = (vcu % 96) * 128;
        const float* Wm = a.in[l ? 20 : 5]; const float* bm = a.in[l ? 21 : 6];
        LAS float* S = (LAS float*)lds;
        for (int i = tid; i < 2048 * 9; i += NT) { const int k = i / 9, bi = i % 9; const float cv = bi == 0 ? a.in[4][k] : a.in[3][(bi - 1) * 2048 + k]; S[k * 12 + bi] = silu_f(cv); }
        __syncthreads();
        const int l4 = tid & 31, rg = tid >> 5;
        f32x4 accm[9];
#pragma unroll
        for (int bi = 0; bi < 9; ++bi) accm[bi] = (f32x4){0.f, 0.f, 0.f, 0.f};
#pragma unroll 4
        for (int kk = 0; kk < 128; ++kk) {
            const int k = rg + 16 * kk;
            const f32x4 w = *(const f32x4*)(Wm + (size_t)k * 12288 + n0 + 4 * l4);
            const f32x4 s0 = *(const LAS f32x4*)(S + k * 12), s1 = *(const LAS f32x4*)(S + k * 12 + 4); const float s8 = S[k * 12 + 8];
            accm[0] += s0[0] * w; accm[1] += s0[1] * w; accm[2] += s0[2] * w; accm[3] += s0[3] * w;
            accm[4] += s1[0] * w; accm[5] += s1[1] * w; accm[6] += s1[2] * w; accm[7] += s1[3] * w; accm[8] += s8 * w;
        }
        __syncthreads();
        LAS float* red = (LAS float*)lds;
#pragma unroll
        for (int bi = 0; bi < 9; ++bi) *(LAS f32x4*)(red + (rg * 9 + bi) * 128 + 4 * l4) = accm[bi];
        __syncthreads();
        float* MOD = (float*)(ws + WS_MOD) + (size_t)l * 9 * 12288;
        for (int o = tid; o < 9 * 128; o += NT) { const int bi = o >> 7, n = o & 127; float s = bm[n0 + n];
#pragma unroll
            for (int r = 0; r < 16; ++r) s += red[(r * 9 + bi) * 128 + n];
            MOD[(size_t)bi * 12288 + n0 + n] = s; }
        __syncthreads();
    }
    {
        const int gt = vcu * NT + tid, GT = G * NT;
        bf16_t* DC = (bf16_t*)(ws + WS_DFTC); bf16_t* D256 = (bf16_t*)(ws + WS_DFT256); bf16_t* D1024 = (bf16_t*)(ws + WS_DFT1024);
        for (int i = gt; i < 1024 * 512; i += GT) { const int r = i >> 9, k = i & 511, c = r & 511; const float ang = 2.0f * (float)((c * k) & 511) * (1.0f / 512.0f);
            const float v = (r < 512 ? cospif(ang) : sinpif(ang)) * 0.04419417382415922f; DC[i] = (bf16_t)f2bf(v); }
        for (int i = gt; i < 256 * 512; i += GT) { const int p = i >> 9, k = i & 511, n = k & 255; const float ang = 2.0f * (float)((p * n) & 255) * (1.0f / 256.0f);
            const float v = (k < 256 ? cospif(ang) : -sinpif(ang)) * 0.0625f; D256[i] = (bf16_t)f2bf(v); }
        for (int i = gt; i < 1024 * 2048; i += GT) { const int p = i >> 11, k = i & 2047, n = k & 1023; const float ang = 2.0f * (float)((p * n) & 1023) * (1.0f / 1024.0f);
            const float v = (k < 1024 ? cospif(ang) : -sinpif(ang)) * 0.03125f; D1024[i] = (bf16_t)f2bf(v); }
    }
    {
        LAS float* scr = (LAS float*)(lds + wave * 8448);
        const int gw = vcu * 8 + wave, NGW = G * 8;
        constexpr int I_IN = 32 * (INW / 32), I_O = 32 * (D / 32), I_UP = 32 * (DFF2 / 32), I_DN = (DFF / 64) * (D / 32);
        constexpr int NITEMS = I_IN + 2 * I_O + 2 * I_UP + 2 * I_DN;
        for (int it = gw; it < NITEMS; it += NGW) {
            int r = it;
            if (r < I_IN) { p0_transpose_item(a.in[8], D, INW, (bf16_t*)(ws + WS_WIN), scr, r, lane, 0); continue; } r -= I_IN;
            if (r < I_O) { p0_transpose_item(a.in[14], D, D, (bf16_t*)(ws + WS_WOUT0), scr, r, lane, 0); continue; } r -= I_O;
            if (r < I_O) { p0_transpose_item(a.in[23], D, D, (bf16_t*)(ws + WS_WOUT1), scr, r, lane, 0); continue; } r -= I_O;
            if (r < I_UP) { p0_transpose_item(a.in[16], D, DFF2, (bf16_t*)(ws + WS_WUP0), scr, r, lane, 1); continue; } r -= I_UP;
            if (r < I_UP) { p0_transpose_item(a.in[25], D, DFF2, (bf16_t*)(ws + WS_WUP1), scr, r, lane, 1); continue; } r -= I_UP;
            if (r < I_DN) { p0_transpose_item(a.in[19], DFF, D, (bf16_t*)(ws + WS_WDN0), scr, r, lane, 0); continue; } r -= I_DN;
            p0_transpose_item(a.in[28], DFF, D, (bf16_t*)(ws + WS_WDN1), scr, r, lane, 0);
        }
    }
}

__device__ __forceinline__ void phase_norm_mod(const float* x0, const float* x1, const float* nw, const float* sh, const float* sc, bf16_t* H, int vcu, int G) {
    const int lane = threadIdx.x & 63, wave = __builtin_amdgcn_readfirstlane(threadIdx.x >> 6);
    const int gw = vcu * 8 + wave, NGW = G * 8;
    for (int row = gw; row < T; row += NGW) {
        const float* xr = row < TCTX ? x0 + (size_t)row * D : x1 + (size_t)(row - TCTX) * D;
        const int bi = row < TCTX ? 0 : 1 + ((row - TCTX) >> 10);
        f32x4 v[8]; float s = 0.f;
#pragma unroll
        for (int j = 0; j < 8; ++j) { v[j] = *(const f32x4*)(xr + 4 * lane + 256 * j); s += (v[j][0] * v[j][0] + v[j][1] * v[j][1]) + (v[j][2] * v[j][2] + v[j][3] * v[j][3]); }
        const float rstd = rsqrtf(wave_sum(s) * (1.0f / D) + 1e-6f);
        const float* shp = sh + (size_t)bi * 12288; const float* scp = sc + (size_t)bi * 12288;
#pragma unroll
        for (int j = 0; j < 8; ++j) { const int c = 4 * lane + 256 * j;
            const f32x4 w = *(const f32x4*)(nw + c), a1 = *(const f32x4*)(scp + c), a0 = *(const f32x4*)(shp + c);
            f32x4 o;
#pragma unroll
            for (int e = 0; e < 4; ++e) o[e] = v[j][e] * rstd * w[e] * (1.0f + a1[e]) + a0[e];
            u32x2 p; p.x = pk2(o[0], o[1]); p.y = pk2(o[2], o[3]);
            *(u32x2*)(H + (size_t)row * D + c) = p; }
    }
}
__device__ __forceinline__ void phase_final_norm(float* X, const float* nw, int vcu, int G) {
    const int lane = threadIdx.x & 63, wave = __builtin_amdgcn_readfirstlane(threadIdx.x >> 6);
    const int gw = vcu * 8 + wave, NGW = G * 8;
    for (int row = gw; row < T; row += NGW) {
        float* xr = X + (size_t)row * D;
        f32x4 v[8]; float s = 0.f;
#pragma unroll
        for (int j = 0; j < 8; ++j) { v[j] = *(const f32x4*)(xr + 4 * lane + 256 * j); s += (v[j][0] * v[j][0] + v[j][1] * v[j][1]) + (v[j][2] * v[j][2] + v[j][3] * v[j][3]); }
        const float rstd = rsqrtf(wave_sum(s) * (1.0f / D) + 1e-6f);
#pragma unroll
        for (int j = 0; j < 8; ++j) { const int c = 4 * lane + 256 * j; const f32x4 w = *(const f32x4*)(nw + c); *(f32x4*)(xr + c) = v[j] * rstd * w; }
    }
}

constexpr int P128 = 136, P64 = 72;
constexpr int SC_QS = 0, SC_KS = SC_QS + 64 * P128 * 2, SC_QI = SC_KS + 64 * P128 * 2, SC_KO = SC_QI + 64 * P128 * 2, SC_VT = SC_KO + 128 * P64 * 2,
              SC_SC = SC_VT + 128 * P64 * 2, SC_ST = SC_SC + 64 * P64 * 2, SC_TOT = SC_ST + 128 * P128 * 2, SC_DEC = SC_TOT + 4 * 128 * 4, SC_END = SC_DEC + 128 * 4;
static_assert(SC_END <= LDS_BYTES, "scan LDS");
__device__ __forceinline__ void scan_item(const Args& a, LAS unsigned char* lds, int seqbase, int N, int b_state, int h, int dir, bool ctx, int b_out) {
    const int tid = threadIdx.x, lane = tid & 63, w = __builtin_amdgcn_readfirstlane(tid >> 6), fr = lane & 15, fq = lane >> 4;
    unsigned char* ws = a.ws;
    const bf16_t* Qg = (const bf16_t*)(ws + WS_Q) + h * 128; const bf16_t* Vg = (const bf16_t*)(ws + WS_V) + h * 128;
    const float* LFg = (const float*)(ws + WS_LF) + dir * 1024 + h * 128;
    float* Og = (float*)(ws + (dir ? WS_OB : WS_OF)) + h * 128;
    LAS bf16_t* QS = (LAS bf16_t*)(lds + SC_QS); LAS bf16_t* KS = (LAS bf16_t*)(lds + SC_KS); LAS bf16_t* QI = (LAS bf16_t*)(lds + SC_QI);
    LAS bf16_t* KO = (LAS bf16_t*)(lds + SC_KO); LAS bf16_t* VT = (LAS bf16_t*)(lds + SC_VT); LAS bf16_t* SCm = (LAS bf16_t*)(lds + SC_SC);
    LAS bf16_t* ST = (LAS bf16_t*)(lds + SC_ST); LAS float* TOT = (LAS float*)(lds + SC_TOT); LAS float* DEC = (LAS float*)(lds + SC_DEC);
    const int ch = tid & 127, seg = tid >> 7;
    f32x4 accS[8];
    if (ctx) {
#pragma unroll
        for (int kt = 0; kt < 8; ++kt) accS[kt] = (f32x4){0.f, 0.f, 0.f, 0.f};
    } else {
        const float* s0 = a.in[2] + ((size_t)(b_state * 2 + dir) * 8 + h) * 16384;
#pragma unroll
        for (int kt = 0; kt < 8; ++kt)
#pragma unroll
            for (int e = 0; e < 4; ++e) accS[kt][e] = s0[(16 * kt + 4 * fq + e) * 128 + 16 * w + fr];
    }
    __syncthreads();
#pragma unroll
    for (int kt = 0; kt < 8; ++kt) { u32x2 p; p.x = pk2(accS[kt][0], accS[kt][1]); p.y = pk2(accS[kt][2], accS[kt][3]); *(LAS u32x2*)(ST + (16 * w + fr) * P128 + 16 * kt + 4 * fq) = p; }
    const int nc = N >> 6;
    for (int c = 0; c < nc; ++c) {
        float lf[16], qv[16]; unsigned short vv16[16];
#pragma unroll
        for (int ii = 0; ii < 16; ++ii) {
            const int i = 64 * c + 16 * seg + ii; const int tok = seqbase + (dir ? N - 1 - i : i);
            lf[ii] = LFg[(size_t)tok * 2048 + ch]; qv[ii] = bf2f(Qg[(size_t)tok * 1024 + ch]); vv16[ii] = Vg[(size_t)tok * 1024 + ch];
        }
        float bcs[16]; float run = 0.f;
#pragma unroll
        for (int ii = 0; ii < 16; ++ii) { run += lf[ii]; bcs[ii] = run; }
        TOT[seg * 128 + ch] = run;
        __syncthreads();
        const float t0 = TOT[ch], t1 = TOT[128 + ch], t2 = TOT[256 + ch], t3 = TOT[384 + ch];
        const float offs = seg == 0 ? 0.f : seg == 1 ? t0 : seg == 2 ? t0 + t1 : t0 + t1 + t2;
        const float ref = t0 + t1, blast = (t0 + t1) + (t2 + t3);
        if (seg == 0) DEC[ch] = __expf(blast);
        unsigned kow[8], vtw[8];
#pragma unroll
        for (int ii = 0; ii < 16; ii += 2) {
            float ko2[2];
#pragma unroll
            for (int d = 0; d < 2; ++d) {
                const int i2 = ii + d, i = 16 * seg + i2; const float b = bcs[i2] + offs; const float kf = 1.0f - __expf(lf[i2]);
                QS[i * P128 + ch] = (bf16_t)f2bf(qv[i2] * __expf(b - ref));
                KS[i * P128 + ch] = (bf16_t)f2bf(kf * __expf(ref - b));
                QI[i * P128 + ch] = (bf16_t)f2bf(qv[i2] * __expf(b));
                ko2[d] = kf * __expf(blast - b);
            }
            kow[ii >> 1] = pk2(ko2[0], ko2[1]); vtw[ii >> 1] = (unsigned)vv16[ii] | ((unsigned)vv16[ii + 1] << 16);
        }
        *(LAS u32x4*)(KO + ch * P64 + 16 * seg) = (u32x4){kow[0], kow[1], kow[2], kow[3]}; *(LAS u32x4*)(KO + ch * P64 + 16 * seg + 8) = (u32x4){kow[4], kow[5], kow[6], kow[7]};
        *(LAS u32x4*)(VT + ch * P64 + 16 * seg) = (u32x4){vtw[0], vtw[1], vtw[2], vtw[3]}; *(LAS u32x4*)(VT + ch * P64 + 16 * seg + 8) = (u32x4){vtw[4], vtw[5], vtw[6], vtw[7]};
        __syncthreads();
        {
            const int it = w >> 1;
#pragma unroll
            for (int jj = 0; jj < 2; ++jj) {
                const int jt = 2 * (w & 1) + jj;
                f32x4 d = (f32x4){0.f, 0.f, 0.f, 0.f};
                if (jt <= it) {
#pragma unroll
                    for (int ks = 0; ks < 4; ++ks) {
                        const bf16x8 af = *(const LAS bf16x8*)(KS + (16 * jt + fr) * P128 + 32 * ks + 8 * fq);
                        const bf16x8 bf = *(const LAS bf16x8*)(QS + (16 * it + fr) * P128 + 32 * ks + 8 * fq);
                        d = __builtin_amdgcn_mfma_f32_16x16x32_bf16(af, bf, d, 0, 0, 0);
                    }
                }
                const int i = 16 * it + fr, j0 = 16 * jt + 4 * fq;
#pragma unroll
                for (int e = 0; e < 4; ++e) if (j0 + e > i) d[e] = 0.f;
                u32x2 p; p.x = pk2(d[0], d[1]); p.y = pk2(d[2], d[3]);
                *(LAS u32x2*)(SCm + i * P64 + j0) = p;
            }
        }
        __syncthreads();
        f32x4 oacc[4];
#pragma unroll
        for (int it = 0; it < 4; ++it) oacc[it] = (f32x4){0.f, 0.f, 0.f, 0.f};
        {
            bf16x8 stf[4], vtf[2];
#pragma unroll
            for (int ks = 0; ks < 4; ++ks) stf[ks] = *(const LAS bf16x8*)(ST + (16 * w + fr) * P128 + 32 * ks + 8 * fq);
#pragma unroll
            for (int ks = 0; ks < 2; ++ks) vtf[ks] = *(const LAS bf16x8*)(VT + (16 * w + fr) * P64 + 32 * ks + 8 * fq);
#pragma unroll
            for (int it = 0; it < 4; ++it) {
#pragma unroll
                for (int ks = 0; ks < 4; ++ks) { const bf16x8 qf = *(const LAS bf16x8*)(QI + (16 * it + fr) * P128 + 32 * ks + 8 * fq); oacc[it] = __builtin_amdgcn_mfma_f32_16x16x32_bf16(stf[ks], qf, oacc[it], 0, 0, 0); }
#pragma unroll
                for (int ks = 0; ks < 2; ++ks) { const bf16x8 sf = *(const LAS bf16x8*)(SCm + (16 * it + fr) * P64 + 32 * ks + 8 * fq); oacc[it] = __builtin_amdgcn_mfma_f32_16x16x32_bf16(vtf[ks], sf, oacc[it], 0, 0, 0); }
            }
#pragma unroll
            for (int kt = 0; kt < 8; ++kt) {
                const f32x4 dc = *(const LAS f32x4*)(DEC + 16 * kt + 4 * fq);
                accS[kt] = accS[kt] * dc;
#pragma unroll
                for (int ks = 0; ks < 2; ++ks) { const bf16x8 kf = *(const LAS bf16x8*)(KO + (16 * kt + fr) * P64 + 32 * ks + 8 * fq); accS[kt] = __builtin_amdgcn_mfma_f32_16x16x32_bf16(kf, vtf[ks], accS[kt], 0, 0, 0); }
            }
        }
#pragma unroll
        for (int it = 0; it < 4; ++it) { const int i = 64 * c + 16 * it + fr; const int tok = seqbase + (dir ? N - 1 - i : i); *(f32x4*)(Og + (size_t)tok * 1024 + 16 * w + 4 * fq) = oacc[it]; }
#pragma unroll
        for (int kt = 0; kt < 8; ++kt) { u32x2 p; p.x = pk2(accS[kt][0], accS[kt][1]); p.y = pk2(accS[kt][2], accS[kt][3]); *(LAS u32x2*)(ST + (16 * w + fr) * P128 + 16 * kt + 4 * fq) = p; }
    }
    if (ctx) {
        float* so = a.out + (size_t)T * D + ((size_t)(b_out * 2 + dir) * 8 + h) * 16384;
#pragma unroll
        for (int kt = 0; kt < 8; ++kt)
#pragma unroll
            for (int e = 0; e < 4; ++e) so[(16 * kt + 4 * fq + e) * 128 + 16 * w + fr] = accS[kt][e];
    }
}

constexpr int MB_WS = 0, MB_BV = 128 * P128 * 2, MB_END = MB_BV + 256 * P128 * 2;
static_assert(MB_END <= LDS_BYTES, "mixer-B LDS");
__device__ __forceinline__ void mixb_item(const Args& a, LAS unsigned char* lds, int cbk, int g) {
    const int tid = threadIdx.x, lane = tid & 63, w = __builtin_amdgcn_readfirstlane(tid >> 6), fr = lane & 15, fq = lane >> 4;
    unsigned char* ws = a.ws;
    LAS bf16_t* WSl = (LAS bf16_t*)(lds + MB_WS); LAS bf16_t* BV = (LAS bf16_t*)(lds + MB_BV);
    const bf16_t* VVg = (const bf16_t*)(ws + WS_VV) + (size_t)cbk * 128 * 1024 + g * 256;
    const bf16_t* Ug = (const bf16_t*)(ws + WS_U) + (size_t)cbk * 128 * 1024 + g * 256;
    bf16_t* CAT = (bf16_t*)(ws + WS_CAT) + (size_t)cbk * 128 * D + 1024 + g * 256;
    const float* wsg = a.in[12] + (size_t)g * 16384; const float* vn = a.in[11] + g * 256; const float* bsg = a.in[13] + g * 128;
    __syncthreads();
#pragma unroll
    for (int j = 0; j < 8; ++j) { const int idx = (tid + j * NT) * 4, p = idx >> 7, q = idx & 127; const f32x4 v = *(const f32x4*)(wsg + idx);
        u32x2 o; o.x = pk2(v[0], v[1]); o.y = pk2(v[2], v[3]); *(LAS u32x2*)(WSl + p * P128 + q) = o; }
    {
        const int q = tid >> 2, qt = tid & 3;
        u32x4 raw[8]; float ss = 0.f;
#pragma unroll
        for (int j = 0; j < 8; ++j) { raw[j] = *(const u32x4*)(VVg + (size_t)q * 1024 + qt * 64 + 8 * j);
#pragma unroll
            for (int e = 0; e < 4; ++e) { const float lo = bflo(raw[j][e]), hi = bfhi(raw[j][e]); ss += lo * lo + hi * hi; } }
        ss += __shfl_xor(ss, 1); ss += __shfl_xor(ss, 2);
        const float rstd = rsqrtf(ss * (1.0f / 256.0f) + 1e-6f);
#pragma unroll
        for (int j = 0; j < 8; ++j)
#pragma unroll
            for (int e = 0; e < 4; ++e) { const int c = qt * 64 + 8 * j + 2 * e;
                BV[c * P128 + q] = (bf16_t)f2bf(bflo(raw[j][e]) * rstd * vn[c]); BV[(c + 1) * P128 + q] = (bf16_t)f2bf(bfhi(raw[j][e]) * rstd * vn[c + 1]); }
    }
    __syncthreads();
    const int wr2 = w >> 2, wc2 = w & 3;
    f32x4 acc[4][4];
#pragma unroll
    for (int mt = 0; mt < 4; ++mt)
#pragma unroll
        for (int nt = 0; nt < 4; ++nt) acc[mt][nt] = (f32x4){0.f, 0.f, 0.f, 0.f};
#pragma unroll
    for (int ks = 0; ks < 4; ++ks) {
        bf16x8 wf[4], vf[4];
#pragma unroll
        for (int mt = 0; mt < 4; ++mt) wf[mt] = *(const LAS bf16x8*)(WSl + (64 * wr2 + 16 * mt + fr) * P128 + 32 * ks + 8 * fq);
#pragma unroll
        for (int nt = 0; nt < 4; ++nt) vf[nt] = *(const LAS bf16x8*)(BV + (64 * wc2 + 16 * nt + fr) * P128 + 32 * ks + 8 * fq);
#pragma unroll
        for (int mt = 0; mt < 4; ++mt)
#pragma unroll
            for (int nt = 0; nt < 4; ++nt) acc[mt][nt] = __builtin_amdgcn_mfma_f32_16x16x32_bf16(vf[nt], wf[mt], acc[mt][nt], 0, 0, 0);
    }
#pragma unroll
    for (int mt = 0; mt < 4; ++mt) {
        const int p = 64 * wr2 + 16 * mt + fr; const float bsv = bsg[p];
#pragma unroll
        for (int nt = 0; nt < 4; ++nt) { const int c = 64 * wc2 + 16 * nt + 4 * fq;
            const u32x2 uu = *(const u32x2*)(Ug + (size_t)p * 1024 + c);
            u32x2 o; o.x = pk2(bflo(uu.x) * (acc[mt][nt][0] + bsv), bfhi(uu.x) * (acc[mt][nt][1] + bsv)); o.y = pk2(bflo(uu.y) * (acc[mt][nt][2] + bsv), bfhi(uu.y) * (acc[mt][nt][3] + bsv));
            *(u32x2*)(CAT + (size_t)p * D + c) = o; }
    }
}
__device__ __forceinline__ void mixer_work(const Args& a, LAS unsigned char* lds, int it) {
    if (it < 128) { const int s = it >> 4, h = (it >> 1) & 7, dir = it & 1; scan_item(a, lds, TCTX + 1024 * s, 1024, s, h, dir, false, 0); }
    else if (it < 384) { const int j = it - 128, s = j >> 4, h = (j >> 1) & 7, dir = j & 1; scan_item(a, lds, 256 * s, 256, 0, h, dir, true, s); }
    else { const int j = it - 384; mixb_item(a, lds, j >> 2, j & 3); }
}
__device__ __forceinline__ void phase_mixers(const Args& a, LAS unsigned char* lds, int vcu, int G) {
    if (G == 256) {
        const int j = vcu - 128, n = vcu < 128 ? 1 : 5;
        for (int q = 0; q < n; ++q) { const int it = vcu < 128 ? vcu : (q < 2 ? 128 + 2 * j + q : 384 + 3 * j + (q - 2)); mixer_work(a, lds, it); }
    } else { for (int it = vcu; it < 768; it += G) mixer_work(a, lds, it); }
}
__device__ __forceinline__ void phase_finalize_a(const Args& a, int vcu, int G) {
    const int lane = threadIdx.x & 63, wave = __builtin_amdgcn_readfirstlane(threadIdx.x >> 6);
    const int gw = vcu * 8 + wave, NGW = G * 8;
    unsigned char* ws = a.ws;
    const float* OF = (const float*)(ws + WS_OF); const float* OB = (const float*)(ws + WS_OB); const bf16_t* GA = (const bf16_t*)(ws + WS_GA); bf16_t* CAT = (bf16_t*)(ws + WS_CAT);
    const int col = (lane >> 3) * 128 + (lane & 7) * 16, vc = (lane & 7) * 16;
    f32x4 gn[4];
#pragma unroll
    for (int j = 0; j < 4; ++j) gn[j] = *(const f32x4*)(a.in[10] + vc + 4 * j);
    for (int row = gw; row < T; row += NGW) {
        f32x4 v[4]; float ss = 0.f;
#pragma unroll
        for (int j = 0; j < 4; ++j) { v[j] = *(const f32x4*)(OF + (size_t)row * 1024 + col + 4 * j) + *(const f32x4*)(OB + (size_t)row * 1024 + col + 4 * j); ss += (v[j][0] * v[j][0] + v[j][1] * v[j][1]) + (v[j][2] * v[j][2] + v[j][3] * v[j][3]); }
        ss += __shfl_xor(ss, 1); ss += __shfl_xor(ss, 2); ss += __shfl_xor(ss, 4);
        const float rstd = rsqrtf(ss * (1.0f / 128.0f) + 1e-6f);
        const u32x4 g0 = *(const u32x4*)(GA + (size_t)row * 1024 + col), g1 = *(const u32x4*)(GA + (size_t)row * 1024 + col + 8);
        u32x4 o0, o1;
#pragma unroll
        for (int e = 0; e < 4; ++e) {
            const int j = e >> 1, k = (e & 1) * 2;
            o0[e] = pk2(v[j][k] * rstd * gn[j][k] * bflo(g0[e]), v[j][k + 1] * rstd * gn[j][k + 1] * bfhi(g0[e]));
            o1[e] = pk2(v[2 + j][k] * rstd * gn[2 + j][k] * bflo(g1[e]), v[2 + j][k + 1] * rstd * gn[2 + j][k + 1] * bfhi(g1[e]));
        }
        *(u32x4*)(CAT + (size_t)row * D + col) = o0; *(u32x4*)(CAT + (size_t)row * D + col + 8) = o1;
    }
}

#ifndef PG8_SP2
#define PG8_SP2 false
#endif
__global__ void __launch_bounds__(NT, 2) mk_fwd(Args a) {
    extern __shared__ __attribute__((aligned(16))) unsigned char lds_raw[];
    LAS unsigned char* lds = (LAS unsigned char*)lds_raw;
    cg::grid_group grid = cg::this_grid();
    const int G = gridDim.x, bx = blockIdx.x;
    const int vcu = (G % 8 == 0) ? (bx % 8) * (G / 8) + bx / 8 : bx;
    unsigned char* ws = a.ws;
    const int lo = a.ph_lo, hi = a.ph_hi;
    float* X = a.out;
    const float* MOD0 = (const float*)(ws + WS_MOD); const float* MOD1 = MOD0 + 9 * 12288;
    bf16_t* Hb = (bf16_t*)(ws + WS_H); bf16_t* CAT = (bf16_t*)(ws + WS_CAT); bf16_t* ACT = (bf16_t*)(ws + WS_ACT); bf16_t* PQT = (bf16_t*)(ws + WS_PQT);
#ifndef PHMASK
#define PHMASK 0x1FFFF
#endif
#define IN(k) (((PHMASK >> (k)) & 1) && lo <= (k) && (k) < hi)
#define SEAM(k) do { if (IN(k) && IN((k) + 1)) grid.sync(); } while (0)

    if (IN(0)) phase_prologue(a, lds, vcu, G);
    SEAM(0);
    if (IN(1)) phase_norm_mod(a.in[0], a.in[1], a.in[7], MOD0, MOD0 + D, Hb, vcu, G);
    SEAM(1);
    if (IN(2)) {
        SchedDense S{48, INW / 256, G, bx, (const char*)Hb, (const char*)(ws + WS_WIN), (size_t)256 * D * 2, (size_t)256 * D * 2};
        EpiInProj E{(bf16_t*)(ws + WS_Q), (bf16_t*)(ws + WS_V), (bf16_t*)(ws + WS_GA), (bf16_t*)(ws + WS_U), (bf16_t*)(ws + WS_VV), (float*)(ws + WS_LF), a.in[9]};
        pg8::gemm_phase<EpiInProj, SchedDense, PG8_SP2, 0>(lds, D, D, D / 64, (size_t)128 * D * 2, (size_t)128 * D * 2, S, E);
    }
    SEAM(2);
    if (IN(3)) phase_mixers(a, lds, vcu, G);
    SEAM(3);
    if (IN(4)) phase_finalize_a(a, vcu, G);
    SEAM(4);
    if (IN(5)) {
        SchedDense S{48, 8, G, bx, (const char*)CAT, (const char*)(ws + WS_WOUT0), (size_t)256 * D * 2, (size_t)256 * D * 2};
        EpiResid E{a.in[0], a.in[1], X, MOD0 + 2 * D};
        pg8::gemm_phase<EpiResid, SchedDense, PG8_SP2, 0>(lds, D, D, D / 64, (size_t)128 * D * 2, (size_t)128 * D * 2, S, E);
    }
    SEAM(5);
    if (IN(6)) phase_norm_mod(X, X + (size_t)TCTX * D, a.in[15], MOD0 + 3 * D, MOD0 + 4 * D, Hb, vcu, G);
    SEAM(6);
    if (IN(7)) {
        SchedDense S{48, DFF / 128, G, bx, (const char*)Hb, (const char*)(ws + WS_WUP0), (size_t)256 * D * 2, (size_t)256 * D * 2};
        EpiConv E{ACT, a.in[17], a.in[18], (LAS float*)(lds + LDS_XCH)};
        pg8::gemm_phase<EpiConv, SchedDense, PG8_SP2, 1>(lds, D, D, D / 64, (size_t)4 * D * 2, (size_t)128 * D * 2, S, E);
    }
    SEAM(7);
    if (IN(8)) {
        SchedDense S{48, 8, G, bx, (const char*)ACT, (const char*)(ws + WS_WDN0), (size_t)256 * DFF * 2, (size_t)256 * DFF * 2};
        EpiResid E{X, X + (size_t)TCTX * D, X, MOD0 + 5 * D};
        pg8::gemm_phase<EpiResid, SchedDense, PG8_SP2, 0>(lds, DFF, DFF, DFF / 64, (size_t)128 * DFF * 2, (size_t)128 * DFF * 2, S, E);
    }
    SEAM(8);
    if (IN(9)) phase_norm_mod(X, X + (size_t)TCTX * D, a.in[22], MOD1, MOD1 + D, Hb, vcu, G);
    SEAM(9);
    if (IN(10)) {
        SchedF1 S{G, bx, (const char*)(ws + WS_DFTC), (const char*)Hb};
        EpiF1 E{PQT};
        pg8::gemm_phase<EpiF1, SchedF1, PG8_SP2, 0>(lds, 512, D, 8, (size_t)128 * 512 * 2, (size_t)128 * D * 2, S, E);
    }
    SEAM(10);
    if (IN(11)) {
        { SchedF2 S{G, bx, 1, (const char*)(ws + WS_DFT1024), (const char*)PQT}; EpiBf16 E{CAT, D};
          pg8::gemm_phase<EpiBf16, SchedF2, PG8_SP2, 0>(lds, 2048, 2 * T, 32, (size_t)128 * 2048 * 2, (size_t)128 * 2 * T * 2, S, E); }
        { SchedF2 S{G, bx, 0, (const char*)(ws + WS_DFT256), (const char*)PQT}; EpiBf16 E{CAT, D};
          pg8::gemm_phase<EpiBf16, SchedF2, PG8_SP2, 0>(lds, 512, 2 * T, 8, (size_t)128 * 512 * 2, (size_t)128 * 2 * T * 2, S, E); }
    }
    SEAM(11);
    if (IN(12)) {
        SchedDense S{48, 8, G, bx, (const char*)CAT, (const char*)(ws + WS_WOUT1), (size_t)256 * D * 2, (size_t)256 * D * 2};
        EpiResid E{X, X + (size_t)TCTX * D, X, MOD1 + 2 * D};
        pg8::gemm_phase<EpiResid, SchedDense, PG8_SP2, 0>(lds, D, D, D / 64, (size_t)128 * D * 2, (size_t)128 * D * 2, S, E);
    }
    SEAM(12);
    if (IN(13)) phase_norm_mod(X, X + (size_t)TCTX * D, a.in[24], MOD1 + 3 * D, MOD1 + 4 * D, Hb, vcu, G);
    SEAM(13);
    if (IN(14)) {
        SchedDense S{48, DFF / 128, G, bx, (const char*)Hb, (const char*)(ws + WS_WUP1), (size_t)256 * D * 2, (size_t)256 * D * 2};
        EpiConv E{ACT, a.in[26], a.in[27], (LAS float*)(lds + LDS_XCH)};
        pg8::gemm_phase<EpiConv, SchedDense, PG8_SP2, 1>(lds, D, D, D / 64, (size_t)4 * D * 2, (size_t)128 * D * 2, S, E);
    }
    SEAM(14);
    if (IN(15)) {
        SchedDense S{48, 8, G, bx, (const char*)ACT, (const char*)(ws + WS_WDN1), (size_t)256 * DFF * 2, (size_t)256 * DFF * 2};
        EpiResid E{X, X + (size_t)TCTX * D, X, MOD1 + 5 * D};
        pg8::gemm_phase<EpiResid, SchedDense, PG8_SP2, 0>(lds, DFF, DFF, DFF / 64, (size_t)128 * DFF * 2, (size_t)128 * DFF * 2, S, E);
    }
    SEAM(15);
    if (IN(16)) phase_final_norm(X, a.in[29], vcu, G);
#undef IN
#undef SEAM
}

extern "C" void kernel_launch(void* const* d_in, const int* in_sizes, int n_in, void* d_out, int out_size, void* d_ws, size_t ws_size, hipStream_t stream) {
    static int grid = 0;
    if (grid == 0) {
        if (n_in != 30 || ws_size < WS_END) { fprintf(stderr, "kernel_launch: need 30 inputs and %zu bytes of workspace (got %d, %zu)\n", (size_t)WS_END, n_in, ws_size); grid = -1; return; }
        int dev = 0, cus = 0, per_cu = 0;
        if (hipGetDevice(&dev) != hipSuccess || hipDeviceGetAttribute(&cus, hipDeviceAttributeMultiprocessorCount, dev) != hipSuccess) { grid = -1; return; }
        if (hipFuncSetAttribute((const void*)mk_fwd, hipFuncAttributeMaxDynamicSharedMemorySize, LDS_BYTES) != hipSuccess) { fprintf(stderr, "kernel_launch: hipFuncSetAttribute failed\n"); grid = -1; return; }
        if (hipOccupancyMaxActiveBlocksPerMultiprocessor(&per_cu, (const void*)mk_fwd, NT, LDS_BYTES) != hipSuccess || per_cu < 1) { fprintf(stderr, "kernel_launch: occupancy query says %d blocks per CU\n", per_cu); grid = -1; return; }
        grid = cus;
    }
    if (grid < 0) return;
    Args a{};
    for (int i = 0; i < 30; ++i) a.in[i] = (const float*)d_in[i];
    a.out = (float*)d_out; a.ws = (unsigned char*)d_ws;
#if MK_FUSED
    a.ph_lo = 0; a.ph_hi = NPH;
    void* args[] = {&a};
    hipError_t e = hipLaunchCooperativeKernel((const void*)mk_fwd, dim3(grid), dim3(NT), args, LDS_BYTES, stream);
    if (e != hipSuccess) fprintf(stderr, "cooperative launch failed: %s (grid %d)\n", hipGetErrorString(e), grid);
#else
    for (int p = 0; p < NPH; ++p) {
        a.ph_lo = p; a.ph_hi = p + 1;
        void* args[] = {&a};
        hipError_t e = hipLaunchCooperativeKernel((const void*)mk_fwd, dim3(grid), dim3(NT), args, LDS_BYTES, stream);
        if (e != hipSuccess) { fprintf(stderr, "launch %d failed: %s (grid %d)\n", p, hipGetErrorString(e), grid); break; }
    }
#endif
}
```

```cpp
#include <hip/hip_runtime.h>
#include <hip/hip_cooperative_groups.h>
#include <cstdio>
#include <cstdint>
namespace cg = cooperative_groups;

#ifndef MK_FUSED
#define MK_FUSED 1
#endif

#define LAS __attribute__((address_space(3)))
typedef unsigned short bf16_t;
typedef short bf16x8 __attribute__((ext_vector_type(8)));
typedef float f32x4 __attribute__((ext_vector_type(4)));
typedef float f32x2 __attribute__((ext_vector_type(2)));
typedef unsigned u32x4 __attribute__((ext_vector_type(4)));
typedef unsigned u32x2 __attribute__((ext_vector_type(2)));

constexpr int D = 2048, T = 12288, TCTX = 4096;
constexpr int DFF = 5632, DFF2 = 11264, INW = 7168, AW = 1024;
constexpr int NPH = 17;
constexpr int NT = 512;

constexpr size_t WS_CTL = 0;
constexpr size_t WS_MOD = 65536;
constexpr size_t WS_WIN = WS_MOD + (size_t)2 * 9 * 12288 * 4;
constexpr size_t WS_WOUT0 = WS_WIN + (size_t)INW * D * 2;
constexpr size_t WS_WUP0 = WS_WOUT0 + (size_t)D * D * 2;
constexpr size_t WS_WDN0 = WS_WUP0 + (size_t)DFF2 * D * 2;
constexpr size_t WS_WOUT1 = WS_WDN0 + (size_t)D * DFF * 2;
constexpr size_t WS_WUP1 = WS_WOUT1 + (size_t)D * D * 2;
constexpr size_t WS_WDN1 = WS_WUP1 + (size_t)DFF2 * D * 2;
constexpr size_t WS_DFTC = WS_WDN1 + (size_t)D * DFF * 2;
constexpr size_t WS_DFT256 = WS_DFTC + (size_t)1024 * 512 * 2;
constexpr size_t WS_DFT1024 = WS_DFT256 + (size_t)256 * 512 * 2;
constexpr size_t WS_H = WS_DFT1024 + (size_t)1024 * 2048 * 2;
constexpr size_t WS_CAT = WS_H + (size_t)T * D * 2;
constexpr size_t WS_R1 = WS_CAT + (size_t)T * D * 2;
constexpr size_t WS_Q = WS_R1;
constexpr size_t WS_V = WS_Q + (size_t)T * AW * 2;
constexpr size_t WS_GA = WS_V + (size_t)T * AW * 2;
constexpr size_t WS_U = WS_GA + (size_t)T * AW * 2;
constexpr size_t WS_VV = WS_U + (size_t)T * AW * 2;
constexpr size_t WS_LF = WS_VV + (size_t)T * AW * 2;
constexpr size_t WS_OF = WS_LF + (size_t)T * 2048 * 4;
constexpr size_t WS_OB = WS_OF + (size_t)T * AW * 4;
constexpr size_t WS_R1_END = WS_OB + (size_t)T * AW * 4;
constexpr size_t WS_ACT = WS_R1;
constexpr size_t WS_PQT = WS_R1;
constexpr size_t WS_END = WS_R1_END;
static_assert(WS_ACT + (size_t)T * DFF * 2 <= WS_R1_END && WS_PQT + (size_t)2048 * 2 * T * 2 <= WS_R1_END, "aliases fit");

constexpr int LDS_BYTES = 147456;
constexpr int LDS_XCH = 131072;
constexpr int LDS_MISC = 131072 + 8192;

__device__ __forceinline__ unsigned f2bf(float f) { unsigned u = __builtin_bit_cast(unsigned, f); return (u + 0x7fffu + ((u >> 16) & 1u)) >> 16; }
__device__ __forceinline__ unsigned pk2(float lo, float hi) { unsigned r; asm("v_cvt_pk_bf16_f32 %0, %1, %2" : "=v"(r) : "v"(lo), "v"(hi)); return r; }
__device__ __forceinline__ float bflo(unsigned w) { return __builtin_bit_cast(float, w << 16); }
__device__ __forceinline__ float bfhi(unsigned w) { return __builtin_bit_cast(float, w & 0xffff0000u); }
__device__ __forceinline__ float bf2f(bf16_t b) { return __builtin_bit_cast(float, (unsigned)b << 16); }
__device__ __forceinline__ float wave_sum(float v) {
#pragma unroll
    for (int o = 1; o < 64; o <<= 1) v += __shfl_xor(v, o);
    return v;
}
__device__ __forceinline__ float fast_sigmoid(float x) { return __builtin_amdgcn_rcpf(1.0f + __expf(-x)); }
__device__ __forceinline__ float silu_f(float x) { return x * fast_sigmoid(x); }
__device__ __forceinline__ float gelu_tanh_f(float x) { const float u = 1.5957691216057308f * (x + 0.044715f * x * x * x); return x * fast_sigmoid(u); }
__device__ __forceinline__ int row_bi(int pm) { return pm < 16 ? 0 : 1 + ((pm - 16) >> 2); }
#define LDS_WAIT() asm volatile("s_waitcnt lgkmcnt(0)" ::: "memory")

namespace pg8 {
constexpr int BM = 256, BK = 64, HALF = 128, HTB = HALF * BK * 2, NXCD = 8, WGM = 8;
__device__ __forceinline__ int lds_byte(int r, int c) { const int st = (r >> 4) * 2 + (c >> 5), rr = r & 15, cc = c & 31, ob = rr * 64 + cc * 2; return st * 1024 + (ob ^ (((ob >> 9) & 1) << 5)); }
__device__ __forceinline__ void stage_rc(int b, int& R, int& C) { const int st = b / 1024, sb = b % 1024, swz = sb ^ (((sb >> 9) & 1) << 5); R = (st >> 1) * 16 + swz / 64; C = (st & 1) * 32 + (swz % 64) / 2; }
__device__ __forceinline__ int perm32(int rho) { const int n = rho >> 4, i = rho & 15; return 8 * (i >> 2) + 4 * n + (i & 3); }
__device__ __forceinline__ int permA_conv(int R) { return 8 * (16 * (R >> 6) + (R & 15)) + ((R >> 4) & 3); }

struct Unit { const char* A; const char* B; int e0, e1, e2, e3; };

__device__ __forceinline__ void tile_order(int L, int nM, int nN, int& pm, int& pn) {
    const int nwg = nM * nN; int wgid = L;
    { const int q = nwg / NXCD, r = nwg % NXCD, xcd = wgid % NXCD, off = wgid / NXCD; wgid = (xcd < r ? xcd * (q + 1) : r * (q + 1) + (xcd - r) * q) + off; }
    const int nig = WGM * nN, gid = wgid / nig, fm = gid * WGM, gsz = (nM - fm) < WGM ? (nM - fm) : WGM;
    pm = fm + ((wgid % nig) % gsz); pn = (wgid % nig) / gsz;
}

template <class Epi, class Sched, bool SP2, int PERMA>
__device__ __forceinline__ void gemm_phase(LAS unsigned char* lds, const int lda, const int ldb, const int nt, const size_t hstepA, const size_t hstepB, const Sched& S, const Epi& E) {
    const int tid = threadIdx.x, wid = __builtin_amdgcn_readfirstlane(tid >> 6), lane = tid & 63, wr = wid >> 2, wc = wid & 3, fr = lane & 15, fq = lane >> 4;
    unsigned voffA[2], voffB[2];
#pragma unroll
    for (int i = 0; i < 2; ++i) { int R, C; stage_rc(tid * 16 + i * 8192, R, C); const int Ra = PERMA ? permA_conv(R) : R; const int Rb = (R & ~31) + perm32(R & 31);
        voffA[i] = (unsigned)(Ra * lda + C) * 2u; voffB[i] = (unsigned)(Rb * ldb + C) * 2u; }
    const size_t kstep = (size_t)(BK * 2);
    const unsigned ldsw = (unsigned)wid * 1024u;
    const int aoff = lds_byte(wr * 64 + fr, fq * 8), boff = lds_byte(wc * 32 + fr, fq * 8);
#define PG8_SA(b, h) (((b) * 2 + (h)) * HTB)
#define PG8_SB(b, h) ((4 + (b) * 2 + (h)) * HTB)
#define PG8_STAGE(bufoff, gbase, voff) do { _Pragma("unroll") for (int _i = 0; _i < 2; ++_i) \
        __builtin_amdgcn_global_load_lds((const unsigned*)((const char*)(gbase) + (voff)[_i]), (LAS unsigned*)(lds + (bufoff) + ldsw + _i * 8192), 16, 0, 0); } while (0)
#define PG8_LDA(dst, b, h) do { _Pragma("unroll") for (int m = 0; m < 4; ++m) _Pragma("unroll") for (int k = 0; k < 2; ++k) dst[m][k] = *(const LAS bf16x8*)(lds + PG8_SA(b, h) + aoff + m * 2048 + k * 1024); } while (0)
#define PG8_LDB(dst, b, h) do { _Pragma("unroll") for (int n = 0; n < 2; ++n) _Pragma("unroll") for (int k = 0; k < 2; ++k) dst[n][k] = *(const LAS bf16x8*)(lds + PG8_SB(b, h) + boff + n * 2048 + k * 1024); } while (0)
#define PG8_MMA(ai, bj, At, Bt) do { __builtin_amdgcn_s_setprio(1); _Pragma("unroll") for (int m = 0; m < 4; ++m) _Pragma("unroll") for (int n = 0; n < 2; ++n) _Pragma("unroll") for (int k = 0; k < 2; ++k) \
        acc[ai][bj][m][n] = __builtin_amdgcn_mfma_f32_16x16x32_bf16(Bt[n][k], At[m][k], acc[ai][bj][m][n], 0, 0, 0); __builtin_amdgcn_s_setprio(0); } while (0)
#define PG8_WAIT_V(n) asm volatile("s_waitcnt vmcnt(" #n ")" ::: "memory")
#define PG8_WAIT_L(n) asm volatile("s_waitcnt lgkmcnt(" #n ")" ::: "memory")
#define PG8_BAR __builtin_amdgcn_s_barrier()
#define PG8_SCHED __builtin_amdgcn_sched_barrier(0)
    Unit cur, nxt; int ui = 0;
    if (!S.next(0, cur)) return;
    f32x4 acc[2][2][4][2];
#pragma unroll
    for (int a = 0; a < 2; ++a)
#pragma unroll
        for (int b = 0; b < 2; ++b)
#pragma unroll
            for (int m = 0; m < 4; ++m)
#pragma unroll
                for (int n = 0; n < 2; ++n) acc[a][b][m][n] = (f32x4){0.f, 0.f, 0.f, 0.f};
    bf16x8 At[4][2], B0[2][2], B1[2][2];
    const char* cA = cur.A; const char* cB = cur.B;
    if constexpr (SP2) {
        PG8_STAGE(PG8_SB(0, 0), cB, voffB); PG8_STAGE(PG8_SB(0, 1), cB + hstepB, voffB); PG8_STAGE(PG8_SA(0, 0), cA, voffA); PG8_STAGE(PG8_SA(0, 1), cA + hstepA, voffA);
        if (wr == 1) PG8_BAR;
        PG8_WAIT_V(2); PG8_BAR;
        PG8_STAGE(PG8_SB(1, 0), cB + kstep, voffB); PG8_STAGE(PG8_SA(1, 0), cA + kstep, voffA); PG8_STAGE(PG8_SB(1, 1), cB + hstepB + kstep, voffB);
        PG8_WAIT_V(6); PG8_BAR;
    } else {
        PG8_STAGE(PG8_SB(0, 0), cB, voffB); PG8_STAGE(PG8_SA(0, 0), cA, voffA); PG8_STAGE(PG8_SB(0, 1), cB + hstepB, voffB); PG8_STAGE(PG8_SA(0, 1), cA + hstepA, voffA);
        if (wr == 1) PG8_BAR;
        PG8_WAIT_V(4); PG8_BAR;
        PG8_STAGE(PG8_SB(1, 0), cB + kstep, voffB); PG8_STAGE(PG8_SA(1, 0), cA + kstep, voffA); PG8_STAGE(PG8_SB(1, 1), cB + hstepB + kstep, voffB);
        PG8_WAIT_V(6); PG8_BAR;
    }
    for (;;) {
        const bool has_next = S.next(ui + 1, nxt);
        const char* nA = has_next ? nxt.A : cA; const char* nB = has_next ? nxt.B : cB;
        for (int t = 0; t < nt; t += 2) {
            const bool last = (t == nt - 2);
            const char* a1 = cA + (size_t)(t + 1) * kstep;
            const char* a2 = last ? nA : cA + (size_t)(t + 2) * kstep; const char* b2 = last ? nB : cB + (size_t)(t + 2) * kstep;
            const char* a3 = a2 + kstep; const char* b3 = b2 + kstep;
            if constexpr (SP2) {
            PG8_LDB(B0, 0, 0); PG8_LDB(B1, 0, 1); PG8_SCHED; PG8_LDA(At, 0, 0); PG8_STAGE(PG8_SA(1, 1), a1 + hstepA, voffA);
            PG8_WAIT_V(8); PG8_WAIT_L(0); PG8_BAR; PG8_MMA(0, 0, At, B0); PG8_MMA(0, 1, At, B1); PG8_BAR; PG8_SCHED;
            PG8_LDA(At, 0, 1); PG8_STAGE(PG8_SB(0, 0), b2, voffB); PG8_STAGE(PG8_SB(0, 1), b2 + hstepB, voffB); PG8_STAGE(PG8_SA(0, 0), a2, voffA);
            PG8_WAIT_V(8); PG8_WAIT_L(0); PG8_BAR; PG8_MMA(1, 0, At, B0); PG8_MMA(1, 1, At, B1); PG8_BAR; PG8_SCHED;
            PG8_LDB(B0, 1, 0); PG8_LDB(B1, 1, 1); PG8_SCHED; PG8_LDA(At, 1, 0); PG8_STAGE(PG8_SA(0, 1), a2 + hstepA, voffA);
            PG8_WAIT_V(8); PG8_WAIT_L(0); PG8_BAR; PG8_MMA(0, 0, At, B0); PG8_MMA(0, 1, At, B1); PG8_BAR; PG8_SCHED;
            PG8_LDA(At, 1, 1); PG8_STAGE(PG8_SB(1, 0), b3, voffB); PG8_STAGE(PG8_SB(1, 1), b3 + hstepB, voffB); PG8_STAGE(PG8_SA(1, 0), a3, voffA);
            PG8_WAIT_V(8); PG8_WAIT_L(0); PG8_BAR; PG8_MMA(1, 0, At, B0); PG8_MMA(1, 1, At, B1); PG8_BAR; PG8_SCHED;
            } else {
            PG8_LDB(B0, 0, 0); PG8_SCHED; PG8_LDA(At, 0, 0); PG8_STAGE(PG8_SA(1, 1), a1 + hstepA, voffA);
            PG8_WAIT_L(8); PG8_BAR; PG8_WAIT_L(0); PG8_MMA(0, 0, At, B0); PG8_BAR; PG8_SCHED;
            PG8_LDB(B1, 0, 1); PG8_STAGE(PG8_SB(0, 0), b2, voffB);
            PG8_BAR; PG8_WAIT_L(0); PG8_MMA(0, 1, At, B1); PG8_BAR;
            PG8_LDA(At, 0, 1); PG8_STAGE(PG8_SA(0, 0), a2, voffA);
            PG8_BAR; PG8_WAIT_L(0); PG8_MMA(1, 0, At, B0); PG8_BAR; PG8_SCHED;
            PG8_STAGE(PG8_SB(0, 1), b2 + hstepB, voffB);
            PG8_WAIT_V(6); PG8_BAR; PG8_MMA(1, 1, At, B1); PG8_BAR;
            PG8_LDB(B0, 1, 0); PG8_SCHED; PG8_LDA(At, 1, 0); PG8_STAGE(PG8_SA(0, 1), a2 + hstepA, voffA);
            PG8_WAIT_L(8); PG8_BAR; PG8_WAIT_L(0); PG8_MMA(0, 0, At, B0); PG8_BAR; PG8_SCHED;
            PG8_LDB(B1, 1, 1); PG8_STAGE(PG8_SB(1, 0), b3, voffB);
            PG8_BAR; PG8_WAIT_L(0); PG8_MMA(0, 1, At, B1); PG8_BAR;
            PG8_LDA(At, 1, 1); PG8_STAGE(PG8_SA(1, 0), a3, voffA);
            PG8_BAR; PG8_WAIT_L(0); PG8_MMA(1, 0, At, B0); PG8_BAR; PG8_SCHED;
            PG8_STAGE(PG8_SB(1, 1), b3 + hstepB, voffB);
            PG8_WAIT_V(6); PG8_BAR; PG8_MMA(1, 1, At, B1); PG8_BAR;
            }
        }
        if (wr == 0) PG8_BAR;
        E(acc, cur, wr, wc, fr, fq);
        if (!has_next) break;
#pragma unroll
        for (int a = 0; a < 2; ++a)
#pragma unroll
            for (int b = 0; b < 2; ++b)
#pragma unroll
                for (int m = 0; m < 4; ++m)
#pragma unroll
                    for (int n = 0; n < 2; ++n) acc[a][b][m][n] = (f32x4){0.f, 0.f, 0.f, 0.f};
        cur = nxt; cA = nA; cB = nB; ++ui;
        if (wr == 1) PG8_BAR;
    }
    PG8_WAIT_V(0);
    PG8_BAR;
#undef PG8_SA
#undef PG8_SB
#undef PG8_STAGE
#undef PG8_LDA
#undef PG8_LDB
#undef PG8_MMA
#undef PG8_WAIT_V
#undef PG8_WAIT_L
#undef PG8_BAR
#undef PG8_SCHED
}
}
using pg8::Unit;
typedef f32x4 Acc[2][2][4][2];

struct SchedDense {
    int nM, nN, G, c; const char* A; const char* B; size_t astep, bstep; int reps;
    __device__ __forceinline__ bool next(int i, Unit& u) const {
        long L = (long)i * G + c; if (L >= (long)reps * nM * nN) return false; L %= (long)nM * nN;
        int pm, pn; pg8::tile_order((int)L, nM, nN, pm, pn);
        u.A = A + (size_t)pm * astep; u.B = B + (size_t)pn * bstep; u.e0 = pm; u.e1 = pn; u.e2 = 0; u.e3 = 0; return true;
    }
};
struct SchedF1 {
    int G, c; const char* A; const char* B;
    __device__ __forceinline__ bool next(int i, Unit& u) const {
        const long L = (long)i * G + c; if (L >= 16 * 48) return false;
        int pmm, pn; pg8::tile_order((int)L, 16, 48, pmm, pn);
        const int g = pmm >> 2, pmd = pmm & 3;
        u.A = A + (size_t)pmd * 256 * 512 * 2; u.B = B + ((size_t)pn * 256 * D + (size_t)g * 512) * 2; u.e0 = pmd; u.e1 = pn; u.e2 = g; u.e3 = 0; return true;
    }
};
struct SchedF2 {
    int G, c, smp; const char* A; const char* B;
    __device__ __forceinline__ bool next(int i, Unit& u) const {
        const long L = (long)i * G + c;
        if (smp) { if (L >= 256) return false; const int l = (int)L, pn2 = l & 1, pm = (l >> 1) & 3, g = (l >> 3) & 3, s = l >> 5;
            u.A = A + (size_t)pm * 256 * 2048 * 2; u.B = B + (((size_t)(g * 512 + pn2 * 256)) * (2 * T) + 2 * (size_t)(TCTX + 1024 * s)) * 2;
            u.e0 = (TCTX + 1024 * s + 256 * pm) >> 8; u.e1 = g * 2 + pn2; u.e2 = 0; u.e3 = 0; return true; }
        if (L >= 128) return false; const int l = (int)L, pn2 = l & 1, g = (l >> 1) & 3, s = l >> 3;
        u.A = A; u.B = B + (((size_t)(g * 512 + pn2 * 256)) * (2 * T) + 2 * (size_t)(256 * s)) * 2;
        u.e0 = s; u.e1 = g * 2 + pn2; u.e2 = 0; u.e3 = 0; return true;
    }
};

struct EpiInProj {
    bf16_t *Q, *V, *GA, *U, *VV; float* LF; const float* lbraw;
    __device__ __forceinline__ void operator()(Acc& acc, const Unit& u, int wr, int wc, int fr, int fq) const {
        const int pm = u.e0, pn = u.e1, seg = pn >> 2;
        const int row0 = pm * 256 + wr * 64 + fr, cs0 = (pn & 3) * 256 + wc * 32 + 8 * fq;
#pragma unroll
        for (int bj = 0; bj < 2; ++bj) {
            const int col = cs0 + bj * 128;
            if (seg == 1 || seg == 2) {
                const float* l0 = lbraw + (seg - 1) * 2048 + col;
                float lb[8];
#pragma unroll
                for (int j = 0; j < 8; ++j) lb[j] = fast_sigmoid(l0[j] - l0[1024 + j]);
#pragma unroll
                for (int ai = 0; ai < 2; ++ai)
#pragma unroll
                    for (int m = 0; m < 4; ++m) {
                        const int row = row0 + ai * 128 + m * 16;
                        f32x4 o0, o1;
#pragma unroll
                        for (int e = 0; e < 4; ++e) { o0[e] = __logf(lb[e] + (1.f - lb[e]) * fast_sigmoid(acc[ai][bj][m][0][e])); o1[e] = __logf(lb[4 + e] + (1.f - lb[4 + e]) * fast_sigmoid(acc[ai][bj][m][1][e])); }
                        float* p = LF + (size_t)row * 2048 + (seg - 1) * 1024 + col;
                        *(f32x4*)p = o0; *(f32x4*)(p + 4) = o1;
                    }
            } else {
                bf16_t* base = seg == 0 ? Q : seg == 3 ? V : seg == 4 ? GA : seg == 5 ? U : VV;
#pragma unroll
                for (int ai = 0; ai < 2; ++ai)
#pragma unroll
                    for (int m = 0; m < 4; ++m) {
                        const int row = row0 + ai * 128 + m * 16;
                        f32x4 v0 = acc[ai][bj][m][0], v1 = acc[ai][bj][m][1];
                        if (seg == 0) {
#pragma unroll
                            for (int e = 0; e < 4; ++e) { v0[e] = silu_f(v0[e]) * 0.08838834764831845f; v1[e] = silu_f(v1[e]) * 0.08838834764831845f; }
                        } else if (seg == 4) {
#pragma unroll
                            for (int e = 0; e < 4; ++e) { v0[e] = silu_f(v0[e]); v1[e] = silu_f(v1[e]); }
                        } else if (seg >= 5) {
#pragma unroll
                            for (int e = 0; e < 4; ++e) { v0[e] = gelu_tanh_f(v0[e]); v1[e] = gelu_tanh_f(v1[e]); }
                        }
                        u32x4 w; w.x = pk2(v0[0], v0[1]); w.y = pk2(v0[2], v0[3]); w.z = pk2(v1[0], v1[1]); w.w = pk2(v1[2], v1[3]);
                        *(u32x4*)(base + (size_t)row * 1024 + col) = w;
                    }
            }
        }
    }
};
struct EpiResid {
    const float* xin0; const float* xin1; float* xout; const float* gate;
    __device__ __forceinline__ void operator()(Acc& acc, const Unit& u, int wr, int wc, int fr, int fq) const {
        const int pm = u.e0, pn = u.e1;
        const int row0 = pm * 256 + wr * 64 + fr, col0 = pn * 256 + wc * 32 + 8 * fq;
        const float* g = gate + (size_t)row_bi(pm) * 12288 + col0;
        const float* xin = pm < 16 ? xin0 : xin1 - (size_t)TCTX * D;
#pragma unroll
        for (int bj = 0; bj < 2; ++bj) {
            const f32x4 g0 = *(const f32x4*)(g + bj * 128), g1 = *(const f32x4*)(g + bj * 128 + 4);
#pragma unroll
            for (int ai = 0; ai < 2; ++ai)
#pragma unroll
                for (int m = 0; m < 4; ++m) {
                    const size_t off = (size_t)(row0 + ai * 128 + m * 16) * D + col0 + bj * 128;
                    const f32x4 x0 = *(const f32x4*)(xin + off), x1 = *(const f32x4*)(xin + off + 4);
                    *(f32x4*)(xout + off) = x0 + g0 * acc[ai][bj][m][0]; *(f32x4*)(xout + off + 4) = x1 + g1 * acc[ai][bj][m][1];
                }
        }
    }
};
__device__ __forceinline__ float dpp_shr1(float src, float old) { return __builtin_bit_cast(float, __builtin_amdgcn_update_dpp(__builtin_bit_cast(int, old), __builtin_bit_cast(int, src), 0x111, 0xf, 0xf, false)); }
__device__ __forceinline__ float dpp_shl1(float src, float old) { return __builtin_bit_cast(float, __builtin_amdgcn_update_dpp(__builtin_bit_cast(int, old), __builtin_bit_cast(int, src), 0x101, 0xf, 0xf, false)); }
struct EpiConv {
    bf16_t* ACT; const float* cw; const float* cb; LAS float* xch;
    __device__ __forceinline__ void operator()(Acc& acc, const Unit& u, int wr, int wc, int fr, int fq) const {
        const int pm = u.e0, pn = u.e1; const bool ctx = pm < 16;
        LAS float* mine = xch + (wr * 4 + wc) * 64; const LAS float* other = xch + ((wr ^ 1) * 4 + wc) * 64;
        if (wr == 0) { if (fr == 15) {
#pragma unroll
            for (int bj = 0; bj < 2; ++bj)
#pragma unroll
                for (int n = 0; n < 2; ++n) *(LAS f32x4*)(mine + ((bj * 2 + n) * 4 + fq) * 4) = acc[1][bj][3][n]; } }
        else { if (fr == 0) {
#pragma unroll
            for (int bj = 0; bj < 2; ++bj)
#pragma unroll
                for (int n = 0; n < 2; ++n) *(LAS f32x4*)(mine + ((bj * 2 + n) * 4 + fq) * 4) = acc[0][bj][0][n]; } }
        LDS_WAIT(); __builtin_amdgcn_s_barrier(); asm volatile("" ::: "memory");
        const bool zl = !ctx && fr == 8, zr = !ctx && fr == 7;
        const int wcol0 = 128 * pn + 32 * wc + 8 * fq;
#pragma unroll
        for (int bj = 0; bj < 2; ++bj)
#pragma unroll
            for (int n = 0; n < 2; ++n) {
                const float* wp = cw + bj * DFF + wcol0 + 4 * n;
                const f32x4 w0 = *(const f32x4*)wp, w1 = *(const f32x4*)(wp + DFF2), w2 = *(const f32x4*)(wp + 2 * DFF2), bb = *(const f32x4*)(cb + bj * DFF + wcol0 + 4 * n);
                f32x4 hv = *(const LAS f32x4*)(other + ((bj * 2 + n) * 4 + fq) * 4); if (!ctx) hv = (f32x4){0.f, 0.f, 0.f, 0.f};
#pragma unroll
                for (int e = 0; e < 4; ++e) {
                    float x[8];
#pragma unroll
                    for (int j = 0; j < 8; ++j) x[j] = acc[j >> 2][bj][j & 3][n][e];
                    float left = dpp_shr1(x[7], wr == 1 ? hv[e] : 0.f);
                    float right = dpp_shl1(x[0], wr == 0 ? hv[e] : 0.f);
                    if (zl) left = 0.f; if (zr) right = 0.f;
#pragma unroll
                    for (int j = 0; j < 8; ++j) {
                        const float xm = j == 0 ? left : x[j - 1], xp = j == 7 ? right : x[j + 1];
                        acc[j >> 2][bj][j & 3][n][e] = w0[e] * xm + w1[e] * x[j] + w2[e] * xp + bb[e];
                    }
                }
            }
#pragma unroll
        for (int ai = 0; ai < 2; ++ai)
#pragma unroll
            for (int m = 0; m < 4; ++m) {
                const int tok = pm * 256 + 8 * (16 * wr + fr) + 4 * ai + m;
                f32x4 o0, o1;
#pragma unroll
                for (int e = 0; e < 4; ++e) { o0[e] = silu_f(acc[ai][0][m][0][e]) * acc[ai][1][m][0][e]; o1[e] = silu_f(acc[ai][0][m][1][e]) * acc[ai][1][m][1][e]; }
                u32x4 w; w.x = pk2(o0[0], o0[1]); w.y = pk2(o0[2], o0[3]); w.z = pk2(o1[0], o1[1]); w.w = pk2(o1[2], o1[3]);
                *(u32x4*)(ACT + (size_t)tok * DFF + wcol0) = w;
            }
    }
};
struct EpiF1 {
    bf16_t* PQT;
    __device__ __forceinline__ void operator()(Acc& acc, const Unit& u, int wr, int wc, int fr, int fq) const {
        const int pmd = u.e0, pn = u.e1, g = u.e2, which = pmd >> 1;
        int sb2, N, n0;
        if (pn < 16) { sb2 = 2 * 256 * pn; N = 256; n0 = 0; } else { const int s = (pn - 16) >> 2; sb2 = 2 * (TCTX + 1024 * s); N = 1024; n0 = ((pn - 16) & 3) * 256; }
        const int c0 = g * 512 + (pmd & 1) * 256 + wr * 64 + fr;
        bf16_t* base = PQT + (size_t)sb2 + which * N + n0 + wc * 32 + 8 * fq;
#pragma unroll
        for (int ai = 0; ai < 2; ++ai)
#pragma unroll
            for (int m = 0; m < 4; ++m) {
                bf16_t* rowp = base + (size_t)(c0 + ai * 128 + m * 16) * (2 * T);
#pragma unroll
                for (int bj = 0; bj < 2; ++bj) { const f32x4 v0 = acc[ai][bj][m][0], v1 = acc[ai][bj][m][1];
                    u32x4 w; w.x = pk2(v0[0], v0[1]); w.y = pk2(v0[2], v0[3]); w.z = pk2(v1[0], v1[1]); w.w = pk2(v1[2], v1[3]);
                    *(u32x4*)(rowp + bj * 128) = w; }
            }
    }
};
struct EpiBf16 {
    bf16_t* O; int ldo;
    __device__ __forceinline__ void operator()(Acc& acc, const Unit& u, int wr, int wc, int fr, int fq) const {
        const int row0 = u.e0 * 256 + wr * 64 + fr, col0 = u.e1 * 256 + wc * 32 + 8 * fq;
#pragma unroll
        for (int ai = 0; ai < 2; ++ai)
#pragma unroll
            for (int m = 0; m < 4; ++m) {
                bf16_t* rowp = O + (size_t)(row0 + ai * 128 + m * 16) * ldo + col0;
#pragma unroll
                for (int bj = 0; bj < 2; ++bj) { const f32x4 v0 = acc[ai][bj][m][0], v1 = acc[ai][bj][m][1];
                    u32x4 w; w.x = pk2(v0[0], v0[1]); w.y = pk2(v0[2], v0[3]); w.z = pk2(v1[0], v1[1]); w.w = pk2(v1[2], v1[3]);
                    *(u32x4*)(rowp + bj * 128) = w; }
            }
    }
};

struct Args { const float* in[30]; float* out; unsigned char* ws; int ph_lo, ph_hi; };

__device__ __forceinline__ void p0_transpose_item(const float* W, int K, int N, bf16_t* WT, LAS float* scr, int item, int lane, int up) {
    const int nblk = N / 32, kb = item / nblk, nb = item % nblk, k0 = 64 * kb, n0 = 32 * nb;
#pragma unroll 8
    for (int i = 0; i < 32; ++i) { const int kk = 2 * i + (lane >> 5); scr[kk * 33 + (lane & 31)] = W[(size_t)(k0 + kk) * N + n0 + (lane & 31)]; }
    LDS_WAIT(); asm volatile("" ::: "memory");
    const int c = lane & 7;
#pragma unroll
    for (int j = 0; j < 4; ++j) { const int n = (lane >> 3) + 8 * j; const LAS float* s = scr + (8 * c) * 33 + n;
        u32x4 o; o.x = pk2(s[0 * 33], s[1 * 33]); o.y = pk2(s[2 * 33], s[3 * 33]); o.z = pk2(s[4 * 33], s[5 * 33]); o.w = pk2(s[6 * 33], s[7 * 33]);
        int nn = n0 + n;
        if (up) { const int bjj = nn >= DFF ? 1 : 0, cgc = nn - bjj * DFF; nn = (cgc >> 7) * 256 + bjj * 128 + (cgc & 127); }
        *(u32x4*)(WT + (size_t)nn * K + k0 + 8 * c) = o; }
    LDS_WAIT(); asm volatile("" ::: "memory");
}
__device__ __forceinline__ void phase_prologue(const Args& a, LAS unsigned char* lds, int vcu, int G) {
    const int tid = threadIdx.x, lane = tid & 63, wave = __builtin_amdgcn_readfirstlane(tid >> 6);
    unsigned char* ws = a.ws;
    __syncthreads();
    if (vcu < 192) {
        const int l = vcu / 96, n0 = (vcu % 96) * 128;
        const float* Wm = a.in[l ? 20 : 5]; const float* bm = a.in[l ? 21 : 6];
        LAS float* S = (LAS float*)lds;
        for (int i = tid; i < 2048 * 9; i += NT) { const int k = i / 9, bi = i % 9; const float cv = bi == 0 ? a.in[4][k] : a.in[3][(bi - 1) * 2048 + k]; S[k * 12 + bi] = silu_f(cv); }
        __syncthreads();
        const int l4 = tid & 31, rg = tid >> 5;
        f32x4 accm[9];
#pragma unroll
        for (int bi = 0; bi < 9; ++bi) accm[bi] = (f32x4){0.f, 0.f, 0.f, 0.f};
#pragma unroll 4
        for (int kk = 0; kk < 128; ++kk) {
            const int k = rg + 16 * kk;
            const f32x4 w = *(const f32x4*)(Wm + (size_t)k * 12288 + n0 + 4 * l4);
            const f32x4 s0 = *(const LAS f32x4*)(S + k * 12), s1 = *(const LAS f32x4*)(S + k * 12 + 4); const float s8 = S[k * 12 + 8];
            accm[0] += s0[0] * w; accm[1] += s0[1] * w; accm[2] += s0[2] * w; accm[3] += s0[3] * w;
            accm[4] += s1[0] * w; accm[5] += s1[1] * w; accm[6] += s1[2] * w; accm[7] += s1[3] * w; accm[8] += s8 * w;
        }
        __syncthreads();
        LAS float* red = (LAS float*)lds;
#pragma unroll
        for (int bi = 0; bi < 9; ++bi) *(LAS f32x4*)(red + (rg * 9 + bi) * 128 + 4 * l4) = accm[bi];
        __syncthreads();
        float* MOD = (float*)(ws + WS_MOD) + (size_t)l * 9 * 12288;
        for (int o = tid; o < 9 * 128; o += NT) { const int bi = o >> 7, n = o & 127; float s = bm[n0 + n];
#pragma unroll
            for (int r = 0; r < 16; ++r) s += red[(r * 9 + bi) * 128 + n];
            MOD[(size_t)bi * 12288 + n0 + n] = s; }
        __syncthreads();
    }
    {
        const int gt = vcu * NT + tid, GT = G * NT;
        bf16_t* DC = (bf16_t*)(ws + WS_DFTC); bf16_t* D256 = (bf16_t*)(ws + WS_DFT256); bf16_t* D1024 = (bf16_t*)(ws + WS_DFT1024);
        for (int i = gt; i < 1024 * 512; i += GT) { const int r = i >> 9, k = i & 511, c = r & 511; const float ang = 2.0f * (float)((c * k) & 511) * (1.0f / 512.0f);
            const float v = (r < 512 ? cospif(ang) : sinpif(ang)) * 0.04419417382415922f; DC[i] = (bf16_t)f2bf(v); }
        for (int i = gt; i < 256 * 512; i += GT) { const int p = i >> 9, k = i & 511, n = k & 255; const float ang = 2.0f * (float)((p * n) & 255) * (1.0f / 256.0f);
            const float v = (k < 256 ? cospif(ang) : -sinpif(ang)) * 0.0625f; D256[i] = (bf16_t)f2bf(v); }
        for (int i = gt; i < 1024 * 2048; i += GT) { const int p = i >> 11, k = i & 2047, n = k & 1023; const float ang = 2.0f * (float)((p * n) & 1023) * (1.0f / 1024.0f);
            const float v = (k < 1024 ? cospif(ang) : -sinpif(ang)) * 0.03125f; D1024[i] = (bf16_t)f2bf(v); }
    }
    {
        LAS float* scr = (LAS float*)(lds + wave * 8448);
        const int gw = vcu * 8 + wave, NGW = G * 8;
        constexpr int I_IN = 32 * (INW / 32), I_O = 32 * (D / 32), I_UP = 32 * (DFF2 / 32), I_DN = (DFF / 64) * (D / 32);
        constexpr int NITEMS = I_IN + 2 * I_O + 2 * I_UP + 2 * I_DN;
        for (int it = gw; it < NITEMS; it += NGW) {
            int r = it;
            if (r < I_IN) { p0_transpose_item(a.in[8], D, INW, (bf16_t*)(ws + WS_WIN), scr, r, lane, 0); continue; } r -= I_IN;
            if (r < I_O) { p0_transpose_item(a.in[14], D, D, (bf16_t*)(ws + WS_WOUT0), scr, r, lane, 0); continue; } r -= I_O;
            if (r < I_O) { p0_transpose_item(a.in[23], D, D, (bf16_t*)(ws + WS_WOUT1), scr, r, lane, 0); continue; } r -= I_O;
            if (r < I_UP) { p0_transpose_item(a.in[16], D, DFF2, (bf16_t*)(ws + WS_WUP0), scr, r, lane, 1); continue; } r -= I_UP;
            if (r < I_UP) { p0_transpose_item(a.in[25], D, DFF2, (bf16_t*)(ws + WS_WUP1), scr, r, lane, 1); continue; } r -= I_UP;
            if (r < I_DN) { p0_transpose_item(a.in[19], DFF, D, (bf16_t*)(ws + WS_WDN0), scr, r, lane, 0); continue; } r -= I_DN;
            p0_transpose_item(a.in[28], DFF, D, (bf16_t*)(ws + WS_WDN1), scr, r, lane, 0);
        }
    }
}

__device__ __forceinline__ void phase_norm_mod(const float* x0, const float* x1, const float* nw, const float* sh, const float* sc, bf16_t* H, int vcu, int G) {
    const int lane = threadIdx.x & 63, wave = __builtin_amdgcn_readfirstlane(threadIdx.x >> 6);
    const int gw = vcu * 8 + wave, NGW = G * 8;
    for (int row = gw; row < T; row += NGW) {
        const float* xr = row < TCTX ? x0 + (size_t)row * D : x1 + (size_t)(row - TCTX) * D;
        const int bi = row < TCTX ? 0 : 1 + ((row - TCTX) >> 10);
        f32x4 v[8]; float s = 0.f;
#pragma unroll
        for (int j = 0; j < 8; ++j) { v[j] = *(const f32x4*)(xr + 4 * lane + 256 * j); s += (v[j][0] * v[j][0] + v[j][1] * v[j][1]) + (v[j][2] * v[j][2] + v[j][3] * v[j][3]); }
        const float rstd = rsqrtf(wave_sum(s) * (1.0f / D) + 1e-6f);
        const float* shp = sh + (size_t)bi * 12288; const float* scp = sc + (size_t)bi * 12288;
#pragma unroll
        for (int j = 0; j < 8; ++j) { const int c = 4 * lane + 256 * j;
            const f32x4 w = *(const f32x4*)(nw + c), a1 = *(const f32x4*)(scp + c), a0 = *(const f32x4*)(shp + c);
            f32x4 o;
#pragma unroll
            for (int e = 0; e < 4; ++e) o[e] = v[j][e] * rstd * w[e] * (1.0f + a1[e]) + a0[e];
            u32x2 p; p.x = pk2(o[0], o[1]); p.y = pk2(o[2], o[3]);
            *(u32x2*)(H + (size_t)row * D + c) = p; }
    }
}
__device__ __forceinline__ void phase_final_norm(float* X, const float* nw, int vcu, int G) {
    const int lane = threadIdx.x & 63, wave = __builtin_amdgcn_readfirstlane(threadIdx.x >> 6);
    const int gw = vcu * 8 + wave, NGW = G * 8;
    for (int row = gw; row < T; row += NGW) {
        float* xr = X + (size_t)row * D;
        f32x4 v[8]; float s = 0.f;
#pragma unroll
        for (int j = 0; j < 8; ++j) { v[j] = *(const f32x4*)(xr + 4 * lane + 256 * j); s += (v[j][0] * v[j][0] + v[j][1] * v[j][1]) + (v[j][2] * v[j][2] + v[j][3] * v[j][3]); }
        const float rstd = rsqrtf(wave_sum(s) * (1.0f / D) + 1e-6f);
#pragma unroll
        for (int j = 0; j < 8; ++j) { const int c = 4 * lane + 256 * j; const f32x4 w = *(const f32x4*)(nw + c); *(f32x4*)(xr + c) = v[j] * rstd * w; }
    }
}

constexpr int P128 = 136, P64 = 72;
constexpr int SC_QS = 0, SC_KS = SC_QS + 64 * P128 * 2, SC_QI = SC_KS + 64 * P128 * 2, SC_KO = SC_QI + 64 * P128 * 2, SC_VT = SC_KO + 128 * P64 * 2,
              SC_SC = SC_VT + 128 * P64 * 2, SC_ST = SC_SC + 64 * P64 * 2, SC_TOT = SC_ST + 128 * P128 * 2, SC_DEC = SC_TOT + 4 * 128 * 4, SC_END = SC_DEC + 128 * 4;
static_assert(SC_END <= LDS_BYTES, "scan LDS");
__device__ __forceinline__ void scan_item(const Args& a, LAS unsigned char* lds, int seqbase, int N, int b_state, int h, int dir, bool ctx, int b_out) {
    const int tid = threadIdx.x, lane = tid & 63, w = __builtin_amdgcn_readfirstlane(tid >> 6), fr = lane & 15, fq = lane >> 4;
    unsigned char* ws = a.ws;
    const bf16_t* Qg = (const bf16_t*)(ws + WS_Q) + h * 128; const bf16_t* Vg = (const bf16_t*)(ws + WS_V) + h * 128;
    const float* LFg = (const float*)(ws + WS_LF) + dir * 1024 + h * 128;
    float* Og = (float*)(ws + (dir ? WS_OB : WS_OF)) + h * 128;
    LAS bf16_t* QS = (LAS bf16_t*)(lds + SC_QS); LAS bf16_t* KS = (LAS bf16_t*)(lds + SC_KS); LAS bf16_t* QI = (LAS bf16_t*)(lds + SC_QI);
    LAS bf16_t* KO = (LAS bf16_t*)(lds + SC_KO); LAS bf16_t* VT = (LAS bf16_t*)(lds + SC_VT); LAS bf16_t* SCm = (LAS bf16_t*)(lds + SC_SC);
    LAS bf16_t* ST = (LAS bf16_t*)(lds + SC_ST); LAS float* TOT = (LAS float*)(lds + SC_TOT); LAS float* DEC = (LAS float*)(lds + SC_DEC);
    const int ch = tid & 127, seg = tid >> 7;
    f32x4 accS[8];
    if (ctx) {
#pragma unroll
        for (int kt = 0; kt < 8; ++kt) accS[kt] = (f32x4){0.f, 0.f, 0.f, 0.f};
    } else {
        const float* s0 = a.in[2] + ((size_t)(b_state * 2 + dir) * 8 + h) * 16384;
#pragma unroll
        for (int kt = 0; kt < 8; ++kt)
#pragma unroll
            for (int e = 0; e < 4; ++e) accS[kt][e] = s0[(16 * kt + 4 * fq + e) * 128 + 16 * w + fr];
    }
    __syncthreads();
#pragma unroll
    for (int kt = 0; kt < 8; ++kt) { u32x2 p; p.x = pk2(accS[kt][0], accS[kt][1]); p.y = pk2(accS[kt][2], accS[kt][3]); *(LAS u32x2*)(ST + (16 * w + fr) * P128 + 16 * kt + 4 * fq) = p; }
    const int nc = N >> 6;
    for (int c = 0; c < nc; ++c) {
        float lf[16], qv[16]; unsigned short vv16[16];
#pragma unroll
        for (int ii = 0; ii < 16; ++ii) {
            const int i = 64 * c + 16 * seg + ii; const int tok = seqbase + (dir ? N - 1 - i : i);
            lf[ii] = LFg[(size_t)tok * 2048 + ch]; qv[ii] = bf2f(Qg[(size_t)tok * 1024 + ch]); vv16[ii] = Vg[(size_t)tok * 1024 + ch];
        }
        float bcs[16]; float run = 0.f;
#pragma unroll
        for (int ii = 0; ii < 16; ++ii) { run += lf[ii]; bcs[ii] = run; }
        TOT[seg * 128 + ch] = run;
        __syncthreads();
        const float t0 = TOT[ch], t1 = TOT[128 + ch], t2 = TOT[256 + ch], t3 = TOT[384 + ch];
        const float offs = seg == 0 ? 0.f : seg == 1 ? t0 : seg == 2 ? t0 + t1 : t0 + t1 + t2;
        const float ref = t0 + t1, blast = (t0 + t1) + (t2 + t3);
        if (seg == 0) DEC[ch] = __expf(blast);
        unsigned kow[8], vtw[8];
#pragma unroll
        for (int ii = 0; ii < 16; ii += 2) {
            float ko2[2];
#pragma unroll
            for (int d = 0; d < 2; ++d) {
                const int i2 = ii + d, i = 16 * seg + i2; const float b = bcs[i2] + offs; const float kf = 1.0f - __expf(lf[i2]);
                QS[i * P128 + ch] = (bf16_t)f2bf(qv[i2] * __expf(b - ref));
                KS[i * P128 + ch] = (bf16_t)f2bf(kf * __expf(ref - b));
                QI[i * P128 + ch] = (bf16_t)f2bf(qv[i2] * __expf(b));
                ko2[d] = kf * __expf(blast - b);
            }
            kow[ii >> 1] = pk2(ko2[0], ko2[1]); vtw[ii >> 1] = (unsigned)vv16[ii] | ((unsigned)vv16[ii + 1] << 16);
        }
        *(LAS u32x4*)(KO + ch * P64 + 16 * seg) = (u32x4){kow[0], kow[1], kow[2], kow[3]}; *(LAS u32x4*)(KO + ch * P64 + 16 * seg + 8) = (u32x4){kow[4], kow[5], kow[6], kow[7]};
        *(LAS u32x4*)(VT + ch * P64 + 16 * seg) = (u32x4){vtw[0], vtw[1], vtw[2], vtw[3]}; *(LAS u32x4*)(VT + ch * P64 + 16 * seg + 8) = (u32x4){vtw[4], vtw[5], vtw[6], vtw[7]};
        __syncthreads();
        {
            const int it = w >> 1;
#pragma unroll
            for (int jj = 0; jj < 2; ++jj) {
                const int jt = 2 * (w & 1) + jj;
                f32x4 d = (f32x4){0.f, 0.f, 0.f, 0.f};
                if (jt <= it) {
#pragma unroll
                    for (int ks = 0; ks < 4; ++ks) {
                        const bf16x8 af = *(const LAS bf16x8*)(KS + (16 * jt + fr) * P128 + 32 * ks + 8 * fq);
                        const bf16x8 bf = *(const LAS bf16x8*)(QS + (16 * it + fr) * P128 + 32 * ks + 8 * fq);
                        d = __builtin_amdgcn_mfma_f32_16x16x32_bf16(af, bf, d, 0, 0, 0);
                    }
                }
                const int i = 16 * it + fr, j0 = 16 * jt + 4 * fq;
#pragma unroll
                for (int e = 0; e < 4; ++e) if (j0 + e > i) d[e] = 0.f;
                u32x2 p; p.x = pk2(d[0], d[1]); p.y = pk2(d[2], d[3]);
                *(LAS u32x2*)(SCm + i * P64 + j0) = p;
            }
        }
        __syncthreads();
        f32x4 oacc[4];
#pragma unroll
        for (int it = 0; it < 4; ++it) oacc[it] = (f32x4){0.f, 0.f, 0.f, 0.f};
        {
            bf16x8 stf[4], vtf[2];
#pragma unroll
            for (int ks = 0; ks < 4; ++ks) stf[ks] = *(const LAS bf16x8*)(ST + (16 * w + fr) * P128 + 32 * ks + 8 * fq);
#pragma unroll
            for (int ks = 0; ks < 2; ++ks) vtf[ks] = *(const LAS bf16x8*)(VT + (16 * w + fr) * P64 + 32 * ks + 8 * fq);
#pragma unroll
            for (int it = 0; it < 4; ++it) {
#pragma unroll
                for (int ks = 0; ks < 4; ++ks) { const bf16x8 qf = *(const LAS bf16x8*)(QI + (16 * it + fr) * P128 + 32 * ks + 8 * fq); oacc[it] = __builtin_amdgcn_mfma_f32_16x16x32_bf16(stf[ks], qf, oacc[it], 0, 0, 0); }
#pragma unroll
                for (int ks = 0; ks < 2; ++ks) { const bf16x8 sf = *(const LAS bf16x8*)(SCm + (16 * it + fr) * P64 + 32 * ks + 8 * fq); oacc[it] = __builtin_amdgcn_mfma_f32_16x16x32_bf16(vtf[ks], sf, oacc[it], 0, 0, 0); }
            }
#pragma unroll
            for (int kt = 0; kt < 8; ++kt) {
                const f32x4 dc = *(const LAS f32x4*)(DEC + 16 * kt + 4 * fq);
                accS[kt] = accS[kt] * dc;
#pragma unroll
                for (int ks = 0; ks < 2; ++ks) { const bf16x8 kf = *(const LAS bf16x8*)(KO + (16 * kt + fr) * P64 + 32 * ks + 8 * fq); accS[kt] = __builtin_amdgcn_mfma_f32_16x16x32_bf16(kf, vtf[ks], accS[kt], 0, 0, 0); }
            }
        }
#pragma unroll
        for (int it = 0; it < 4; ++it) { const int i = 64 * c + 16 * it + fr; const int tok = seqbase + (dir ? N - 1 - i : i); *(f32x4*)(Og + (size_t)tok * 1024 + 16 * w + 4 * fq) = oacc[it]; }
#pragma unroll
        for (int kt = 0; kt < 8; ++kt) { u32x2 p; p.x = pk2(accS[kt][0], accS[kt][1]); p.y = pk2(accS[kt][2], accS[kt][3]); *(LAS u32x2*)(ST + (16 * w + fr) * P128 + 16 * kt + 4 * fq) = p; }
    }
    if (ctx) {
        float* so = a.out + (size_t)T * D + ((size_t)(b_out * 2 + dir) * 8 + h) * 16384;
#pragma unroll
        for (int kt = 0; kt < 8; ++kt)
#pragma unroll
            for (int e = 0; e < 4; ++e) so[(16 * kt + 4 * fq + e) * 128 + 16 * w + fr] = accS[kt][e];
    }
}

constexpr int MB_WS = 0, MB_BV = 128 * P128 * 2, MB_END = MB_BV + 256 * P128 * 2;
static_assert(MB_END <= LDS_BYTES, "mixer-B LDS");
__device__ __forceinline__ void mixb_item(const Args& a, LAS unsigned char* lds, int cbk, int g) {
    const int tid = threadIdx.x, lane = tid & 63, w = __builtin_amdgcn_readfirstlane(tid >> 6), fr = lane & 15, fq = lane >> 4;
    unsigned char* ws = a.ws;
    LAS bf16_t* WSl = (LAS bf16_t*)(lds + MB_WS); LAS bf16_t* BV = (LAS bf16_t*)(lds + MB_BV);
    const bf16_t* VVg = (const bf16_t*)(ws + WS_VV) + (size_t)cbk * 128 * 1024 + g * 256;
    const bf16_t* Ug = (const bf16_t*)(ws + WS_U) + (size_t)cbk * 128 * 1024 + g * 256;
    bf16_t* CAT = (bf16_t*)(ws + WS_CAT) + (size_t)cbk * 128 * D + 1024 + g * 256;
    const float* wsg = a.in[12] + (size_t)g * 16384; const float* vn = a.in[11] + g * 256; const float* bsg = a.in[13] + g * 128;
    __syncthreads();
#pragma unroll
    for (int j = 0; j < 8; ++j) { const int idx = (tid + j * NT) * 4, p = idx >> 7, q = idx & 127; const f32x4 v = *(const f32x4*)(wsg + idx);
        u32x2 o; o.x = pk2(v[0], v[1]); o.y = pk2(v[2], v[3]); *(LAS u32x2*)(WSl + p * P128 + q) = o; }
    {
        const int q = tid >> 2, qt = tid & 3;
        u32x4 raw[8]; float ss = 0.f;
#pragma unroll
        for (int j = 0; j < 8; ++j) { raw[j] = *(const u32x4*)(VVg + (size_t)q * 1024 + qt * 64 + 8 * j);
#pragma unroll
            for (int e = 0; e < 4; ++e) { const float lo = bflo(raw[j][e]), hi = bfhi(raw[j][e]); ss += lo * lo + hi * hi; } }
        ss += __shfl_xor(ss, 1); ss += __shfl_xor(ss, 2);
        const float rstd = rsqrtf(ss * (1.0f / 256.0f) + 1e-6f);
#pragma unroll
        for (int j = 0; j < 8; ++j)
#pragma unroll
            for (int e = 0; e < 4; ++e) { const int c = qt * 64 + 8 * j + 2 * e;
                BV[c * P128 + q] = (bf16_t)f2bf(bflo(raw[j][e]) * rstd * vn[c]); BV[(c + 1) * P128 + q] = (bf16_t)f2bf(bfhi(raw[j][e]) * rstd * vn[c + 1]); }
    }
    __syncthreads();
    const int wr2 = w >> 2, wc2 = w & 3;
    f32x4 acc[4][4];
#pragma unroll
    for (int mt = 0; mt < 4; ++mt)
#pragma unroll
        for (int nt = 0; nt < 4; ++nt) acc[mt][nt] = (f32x4){0.f, 0.f, 0.f, 0.f};
#pragma unroll
    for (int ks = 0; ks < 4; ++ks) {
        bf16x8 wf[4], vf[4];
#pragma unroll
        for (int mt = 0; mt < 4; ++mt) wf[mt] = *(const LAS bf16x8*)(WSl + (64 * wr2 + 16 * mt + fr) * P128 + 32 * ks + 8 * fq);
#pragma unroll
        for (int nt = 0; nt < 4; ++nt) vf[nt] = *(const LAS bf16x8*)(BV + (64 * wc2 + 16 * nt + fr) * P128 + 32 * ks + 8 * fq);
#pragma unroll
        for (int mt = 0; mt < 4; ++mt)
#pragma unroll
            for (int nt = 0; nt < 4; ++nt) acc[mt][nt] = __builtin_amdgcn_mfma_f32_16x16x32_bf16(vf[nt], wf[mt], acc[mt][nt], 0, 0, 0);
    }
#pragma unroll
    for (int mt = 0; mt < 4; ++mt) {
        const int p = 64 * wr2 + 16 * mt + fr; const float bsv = bsg[p];
#pragma unroll
        for (int nt = 0; nt < 4; ++nt) { const int c = 64 * wc2 + 16 * nt + 4 * fq;
            const u32x2 uu = *(const u32x2*)(Ug + (size_t)p * 1024 + c);
            u32x2 o; o.x = pk2(bflo(uu.x) * (acc[mt][nt][0] + bsv), bfhi(uu.x) * (acc[mt][nt][1] + bsv)); o.y = pk2(bflo(uu.y) * (acc[mt][nt][2] + bsv), bfhi(uu.y) * (acc[mt][nt][3] + bsv));
            *(u32x2*)(CAT + (size_t)p * D + c) = o; }
    }
}
__device__ __forceinline__ void mixer_work(const Args& a, LAS unsigned char* lds, int it) {
    if (it < 128) { const int s = it >> 4, h = (it >> 1) & 7, dir = it & 1; scan_item(a, lds, TCTX + 1024 * s, 1024, s, h, dir, false, 0); }
    else if (it < 384) { const int j = it - 128, s = j >> 4, h = (j >> 1) & 7, dir = j & 1; scan_item(a, lds, 256 * s, 256, 0, h, dir, true, s); }
    else { const int j = it - 384; mixb_item(a, lds, j >> 2, j & 3); }
}
__device__ __forceinline__ void phase_mixers(const Args& a, LAS unsigned char* lds, int vcu, int G) {
    if (G == 256) {
        const int j = vcu - 128, n = vcu < 128 ? 1 : 5;
        for (int q = 0; q < n; ++q) { const int it = vcu < 128 ? vcu : (q < 2 ? 128 + 2 * j + q : 384 + 3 * j + (q - 2)); mixer_work(a, lds, it); }
    } else { for (int it = vcu; it < 768; it += G) mixer_work(a, lds, it); }
}
__device__ __forceinline__ void phase_finalize_a(const Args& a, int vcu, int G) {
    const int lane = threadIdx.x & 63, wave = __builtin_amdgcn_readfirstlane(threadIdx.x >> 6);
    const int gw = vcu * 8 + wave, NGW = G * 8;
    unsigned char* ws = a.ws;
    const float* OF = (const float*)(ws + WS_OF); const float* OB = (const float*)(ws + WS_OB); const bf16_t* GA = (const bf16_t*)(ws + WS_GA); bf16_t* CAT = (bf16_t*)(ws + WS_CAT);
    const int col = (lane >> 3) * 128 + (lane & 7) * 16, vc = (lane & 7) * 16;
    f32x4 gn[4];
#pragma unroll
    for (int j = 0; j < 4; ++j) gn[j] = *(const f32x4*)(a.in[10] + vc + 4 * j);
    for (int row = gw; row < T; row += NGW) {
        f32x4 v[4]; float ss = 0.f;
#pragma unroll
        for (int j = 0; j < 4; ++j) { v[j] = *(const f32x4*)(OF + (size_t)row * 1024 + col + 4 * j) + *(const f32x4*)(OB + (size_t)row * 1024 + col + 4 * j); ss += (v[j][0] * v[j][0] + v[j][1] * v[j][1]) + (v[j][2] * v[j][2] + v[j][3] * v[j][3]); }
        ss += __shfl_xor(ss, 1); ss += __shfl_xor(ss, 2); ss += __shfl_xor(ss, 4);
        const float rstd = rsqrtf(ss * (1.0f / 128.0f) + 1e-6f);
        const u32x4 g0 = *(const u32x4*)(GA + (size_t)row * 1024 + col), g1 = *(const u32x4*)(GA + (size_t)row * 1024 + col + 8);
        u32x4 o0, o1;
#pragma unroll
        for (int e = 0; e < 4; ++e) {
            const int j = e >> 1, k = (e & 1) * 2;
            o0[e] = pk2(v[j][k] * rstd * gn[j][k] * bflo(g0[e]), v[j][k + 1] * rstd * gn[j][k + 1] * bfhi(g0[e]));
            o1[e] = pk2(v[2 + j][k] * rstd * gn[2 + j][k] * bflo(g1[e]), v[2 + j][k + 1] * rstd * gn[2 + j][k + 1] * bfhi(g1[e]));
        }
        *(u32x4*)(CAT + (size_t)row * D + col) = o0; *(u32x4*)(CAT + (size_t)row * D + col + 8) = o1;
    }
}


#define XB_TMO      128
#define XB_XCNT(j)  (256  + 64 * (j))
#define XB_XSUB(j)  (1280 + 64 * (j))
#define XB_XGEN(j)  (2304 + 64 * (j))
#define XB_TOP      3328
#define XB_TOPGEN   3392
#define XCD_BAR_WORDS 3456
#define XB_SPIN_CAP (1u << 18)
__device__ __forceinline__ unsigned xb_ld(unsigned* p)              { return __hip_atomic_load(p, __ATOMIC_RELAXED, __HIP_MEMORY_SCOPE_AGENT); }
__device__ __forceinline__ unsigned xb_add(unsigned* p, unsigned v) { return __hip_atomic_fetch_add(p, v, __ATOMIC_RELAXED, __HIP_MEMORY_SCOPE_AGENT); }
__device__ __forceinline__ unsigned xb_xcc_id() { return (unsigned)__builtin_amdgcn_s_getreg((3 << 11) | 20) & 0xFu; }
#define XB_SPIN(cond, bar) do { unsigned _sp = 0; while (cond) { __builtin_amdgcn_s_sleep(1); \
    if ((++_sp & 255u) == 0u) { if (xb_ld(&(bar)[XB_TMO])) break; if (_sp > XB_SPIN_CAP) { atomicAdd(&(bar)[XB_TMO], 1u); break; } } } } while (0)
struct XcdBarrier { unsigned* bar; unsigned x; volatile LAS unsigned* st; };
__device__ __forceinline__ XcdBarrier xcd_barrier_post(unsigned* bar, volatile LAS unsigned* st) {
    XcdBarrier b; b.bar = bar; b.x = xb_xcc_id(); b.st = st;
    if (threadIdx.x == 0) (void)xb_add(&bar[XB_XCNT(b.x)], 1u);
    return b;
}
__device__ __forceinline__ void xcd_barrier_complete(unsigned* bar, unsigned x, unsigned& nloc, unsigned& nx) {
    const unsigned G = gridDim.x * gridDim.y * gridDim.z;
    unsigned sum, cnt, mine, sp = 0u;
    for (;;) {
        sum = 0u; cnt = 0u; mine = 0u;
#pragma unroll
        for (unsigned j = 0; j < 16; ++j) { const unsigned c = xb_ld(&bar[XB_XCNT(j)]); sum += c; cnt += (c > 0u) ? 1u : 0u; mine = (j == x) ? c : mine; }
        if (sum == G) break;
        __builtin_amdgcn_s_sleep(1);
        if ((++sp & 255u) == 0u) { if (xb_ld(&bar[XB_TMO])) break; if (sp > XB_SPIN_CAP) { atomicAdd(&bar[XB_TMO], 1u); break; } }
    }
    nloc = mine > 0u ? mine : 1u; nx = cnt > 0u ? cnt : 1u;
}
__device__ __forceinline__ void xcd_barrier(const XcdBarrier& b) {
    asm volatile("s_waitcnt vmcnt(0)" ::: "memory");
    __syncthreads();
    if (threadIdx.x == 0) {
        unsigned* bar = b.bar;
        __builtin_amdgcn_s_waitcnt(0);
        unsigned nloc = b.st[0], nx = b.st[1];
        if (nloc == 0u) { xcd_barrier_complete(bar, b.x, nloc, nx); b.st[0] = nloc; b.st[1] = nx; }
        const unsigned old = xb_add(&bar[XB_XSUB(b.x)], 1u);
        const unsigned gen = old / nloc;
        if (old + 1u == (gen + 1u) * nloc) {
            __builtin_amdgcn_fence(__ATOMIC_RELEASE, "agent");
            asm volatile("s_waitcnt vmcnt(0)" ::: "memory");
            const unsigned og = xb_add(&bar[XB_TOP], 1u);
            const unsigned tg = og / nx;
            if (og + 1u == (tg + 1u) * nx) xb_add(&bar[XB_TOPGEN], 1u);
            else XB_SPIN(xb_ld(&bar[XB_TOPGEN]) == tg, bar);
            __builtin_amdgcn_fence(__ATOMIC_ACQUIRE, "agent");
            xb_add(&bar[XB_XGEN(b.x)], 1u);
            asm volatile("s_waitcnt vmcnt(0)" ::: "memory");
        } else {
            XB_SPIN(xb_ld(&bar[XB_XGEN(b.x)]) == gen, bar);
            __builtin_amdgcn_fence(__ATOMIC_ACQUIRE, "agent");
            asm volatile("s_waitcnt vmcnt(0)" ::: "memory");
        }
    }
    __syncthreads();
}

#ifndef PG8_SP2
#define PG8_SP2 false
#endif
__global__ void __launch_bounds__(NT, 2) mk_fwd(Args a) {
    extern __shared__ __attribute__((aligned(16))) unsigned char lds_raw[];
    LAS unsigned char* lds = (LAS unsigned char*)lds_raw;
    cg::grid_group grid = cg::this_grid();
    const int G = gridDim.x, bx = blockIdx.x;
    const int vcu = (G % 8 == 0) ? (bx % 8) * (G / 8) + bx / 8 : bx;
    unsigned char* ws = a.ws;
    const int lo = a.ph_lo, hi = a.ph_hi;
    if (threadIdx.x < 16) ((LAS unsigned*)(lds + LDS_MISC))[threadIdx.x] = 0u;
    __syncthreads();
    (void)xcd_barrier_post((unsigned*)(ws + WS_CTL), (volatile LAS unsigned*)(lds + LDS_MISC));
    if (lo == -12345) grid.sync();
    float* X = a.out;
    const float* MOD0 = (const float*)(ws + WS_MOD); const float* MOD1 = MOD0 + 9 * 12288;
    bf16_t* Hb = (bf16_t*)(ws + WS_H); bf16_t* CAT = (bf16_t*)(ws + WS_CAT); bf16_t* ACT = (bf16_t*)(ws + WS_ACT); bf16_t* PQT = (bf16_t*)(ws + WS_PQT);
#ifndef PHMASK
#define PHMASK 0x1FFFF
#endif
#define IN(k) (((PHMASK >> (k)) & 1) && lo <= (k) && (k) < hi)
#ifndef REPMASK
#define REPMASK 0
#endif
#ifndef REPN
#define REPN 2
#endif
#define REPS(k) for (int rep_ = 0; rep_ < (((REPMASK >> (k)) & 1) ? REPN : 1); ++rep_)
#define SEAM(k) do { if (IN(k) && IN((k) + 1)) { XcdBarrier b_; b_.bar = (unsigned*)(a.ws + WS_CTL); b_.x = xb_xcc_id(); b_.st = (volatile LAS unsigned*)(lds + LDS_MISC); xcd_barrier(b_); } } while (0)

    if (IN(0)) REPS(0) phase_prologue(a, lds, vcu, G);
    SEAM(0);
    if (IN(1)) REPS(1) phase_norm_mod(a.in[0], a.in[1], a.in[7], MOD0, MOD0 + D, Hb, vcu, G);
    SEAM(1);
    if (IN(2)) {
        SchedDense S{48, INW / 256, G, bx, (const char*)Hb, (const char*)(ws + WS_WIN), (size_t)256 * D * 2, (size_t)256 * D * 2, ((REPMASK >> 2) & 1) ? REPN : 1};
        EpiInProj E{(bf16_t*)(ws + WS_Q), (bf16_t*)(ws + WS_V), (bf16_t*)(ws + WS_GA), (bf16_t*)(ws + WS_U), (bf16_t*)(ws + WS_VV), (float*)(ws + WS_LF), a.in[9]};
        pg8::gemm_phase<EpiInProj, SchedDense, PG8_SP2, 0>(lds, D, D, D / 64, (size_t)128 * D * 2, (size_t)128 * D * 2, S, E);
    }
    SEAM(2);
    if (IN(3)) REPS(3) phase_mixers(a, lds, vcu, G);
    SEAM(3);
    if (IN(4)) REPS(4) phase_finalize_a(a, vcu, G);
    SEAM(4);
    if (IN(5)) {
        SchedDense S{48, 8, G, bx, (const char*)CAT, (const char*)(ws + WS_WOUT0), (size_t)256 * D * 2, (size_t)256 * D * 2, ((REPMASK >> 5) & 1) ? REPN : 1};
        EpiResid E{a.in[0], a.in[1], X, MOD0 + 2 * D};
        pg8::gemm_phase<EpiResid, SchedDense, PG8_SP2, 0>(lds, D, D, D / 64, (size_t)128 * D * 2, (size_t)128 * D * 2, S, E);
    }
    SEAM(5);
    if (IN(6)) REPS(6) phase_norm_mod(X, X + (size_t)TCTX * D, a.in[15], MOD0 + 3 * D, MOD0 + 4 * D, Hb, vcu, G);
    SEAM(6);
    if (IN(7)) {
        SchedDense S{48, DFF / 128, G, bx, (const char*)Hb, (const char*)(ws + WS_WUP0), (size_t)256 * D * 2, (size_t)256 * D * 2, ((REPMASK >> 7) & 1) ? REPN : 1};
        EpiConv E{ACT, a.in[17], a.in[18], (LAS float*)(lds + LDS_XCH)};
        pg8::gemm_phase<EpiConv, SchedDense, PG8_SP2, 1>(lds, D, D, D / 64, (size_t)4 * D * 2, (size_t)128 * D * 2, S, E);
    }
    SEAM(7);
    if (IN(8)) {
        SchedDense S{48, 8, G, bx, (const char*)ACT, (const char*)(ws + WS_WDN0), (size_t)256 * DFF * 2, (size_t)256 * DFF * 2, ((REPMASK >> 8) & 1) ? REPN : 1};
        EpiResid E{X, X + (size_t)TCTX * D, X, MOD0 + 5 * D};
        pg8::gemm_phase<EpiResid, SchedDense, PG8_SP2, 0>(lds, DFF, DFF, DFF / 64, (size_t)128 * DFF * 2, (size_t)128 * DFF * 2, S, E);
    }
    SEAM(8);
    if (IN(9)) REPS(9) phase_norm_mod(X, X + (size_t)TCTX * D, a.in[22], MOD1, MOD1 + D, Hb, vcu, G);
    SEAM(9);
    if (IN(10)) REPS(10) {
        SchedF1 S{G, bx, (const char*)(ws + WS_DFTC), (const char*)Hb};
        EpiF1 E{PQT};
        pg8::gemm_phase<EpiF1, SchedF1, PG8_SP2, 0>(lds, 512, D, 8, (size_t)128 * 512 * 2, (size_t)128 * D * 2, S, E);
    }
    SEAM(10);
    if (IN(11)) REPS(11) {
        { SchedF2 S{G, bx, 1, (const char*)(ws + WS_DFT1024), (const char*)PQT}; EpiBf16 E{CAT, D};
          pg8::gemm_phase<EpiBf16, SchedF2, PG8_SP2, 0>(lds, 2048, 2 * T, 32, (size_t)128 * 2048 * 2, (size_t)128 * 2 * T * 2, S, E); }
        { SchedF2 S{G, bx, 0, (const char*)(ws + WS_DFT256), (const char*)PQT}; EpiBf16 E{CAT, D};
          pg8::gemm_phase<EpiBf16, SchedF2, PG8_SP2, 0>(lds, 512, 2 * T, 8, (size_t)128 * 512 * 2, (size_t)128 * 2 * T * 2, S, E); }
    }
    SEAM(11);
    if (IN(12)) {
        SchedDense S{48, 8, G, bx, (const char*)CAT, (const char*)(ws + WS_WOUT1), (size_t)256 * D * 2, (size_t)256 * D * 2, ((REPMASK >> 12) & 1) ? REPN : 1};
        EpiResid E{X, X + (size_t)TCTX * D, X, MOD1 + 2 * D};
        pg8::gemm_phase<EpiResid, SchedDense, PG8_SP2, 0>(lds, D, D, D / 64, (size_t)128 * D * 2, (size_t)128 * D * 2, S, E);
    }
    SEAM(12);
    if (IN(13)) REPS(13) phase_norm_mod(X, X + (size_t)TCTX * D, a.in[24], MOD1 + 3 * D, MOD1 + 4 * D, Hb, vcu, G);
    SEAM(13);
    if (IN(14)) {
        SchedDense S{48, DFF / 128, G, bx, (const char*)Hb, (const char*)(ws + WS_WUP1), (size_t)256 * D * 2, (size_t)256 * D * 2, ((REPMASK >> 14) & 1) ? REPN : 1};
        EpiConv E{ACT, a.in[26], a.in[27], (LAS float*)(lds + LDS_XCH)};
        pg8::gemm_phase<EpiConv, SchedDense, PG8_SP2, 1>(lds, D, D, D / 64, (size_t)4 * D * 2, (size_t)128 * D * 2, S, E);
    }
    SEAM(14);
    if (IN(15)) {
        SchedDense S{48, 8, G, bx, (const char*)ACT, (const char*)(ws + WS_WDN1), (size_t)256 * DFF * 2, (size_t)256 * DFF * 2, ((REPMASK >> 15) & 1) ? REPN : 1};
        EpiResid E{X, X + (size_t)TCTX * D, X, MOD1 + 5 * D};
        pg8::gemm_phase<EpiResid, SchedDense, PG8_SP2, 0>(lds, DFF, DFF, DFF / 64, (size_t)128 * DFF * 2, (size_t)128 * DFF * 2, S, E);
    }
    SEAM(15);
    if (IN(16)) REPS(16) phase_final_norm(X, a.in[29], vcu, G);
#undef IN
#undef SEAM
}

extern "C" void kernel_launch(void* const* d_in, const int* in_sizes, int n_in, void* d_out, int out_size, void* d_ws, size_t ws_size, hipStream_t stream) {
    static int grid = 0;
    if (grid == 0) {
        if (n_in != 30 || ws_size < WS_END) { fprintf(stderr, "kernel_launch: need 30 inputs and %zu bytes of workspace (got %d, %zu)\n", (size_t)WS_END, n_in, ws_size); grid = -1; return; }
        int dev = 0, cus = 0, per_cu = 0;
        if (hipGetDevice(&dev) != hipSuccess || hipDeviceGetAttribute(&cus, hipDeviceAttributeMultiprocessorCount, dev) != hipSuccess) { grid = -1; return; }
        if (hipFuncSetAttribute((const void*)mk_fwd, hipFuncAttributeMaxDynamicSharedMemorySize, LDS_BYTES) != hipSuccess) { fprintf(stderr, "kernel_launch: hipFuncSetAttribute failed\n"); grid = -1; return; }
        if (hipOccupancyMaxActiveBlocksPerMultiprocessor(&per_cu, (const void*)mk_fwd, NT, LDS_BYTES) != hipSuccess || per_cu < 1) { fprintf(stderr, "kernel_launch: occupancy query says %d blocks per CU\n", per_cu); grid = -1; return; }
        grid = cus;
    }
    if (grid < 0) return;
    if (hipMemsetAsync((char*)d_ws + WS_CTL, 0, 65536, stream) != hipSuccess) { fprintf(stderr, "kernel_launch: hipMemsetAsync failed\n"); return; }
    Args a{};
    for (int i = 0; i < 30; ++i) a.in[i] = (const float*)d_in[i];
    a.out = (float*)d_out; a.ws = (unsigned char*)d_ws;
#if MK_FUSED
    a.ph_lo = 0; a.ph_hi = NPH;
    void* args[] = {&a};
    hipError_t e = hipLaunchCooperativeKernel((const void*)mk_fwd, dim3(grid), dim3(NT), args, LDS_BYTES, stream);
    if (e != hipSuccess) fprintf(stderr, "cooperative launch failed: %s (grid %d)\n", hipGetErrorString(e), grid);
#else
    for (int p = 0; p < NPH; ++p) {
        a.ph_lo = p; a.ph_hi = p + 1;
        void* args[] = {&a};
        hipError_t e = hipLaunchCooperativeKernel((const void*)mk_fwd, dim3(grid), dim3(NT), args, LDS_BYTES, stream);
        if (e != hipSuccess) { fprintf(stderr, "launch %d failed: %s (grid %d)\n", p, hipGetErrorString(e), grid); break; }
    }
#endif
}
```

```cpp
#include <hip/hip_runtime.h>
#include <hip/hip_cooperative_groups.h>
#include <cstdio>
#include <cstdint>
namespace cg = cooperative_groups;

#ifndef MK_FUSED
#define MK_FUSED 1
#endif

#define LAS __attribute__((address_space(3)))
typedef unsigned short bf16_t;
typedef short bf16x8 __attribute__((ext_vector_type(8)));
typedef float f32x4 __attribute__((ext_vector_type(4)));
typedef float f32x2 __attribute__((ext_vector_type(2)));
typedef unsigned u32x4 __attribute__((ext_vector_type(4)));
typedef unsigned u32x2 __attribute__((ext_vector_type(2)));

constexpr int D = 2048, T = 12288, TCTX = 4096;
constexpr int DFF = 5632, DFF2 = 11264, INW = 7168, AW = 1024;
constexpr int NPH = 17;
constexpr int NT = 512;

constexpr size_t WS_CTL = 0;
constexpr size_t WS_MOD = 65536;
constexpr size_t WS_WIN = WS_MOD + (size_t)2 * 9 * 12288 * 4;
constexpr size_t WS_WOUT0 = WS_WIN + (size_t)INW * D * 2;
constexpr size_t WS_WUP0 = WS_WOUT0 + (size_t)D * D * 2;
constexpr size_t WS_WDN0 = WS_WUP0 + (size_t)DFF2 * D * 2;
constexpr size_t WS_WOUT1 = WS_WDN0 + (size_t)D * DFF * 2;
constexpr size_t WS_WUP1 = WS_WOUT1 + (size_t)D * D * 2;
constexpr size_t WS_WDN1 = WS_WUP1 + (size_t)DFF2 * D * 2;
constexpr size_t WS_DFTC = WS_WDN1 + (size_t)D * DFF * 2;
constexpr size_t WS_DFT256 = WS_DFTC + (size_t)1024 * 512 * 2;
constexpr size_t WS_DFT1024 = WS_DFT256 + (size_t)256 * 512 * 2;
constexpr size_t WS_H = WS_DFT1024 + (size_t)1024 * 2048 * 2;
constexpr size_t WS_CAT = WS_H + (size_t)T * D * 2;
constexpr size_t WS_R1 = WS_CAT + (size_t)T * D * 2;
constexpr size_t WS_Q = WS_R1;
constexpr size_t WS_V = WS_Q + (size_t)T * AW * 2;
constexpr size_t WS_GA = WS_V + (size_t)T * AW * 2;
constexpr size_t WS_U = WS_GA + (size_t)T * AW * 2;
constexpr size_t WS_VV = WS_U + (size_t)T * AW * 2;
constexpr size_t WS_LF = WS_VV + (size_t)T * AW * 2;
constexpr size_t WS_OF = WS_LF + (size_t)T * 2048 * 4;
constexpr size_t WS_OB = WS_OF + (size_t)T * AW * 4;
constexpr size_t WS_R1_END = WS_OB + (size_t)T * AW * 4;
constexpr size_t WS_ACT = WS_R1;
constexpr size_t WS_PQT = WS_R1;
constexpr size_t WS_END = WS_R1_END;
static_assert(WS_ACT + (size_t)T * DFF * 2 <= WS_R1_END && WS_PQT + (size_t)2048 * 2 * T * 2 <= WS_R1_END, "aliases fit");

constexpr int LDS_BYTES = 147456;
constexpr int LDS_XCH = 131072;
constexpr int LDS_MISC = 131072 + 8192;

__device__ __forceinline__ unsigned f2bf(float f) { unsigned u = __builtin_bit_cast(unsigned, f); return (u + 0x7fffu + ((u >> 16) & 1u)) >> 16; }
__device__ __forceinline__ unsigned pk2(float lo, float hi) { unsigned r; asm("v_cvt_pk_bf16_f32 %0, %1, %2" : "=v"(r) : "v"(lo), "v"(hi)); return r; }
__device__ __forceinline__ float bflo(unsigned w) { return __builtin_bit_cast(float, w << 16); }
__device__ __forceinline__ float bfhi(unsigned w) { return __builtin_bit_cast(float, w & 0xffff0000u); }
__device__ __forceinline__ float bf2f(bf16_t b) { return __builtin_bit_cast(float, (unsigned)b << 16); }
__device__ __forceinline__ float wave_sum(float v) {
#pragma unroll
    for (int o = 1; o < 64; o <<= 1) v += __shfl_xor(v, o);
    return v;
}
__device__ __forceinline__ float fast_sigmoid(float x) { return __builtin_amdgcn_rcpf(1.0f + __expf(-x)); }
__device__ __forceinline__ float silu_f(float x) { return x * fast_sigmoid(x); }
__device__ __forceinline__ float gelu_tanh_f(float x) { const float u = 1.5957691216057308f * (x + 0.044715f * x * x * x); return x * fast_sigmoid(u); }
__device__ __forceinline__ int row_bi(int pm) { return pm < 16 ? 0 : 1 + ((pm - 16) >> 2); }
#define LDS_WAIT() asm volatile("s_waitcnt lgkmcnt(0)" ::: "memory")

namespace pg8 {
constexpr int BM = 256, BK = 64, HALF = 128, HTB = HALF * BK * 2, NXCD = 8, WGM = 8;
__device__ __forceinline__ int lds_byte(int r, int c) { const int st = (r >> 4) * 2 + (c >> 5), rr = r & 15, cc = c & 31, ob = rr * 64 + cc * 2; return st * 1024 + (ob ^ (((ob >> 9) & 1) << 5)); }
__device__ __forceinline__ void stage_rc(int b, int& R, int& C) { const int st = b / 1024, sb = b % 1024, swz = sb ^ (((sb >> 9) & 1) << 5); R = (st >> 1) * 16 + swz / 64; C = (st & 1) * 32 + (swz % 64) / 2; }
__device__ __forceinline__ int perm32(int rho) { const int n = rho >> 4, i = rho & 15; return 8 * (i >> 2) + 4 * n + (i & 3); }
__device__ __forceinline__ int permA_conv(int R) { return 8 * (16 * (R >> 6) + (R & 15)) + ((R >> 4) & 3); }

struct Unit { const char* A; const char* B; int e0, e1, e2, e3; };

__device__ __forceinline__ void tile_order(int L, int nM, int nN, int& pm, int& pn) {
    const int nwg = nM * nN; int wgid = L;
    { const int q = nwg / NXCD, r = nwg % NXCD, xcd = wgid % NXCD, off = wgid / NXCD; wgid = (xcd < r ? xcd * (q + 1) : r * (q + 1) + (xcd - r) * q) + off; }
    const int nig = WGM * nN, gid = wgid / nig, fm = gid * WGM, gsz = (nM - fm) < WGM ? (nM - fm) : WGM;
    pm = fm + ((wgid % nig) % gsz); pn = (wgid % nig) / gsz;
}

template <class Epi, class Sched, bool SP2, int PERMA>
__device__ __forceinline__ void gemm_phase(LAS unsigned char* lds, const int lda, const int ldb, const int nt, const size_t hstepA, const size_t hstepB, const Sched& S, const Epi& E) {
    const int tid = threadIdx.x, wid = __builtin_amdgcn_readfirstlane(tid >> 6), lane = tid & 63, wr = wid >> 2, wc = wid & 3, fr = lane & 15, fq = lane >> 4;
    unsigned voffA[2], voffB[2];
#pragma unroll
    for (int i = 0; i < 2; ++i) { int R, C; stage_rc(tid * 16 + i * 8192, R, C); const int Ra = PERMA ? permA_conv(R) : R; const int Rb = (R & ~31) + perm32(R & 31);
        voffA[i] = (unsigned)(Ra * lda + C) * 2u; voffB[i] = (unsigned)(Rb * ldb + C) * 2u; }
    const size_t kstep = (size_t)(BK * 2);
    const unsigned ldsw = (unsigned)wid * 1024u;
    const int aoff = lds_byte(wr * 64 + fr, fq * 8), boff = lds_byte(wc * 32 + fr, fq * 8);
#define PG8_SA(b, h) (((b) * 2 + (h)) * HTB)
#define PG8_SB(b, h) ((4 + (b) * 2 + (h)) * HTB)
#define PG8_STAGE(bufoff, gbase, voff) do { _Pragma("unroll") for (int _i = 0; _i < 2; ++_i) \
        __builtin_amdgcn_global_load_lds((const unsigned*)((const char*)(gbase) + (voff)[_i]), (LAS unsigned*)(lds + (bufoff) + ldsw + _i * 8192), 16, 0, 0); } while (0)
#define PG8_LDA(dst, b, h) do { _Pragma("unroll") for (int m = 0; m < 4; ++m) _Pragma("unroll") for (int k = 0; k < 2; ++k) dst[m][k] = *(const LAS bf16x8*)(lds + PG8_SA(b, h) + aoff + m * 2048 + k * 1024); } while (0)
#define PG8_LDB(dst, b, h) do { _Pragma("unroll") for (int n = 0; n < 2; ++n) _Pragma("unroll") for (int k = 0; k < 2; ++k) dst[n][k] = *(const LAS bf16x8*)(lds + PG8_SB(b, h) + boff + n * 2048 + k * 1024); } while (0)
#define PG8_MMA(ai, bj, At, Bt) do { __builtin_amdgcn_s_setprio(1); _Pragma("unroll") for (int m = 0; m < 4; ++m) _Pragma("unroll") for (int n = 0; n < 2; ++n) _Pragma("unroll") for (int k = 0; k < 2; ++k) \
        acc[ai][bj][m][n] = __builtin_amdgcn_mfma_f32_16x16x32_bf16(Bt[n][k], At[m][k], acc[ai][bj][m][n], 0, 0, 0); __builtin_amdgcn_s_setprio(0); } while (0)
#define PG8_WAIT_V(n) asm volatile("s_waitcnt vmcnt(" #n ")" ::: "memory")
#define PG8_WAIT_L(n) asm volatile("s_waitcnt lgkmcnt(" #n ")" ::: "memory")
#define PG8_BAR __builtin_amdgcn_s_barrier()
#define PG8_SCHED __builtin_amdgcn_sched_barrier(0)
    Unit cur, nxt; int ui = 0;
    if (!S.next(0, cur)) return;
    f32x4 acc[2][2][4][2];
#pragma unroll
    for (int a = 0; a < 2; ++a)
#pragma unroll
        for (int b = 0; b < 2; ++b)
#pragma unroll
            for (int m = 0; m < 4; ++m)
#pragma unroll
                for (int n = 0; n < 2; ++n) acc[a][b][m][n] = (f32x4){0.f, 0.f, 0.f, 0.f};
    bf16x8 At[4][2], B0[2][2], B1[2][2];
    const char* cA = cur.A; const char* cB = cur.B;
    if constexpr (SP2) {
        PG8_STAGE(PG8_SB(0, 0), cB, voffB); PG8_STAGE(PG8_SB(0, 1), cB + hstepB, voffB); PG8_STAGE(PG8_SA(0, 0), cA, voffA); PG8_STAGE(PG8_SA(0, 1), cA + hstepA, voffA);
        if (wr == 1) PG8_BAR;
        PG8_WAIT_V(2); PG8_BAR;
        PG8_STAGE(PG8_SB(1, 0), cB + kstep, voffB); PG8_STAGE(PG8_SA(1, 0), cA + kstep, voffA); PG8_STAGE(PG8_SB(1, 1), cB + hstepB + kstep, voffB);
        PG8_WAIT_V(6); PG8_BAR;
    } else {
        PG8_STAGE(PG8_SB(0, 0), cB, voffB); PG8_STAGE(PG8_SA(0, 0), cA, voffA); PG8_STAGE(PG8_SB(0, 1), cB + hstepB, voffB); PG8_STAGE(PG8_SA(0, 1), cA + hstepA, voffA);
        if (wr == 1) PG8_BAR;
        PG8_WAIT_V(4); PG8_BAR;
        PG8_STAGE(PG8_SB(1, 0), cB + kstep, voffB); PG8_STAGE(PG8_SA(1, 0), cA + kstep, voffA); PG8_STAGE(PG8_SB(1, 1), cB + hstepB + kstep, voffB);
        PG8_WAIT_V(6); PG8_BAR;
    }
    for (;;) {
        const bool has_next = S.next(ui + 1, nxt);
        const char* nA = has_next ? nxt.A : cA; const char* nB = has_next ? nxt.B : cB;
        for (int t = 0; t < nt; t += 2) {
            const bool last = (t == nt - 2);
            const char* a1 = cA + (size_t)(t + 1) * kstep;
            const char* a2 = last ? nA : cA + (size_t)(t + 2) * kstep; const char* b2 = last ? nB : cB + (size_t)(t + 2) * kstep;
            const char* a3 = a2 + kstep; const char* b3 = b2 + kstep;
            if constexpr (SP2) {
            PG8_LDB(B0, 0, 0); PG8_LDB(B1, 0, 1); PG8_SCHED; PG8_LDA(At, 0, 0); PG8_STAGE(PG8_SA(1, 1), a1 + hstepA, voffA);
            PG8_WAIT_V(8); PG8_WAIT_L(0); PG8_BAR; PG8_MMA(0, 0, At, B0); PG8_MMA(0, 1, At, B1); PG8_BAR; PG8_SCHED;
            PG8_LDA(At, 0, 1); PG8_STAGE(PG8_SB(0, 0), b2, voffB); PG8_STAGE(PG8_SB(0, 1), b2 + hstepB, voffB); PG8_STAGE(PG8_SA(0, 0), a2, voffA);
            PG8_WAIT_V(8); PG8_WAIT_L(0); PG8_BAR; PG8_MMA(1, 0, At, B0); PG8_MMA(1, 1, At, B1); PG8_BAR; PG8_SCHED;
            PG8_LDB(B0, 1, 0); PG8_LDB(B1, 1, 1); PG8_SCHED; PG8_LDA(At, 1, 0); PG8_STAGE(PG8_SA(0, 1), a2 + hstepA, voffA);
            PG8_WAIT_V(8); PG8_WAIT_L(0); PG8_BAR; PG8_MMA(0, 0, At, B0); PG8_MMA(0, 1, At, B1); PG8_BAR; PG8_SCHED;
            PG8_LDA(At, 1, 1); PG8_STAGE(PG8_SB(1, 0), b3, voffB); PG8_STAGE(PG8_SB(1, 1), b3 + hstepB, voffB); PG8_STAGE(PG8_SA(1, 0), a3, voffA);
            PG8_WAIT_V(8); PG8_WAIT_L(0); PG8_BAR; PG8_MMA(1, 0, At, B0); PG8_MMA(1, 1, At, B1); PG8_BAR; PG8_SCHED;
            } else {
            PG8_LDB(B0, 0, 0); PG8_SCHED; PG8_LDA(At, 0, 0); PG8_STAGE(PG8_SA(1, 1), a1 + hstepA, voffA);
            PG8_WAIT_L(8); PG8_BAR; PG8_WAIT_L(0); PG8_MMA(0, 0, At, B0); PG8_BAR; PG8_SCHED;
            PG8_LDB(B1, 0, 1); PG8_STAGE(PG8_SB(0, 0), b2, voffB);
            PG8_BAR; PG8_WAIT_L(0); PG8_MMA(0, 1, At, B1); PG8_BAR;
            PG8_LDA(At, 0, 1); PG8_STAGE(PG8_SA(0, 0), a2, voffA);
            PG8_BAR; PG8_WAIT_L(0); PG8_MMA(1, 0, At, B0); PG8_BAR; PG8_SCHED;
            PG8_STAGE(PG8_SB(0, 1), b2 + hstepB, voffB);
            PG8_WAIT_V(6); PG8_BAR; PG8_MMA(1, 1, At, B1); PG8_BAR;
            PG8_LDB(B0, 1, 0); PG8_SCHED; PG8_LDA(At, 1, 0); PG8_STAGE(PG8_SA(0, 1), a2 + hstepA, voffA);
            PG8_WAIT_L(8); PG8_BAR; PG8_WAIT_L(0); PG8_MMA(0, 0, At, B0); PG8_BAR; PG8_SCHED;
            PG8_LDB(B1, 1, 1); PG8_STAGE(PG8_SB(1, 0), b3, voffB);
            PG8_BAR; PG8_WAIT_L(0); PG8_MMA(0, 1, At, B1); PG8_BAR;
            PG8_LDA(At, 1, 1); PG8_STAGE(PG8_SA(1, 0), a3, voffA);
            PG8_BAR; PG8_WAIT_L(0); PG8_MMA(1, 0, At, B0); PG8_BAR; PG8_SCHED;
            PG8_STAGE(PG8_SB(1, 1), b3 + hstepB, voffB);
            PG8_WAIT_V(6); PG8_BAR; PG8_MMA(1, 1, At, B1); PG8_BAR;
            }
        }
        if (wr == 0) PG8_BAR;
        E(acc, cur, wr, wc, fr, fq);
        if (!has_next) break;
#pragma unroll
        for (int a = 0; a < 2; ++a)
#pragma unroll
            for (int b = 0; b < 2; ++b)
#pragma unroll
                for (int m = 0; m < 4; ++m)
#pragma unroll
                    for (int n = 0; n < 2; ++n) acc[a][b][m][n] = (f32x4){0.f, 0.f, 0.f, 0.f};
        cur = nxt; cA = nA; cB = nB; ++ui;
        if (wr == 1) PG8_BAR;
    }
    PG8_WAIT_V(0);
    PG8_BAR;
#undef PG8_SA
#undef PG8_SB
#undef PG8_STAGE
#undef PG8_LDA
#undef PG8_LDB
#undef PG8_MMA
#undef PG8_WAIT_V
#undef PG8_WAIT_L
#undef PG8_BAR
#undef PG8_SCHED
}
}
using pg8::Unit;
typedef f32x4 Acc[2][2][4][2];

struct SchedDense {
    int nM, nN, G, c; const char* A; const char* B; size_t astep, bstep; int reps;
    __device__ __forceinline__ bool next(int i, Unit& u) const {
        long L = (long)i * G + c; if (L >= (long)reps * nM * nN) return false; L %= (long)nM * nN;
        int pm, pn; pg8::tile_order((int)L, nM, nN, pm, pn);
        u.A = A + (size_t)pm * astep; u.B = B + (size_t)pn * bstep; u.e0 = pm; u.e1 = pn; u.e2 = 0; u.e3 = 0; return true;
    }
};
struct SchedF1 {
    int G, c; const char* A; const char* B;
    __device__ __forceinline__ bool next(int i, Unit& u) const {
        const long L = (long)i * G + c; if (L >= 16 * 48) return false;
        int pmm, pn; pg8::tile_order((int)L, 16, 48, pmm, pn);
        const int g = pmm >> 2, pmd = pmm & 3;
        u.A = A + (size_t)pmd * 256 * 512 * 2; u.B = B + ((size_t)pn * 256 * D + (size_t)g * 512) * 2; u.e0 = pmd; u.e1 = pn; u.e2 = g; u.e3 = 0; return true;
    }
};
struct SchedF2 {
    int G, c, smp; const char* A; const char* B;
    __device__ __forceinline__ bool next(int i, Unit& u) const {
        const long L = (long)i * G + c;
        if (smp) { if (L >= 256) return false; const int l = (int)L, pn2 = l & 1, pm = (l >> 1) & 3, g = (l >> 3) & 3, s = l >> 5;
            u.A = A + (size_t)pm * 256 * 2048 * 2; u.B = B + (((size_t)(g * 512 + pn2 * 256)) * (2 * T) + 2 * (size_t)(TCTX + 1024 * s)) * 2;
            u.e0 = (TCTX + 1024 * s + 256 * pm) >> 8; u.e1 = g * 2 + pn2; u.e2 = 0; u.e3 = 0; return true; }
        if (L >= 128) return false; const int l = (int)L, pn2 = l & 1, g = (l >> 1) & 3, s = l >> 3;
        u.A = A; u.B = B + (((size_t)(g * 512 + pn2 * 256)) * (2 * T) + 2 * (size_t)(256 * s)) * 2;
        u.e0 = s; u.e1 = g * 2 + pn2; u.e2 = 0; u.e3 = 0; return true;
    }
};

struct EpiInProj {
    bf16_t *Q, *V, *GA, *U, *VV; float* LF; const float* lbraw;
    __device__ __forceinline__ void operator()(Acc& acc, const Unit& u, int wr, int wc, int fr, int fq) const {
        const int pm = u.e0, pn = u.e1, seg = pn >> 2;
        const int row0 = pm * 256 + wr * 64 + fr, cs0 = (pn & 3) * 256 + wc * 32 + 8 * fq;
#pragma unroll
        for (int bj = 0; bj < 2; ++bj) {
            const int col = cs0 + bj * 128;
            if (seg == 1 || seg == 2) {
                const float* l0 = lbraw + (seg - 1) * 2048 + col;
                float lb[8];
#pragma unroll
                for (int j = 0; j < 8; ++j) lb[j] = fast_sigmoid(l0[j] - l0[1024 + j]);
#pragma unroll
                for (int ai = 0; ai < 2; ++ai)
#pragma unroll
                    for (int m = 0; m < 4; ++m) {
                        const int row = row0 + ai * 128 + m * 16;
                        f32x4 o0, o1;
#pragma unroll
                        for (int e = 0; e < 4; ++e) { o0[e] = __logf(lb[e] + (1.f - lb[e]) * fast_sigmoid(acc[ai][bj][m][0][e])); o1[e] = __logf(lb[4 + e] + (1.f - lb[4 + e]) * fast_sigmoid(acc[ai][bj][m][1][e])); }
                        float* p = LF + (size_t)row * 2048 + (seg - 1) * 1024 + col;
                        *(f32x4*)p = o0; *(f32x4*)(p + 4) = o1;
                    }
            } else {
                bf16_t* base = seg == 0 ? Q : seg == 3 ? V : seg == 4 ? GA : seg == 5 ? U : VV;
#pragma unroll
                for (int ai = 0; ai < 2; ++ai)
#pragma unroll
                    for (int m = 0; m < 4; ++m) {
                        const int row = row0 + ai * 128 + m * 16;
                        f32x4 v0 = acc[ai][bj][m][0], v1 = acc[ai][bj][m][1];
                        if (seg == 0) {
#pragma unroll
                            for (int e = 0; e < 4; ++e) { v0[e] = silu_f(v0[e]) * 0.08838834764831845f; v1[e] = silu_f(v1[e]) * 0.08838834764831845f; }
                        } else if (seg == 4) {
#pragma unroll
                            for (int e = 0; e < 4; ++e) { v0[e] = silu_f(v0[e]); v1[e] = silu_f(v1[e]); }
                        } else if (seg >= 5) {
#pragma unroll
                            for (int e = 0; e < 4; ++e) { v0[e] = gelu_tanh_f(v0[e]); v1[e] = gelu_tanh_f(v1[e]); }
                        }
                        u32x4 w; w.x = pk2(v0[0], v0[1]); w.y = pk2(v0[2], v0[3]); w.z = pk2(v1[0], v1[1]); w.w = pk2(v1[2], v1[3]);
                        *(u32x4*)(base + (size_t)row * 1024 + col) = w;
                    }
            }
        }
    }
};
struct EpiResid {
    const float* xin0; const float* xin1; float* xout; const float* gate;
    __device__ __forceinline__ void operator()(Acc& acc, const Unit& u, int wr, int wc, int fr, int fq) const {
        const int pm = u.e0, pn = u.e1;
        const int row0 = pm * 256 + wr * 64 + fr, col0 = pn * 256 + wc * 32 + 8 * fq;
        const float* g = gate + (size_t)row_bi(pm) * 12288 + col0;
        const float* xin = pm < 16 ? xin0 : xin1 - (size_t)TCTX * D;
#pragma unroll
        for (int bj = 0; bj < 2; ++bj) {
            const f32x4 g0 = *(const f32x4*)(g + bj * 128), g1 = *(const f32x4*)(g + bj * 128 + 4);
#pragma unroll
            for (int ai = 0; ai < 2; ++ai)
#pragma unroll
                for (int m = 0; m < 4; ++m) {
                    const size_t off = (size_t)(row0 + ai * 128 + m * 16) * D + col0 + bj * 128;
                    const f32x4 x0 = *(const f32x4*)(xin + off), x1 = *(const f32x4*)(xin + off + 4);
                    *(f32x4*)(xout + off) = x0 + g0 * acc[ai][bj][m][0]; *(f32x4*)(xout + off + 4) = x1 + g1 * acc[ai][bj][m][1];
                }
        }
    }
};
__device__ __forceinline__ float dpp_shr1(float src, float old) { return __builtin_bit_cast(float, __builtin_amdgcn_update_dpp(__builtin_bit_cast(int, old), __builtin_bit_cast(int, src), 0x111, 0xf, 0xf, false)); }
__device__ __forceinline__ float dpp_shl1(float src, float old) { return __builtin_bit_cast(float, __builtin_amdgcn_update_dpp(__builtin_bit_cast(int, old), __builtin_bit_cast(int, src), 0x101, 0xf, 0xf, false)); }
struct EpiConv {
    bf16_t* ACT; const float* cw; const float* cb; LAS float* xch;
    __device__ __forceinline__ void operator()(Acc& acc, const Unit& u, int wr, int wc, int fr, int fq) const {
        const int pm = u.e0, pn = u.e1; const bool ctx = pm < 16;
        LAS float* mine = xch + (wr * 4 + wc) * 64; const LAS float* other = xch + ((wr ^ 1) * 4 + wc) * 64;
        if (wr == 0) { if (fr == 15) {
#pragma unroll
            for (int bj = 0; bj < 2; ++bj)
#pragma unroll
                for (int n = 0; n < 2; ++n) *(LAS f32x4*)(mine + ((bj * 2 + n) * 4 + fq) * 4) = acc[1][bj][3][n]; } }
        else { if (fr == 0) {
#pragma unroll
            for (int bj = 0; bj < 2; ++bj)
#pragma unroll
                for (int n = 0; n < 2; ++n) *(LAS f32x4*)(mine + ((bj * 2 + n) * 4 + fq) * 4) = acc[0][bj][0][n]; } }
        LDS_WAIT(); __builtin_amdgcn_s_barrier(); asm volatile("" ::: "memory");
        const bool zl = !ctx && fr == 8, zr = !ctx && fr == 7;
        const int wcol0 = 128 * pn + 32 * wc + 8 * fq;
#pragma unroll
        for (int bj = 0; bj < 2; ++bj)
#pragma unroll
            for (int n = 0; n < 2; ++n) {
                const float* wp = cw + bj * DFF + wcol0 + 4 * n;
                const f32x4 w0 = *(const f32x4*)wp, w1 = *(const f32x4*)(wp + DFF2), w2 = *(const f32x4*)(wp + 2 * DFF2), bb = *(const f32x4*)(cb + bj * DFF + wcol0 + 4 * n);
                f32x4 hv = *(const LAS f32x4*)(other + ((bj * 2 + n) * 4 + fq) * 4); if (!ctx) hv = (f32x4){0.f, 0.f, 0.f, 0.f};
#pragma unroll
                for (int e = 0; e < 4; ++e) {
                    float x[8];
#pragma unroll
                    for (int j = 0; j < 8; ++j) x[j] = acc[j >> 2][bj][j & 3][n][e];
                    float left = dpp_shr1(x[7], wr == 1 ? hv[e] : 0.f);
                    float right = dpp_shl1(x[0], wr == 0 ? hv[e] : 0.f);
                    if (zl) left = 0.f; if (zr) right = 0.f;
#pragma unroll
                    for (int j = 0; j < 8; ++j) {
                        const float xm = j == 0 ? left : x[j - 1], xp = j == 7 ? right : x[j + 1];
                        acc[j >> 2][bj][j & 3][n][e] = w0[e] * xm + w1[e] * x[j] + w2[e] * xp + bb[e];
                    }
                }
            }
#pragma unroll
        for (int ai = 0; ai < 2; ++ai)
#pragma unroll
            for (int m = 0; m < 4; ++m) {
                const int tok = pm * 256 + 8 * (16 * wr + fr) + 4 * ai + m;
                f32x4 o0, o1;
#pragma unroll
                for (int e = 0; e < 4; ++e) { o0[e] = silu_f(acc[ai][0][m][0][e]) * acc[ai][1][m][0][e]; o1[e] = silu_f(acc[ai][0][m][1][e]) * acc[ai][1][m][1][e]; }
                u32x4 w; w.x = pk2(o0[0], o0[1]); w.y = pk2(o0[2], o0[3]); w.z = pk2(o1[0], o1[1]); w.w = pk2(o1[2], o1[3]);
                *(u32x4*)(ACT + (size_t)tok * DFF + wcol0) = w;
            }
    }
};
struct EpiF1 {
    bf16_t* PQT;
    __device__ __forceinline__ void operator()(Acc& acc, const Unit& u, int wr, int wc, int fr, int fq) const {
        const int pmd = u.e0, pn = u.e1, g = u.e2, which = pmd >> 1;
        int sb2, N, n0;
        if (pn < 16) { sb2 = 2 * 256 * pn; N = 256; n0 = 0; } else { const int s = (pn - 16) >> 2; sb2 = 2 * (TCTX + 1024 * s); N = 1024; n0 = ((pn - 16) & 3) * 256; }
        const int c0 = g * 512 + (pmd & 1) * 256 + wr * 64 + fr;
        bf16_t* base = PQT + (size_t)sb2 + which * N + n0 + wc * 32 + 8 * fq;
#pragma unroll
        for (int ai = 0; ai < 2; ++ai)
#pragma unroll
            for (int m = 0; m < 4; ++m) {
                bf16_t* rowp = base + (size_t)(c0 + ai * 128 + m * 16) * (2 * T);
#pragma unroll
                for (int bj = 0; bj < 2; ++bj) { const f32x4 v0 = acc[ai][bj][m][0], v1 = acc[ai][bj][m][1];
                    u32x4 w; w.x = pk2(v0[0], v0[1]); w.y = pk2(v0[2], v0[3]); w.z = pk2(v1[0], v1[1]); w.w = pk2(v1[2], v1[3]);
                    *(u32x4*)(rowp + bj * 128) = w; }
            }
    }
};
struct EpiBf16 {
    bf16_t* O; int ldo;
    __device__ __forceinline__ void operator()(Acc& acc, const Unit& u, int wr, int wc, int fr, int fq) const {
        const int row0 = u.e0 * 256 + wr * 64 + fr, col0 = u.e1 * 256 + wc * 32 + 8 * fq;
#pragma unroll
        for (int ai = 0; ai < 2; ++ai)
#pragma unroll
            for (int m = 0; m < 4; ++m) {
                bf16_t* rowp = O + (size_t)(row0 + ai * 128 + m * 16) * ldo + col0;
#pragma unroll
                for (int bj = 0; bj < 2; ++bj) { const f32x4 v0 = acc[ai][bj][m][0], v1 = acc[ai][bj][m][1];
                    u32x4 w; w.x = pk2(v0[0], v0[1]); w.y = pk2(v0[2], v0[3]); w.z = pk2(v1[0], v1[1]); w.w = pk2(v1[2], v1[3]);
                    *(u32x4*)(rowp + bj * 128) = w; }
            }
    }
};

struct Args { const float* in[30]; float* out; unsigned char* ws; int ph_lo, ph_hi; };

__device__ __forceinline__ void p0_transpose_item(const float* W, int K, int N, bf16_t* WT, LAS float* scr, int item, int lane, int up) {
    const int nblk = N / 32, kb = item / nblk, nb = item % nblk, k0 = 64 * kb, n0 = 32 * nb;
#pragma unroll 8
    for (int i = 0; i < 32; ++i) { const int kk = 2 * i + (lane >> 5); scr[kk * 33 + (lane & 31)] = W[(size_t)(k0 + kk) * N + n0 + (lane & 31)]; }
    LDS_WAIT(); asm volatile("" ::: "memory");
    const int c = lane & 7;
#pragma unroll
    for (int j = 0; j < 4; ++j) { const int n = (lane >> 3) + 8 * j; const LAS float* s = scr + (8 * c) * 33 + n;
        u32x4 o; o.x = pk2(s[0 * 33], s[1 * 33]); o.y = pk2(s[2 * 33], s[3 * 33]); o.z = pk2(s[4 * 33], s[5 * 33]); o.w = pk2(s[6 * 33], s[7 * 33]);
        int nn = n0 + n;
        if (up) { const int bjj = nn >= DFF ? 1 : 0, cgc = nn - bjj * DFF; nn = (cgc >> 7) * 256 + bjj * 128 + (cgc & 127); }
        *(u32x4*)(WT + (size_t)nn * K + k0 + 8 * c) = o; }
    LDS_WAIT(); asm volatile("" ::: "memory");
}
__device__ __forceinline__ void phase_prologue(const Args& a, LAS unsigned char* lds, int vcu, int G) {
    const int tid = threadIdx.x, lane = tid & 63, wave = __builtin_amdgcn_readfirstlane(tid >> 6);
    unsigned char* ws = a.ws;
    __syncthreads();
    if (vcu < 192) {
        const int l = vcu / 96, n0 = (vcu % 96) * 128;
        const float* Wm = a.in[l ? 20 : 5]; const float* bm = a.in[l ? 21 : 6];
        LAS float* S = (LAS float*)lds;
        for (int i = tid; i < 2048 * 9; i += NT) { const int k = i / 9, bi = i % 9; const float cv = bi == 0 ? a.in[4][k] : a.in[3][(bi - 1) * 2048 + k]; S[k * 12 + bi] = silu_f(cv); }
        __syncthreads();
        const int l4 = tid & 31, rg = tid >> 5;
        f32x4 accm[9];
#pragma unroll
        for (int bi = 0; bi < 9; ++bi) accm[bi] = (f32x4){0.f, 0.f, 0.f, 0.f};
#pragma unroll 4
        for (int kk = 0; kk < 128; ++kk) {
            const int k = rg + 16 * kk;
            const f32x4 w = *(const f32x4*)(Wm + (size_t)k * 12288 + n0 + 4 * l4);
            const f32x4 s0 = *(const LAS f32x4*)(S + k * 12), s1 = *(const LAS f32x4*)(S + k * 12 + 4); const float s8 = S[k * 12 + 8];
            accm[0] += s0[0] * w; accm[1] += s0[1] * w; accm[2] += s0[2] * w; accm[3] += s0[3] * w;
            accm[4] += s1[0] * w; accm[5] += s1[1] * w; accm[6] += s1[2] * w; accm[7] += s1[3] * w; accm[8] += s8 * w;
        }
        __syncthreads();
        LAS float* red = (LAS float*)lds;
#pragma unroll
        for (int bi = 0; bi < 9; ++bi) *(LAS f32x4*)(red + (rg * 9 + bi) * 128 + 4 * l4) = accm[bi];
        __syncthreads();
        float* MOD = (float*)(ws + WS_MOD) + (size_t)l * 9 * 12288;
        for (int o = tid; o < 9 * 128; o += NT) { const int bi = o >> 7, n = o & 127; float s = bm[n0 + n];
#pragma unroll
            for (int r = 0; r < 16; ++r) s += red[(r * 9 + bi) * 128 + n];
            MOD[(size_t)bi * 12288 + n0 + n] = s; }
        __syncthreads();
    }
    {
        const int gt = vcu * NT + tid, GT = G * NT;
        bf16_t* DC = (bf16_t*)(ws + WS_DFTC); bf16_t* D256 = (bf16_t*)(ws + WS_DFT256); bf16_t* D1024 = (bf16_t*)(ws + WS_DFT1024);
        for (int i = gt; i < 1024 * 512; i += GT) { const int r = i >> 9, k = i & 511, c = r & 511; const float ang = 2.0f * (float)((c * k) & 511) * (1.0f / 512.0f);
            const float v = (r < 512 ? cospif(ang) : sinpif(ang)) * 0.04419417382415922f; DC[i] = (bf16_t)f2bf(v); }
        for (int i = gt; i < 256 * 512; i += GT) { const int p = i >> 9, k = i & 511, n = k & 255; const float ang = 2.0f * (float)((p * n) & 255) * (1.0f / 256.0f);
            const float v = (k < 256 ? cospif(ang) : -sinpif(ang)) * 0.0625f; D256[i] = (bf16_t)f2bf(v); }
        for (int i = gt; i < 1024 * 2048; i += GT) { const int p = i >> 11, k = i & 2047, n = k & 1023; const float ang = 2.0f * (float)((p * n) & 1023) * (1.0f / 1024.0f);
            const float v = (k < 1024 ? cospif(ang) : -sinpif(ang)) * 0.03125f; D1024[i] = (bf16_t)f2bf(v); }
    }
    {
        LAS float* scr = (LAS float*)(lds + wave * 8448);
        const int gw = vcu * 8 + wave, NGW = G * 8;
        constexpr int I_IN = 32 * (INW / 32), I_O = 32 * (D / 32), I_UP = 32 * (DFF2 / 32), I_DN = (DFF / 64) * (D / 32);
        constexpr int NITEMS = I_IN + 2 * I_O + 2 * I_UP + 2 * I_DN;
        for (int it = gw; it < NITEMS; it += NGW) {
            int r = it;
            if (r < I_IN) { p0_transpose_item(a.in[8], D, INW, (bf16_t*)(ws + WS_WIN), scr, r, lane, 0); continue; } r -= I_IN;
            if (r < I_O) { p0_transpose_item(a.in[14], D, D, (bf16_t*)(ws + WS_WOUT0), scr, r, lane, 0); continue; } r -= I_O;
            if (r < I_O) { p0_transpose_item(a.in[23], D, D, (bf16_t*)(ws + WS_WOUT1), scr, r, lane, 0); continue; } r -= I_O;
            if (r < I_UP) { p0_transpose_item(a.in[16], D, DFF2, (bf16_t*)(ws + WS_WUP0), scr, r, lane, 1); continue; } r -= I_UP;
            if (r < I_UP) { p0_transpose_item(a.in[25], D, DFF2, (bf16_t*)(ws + WS_WUP1), scr, r, lane, 1); continue; } r -= I_UP;
            if (r < I_DN) { p0_transpose_item(a.in[19], DFF, D, (bf16_t*)(ws + WS_WDN0), scr, r, lane, 0); continue; } r -= I_DN;
            p0_transpose_item(a.in[28], DFF, D, (bf16_t*)(ws + WS_WDN1), scr, r, lane, 0);
        }
    }
}

__device__ __forceinline__ void phase_norm_mod(const float* x0, const float* x1, const float* nw, const float* sh, const float* sc, bf16_t* H, int vcu, int G) {
    const int lane = threadIdx.x & 63, wave = __builtin_amdgcn_readfirstlane(threadIdx.x >> 6);
    const int gw = vcu * 8 + wave, NGW = G * 8;
    for (int row = gw; row < T; row += NGW) {
        const float* xr = row < TCTX ? x0 + (size_t)row * D : x1 + (size_t)(row - TCTX) * D;
        const int bi = row < TCTX ? 0 : 1 + ((row - TCTX) >> 10);
        f32x4 v[8]; float s = 0.f;
#pragma unroll
        for (int j = 0; j < 8; ++j) { v[j] = *(const f32x4*)(xr + 4 * lane + 256 * j); s += (v[j][0] * v[j][0] + v[j][1] * v[j][1]) + (v[j][2] * v[j][2] + v[j][3] * v[j][3]); }
        const float rstd = rsqrtf(wave_sum(s) * (1.0f / D) + 1e-6f);
        const float* shp = sh + (size_t)bi * 12288; const float* scp = sc + (size_t)bi * 12288;
#pragma unroll
        for (int j = 0; j < 8; ++j) { const int c = 4 * lane + 256 * j;
            const f32x4 w = *(const f32x4*)(nw + c), a1 = *(const f32x4*)(scp + c), a0 = *(const f32x4*)(shp + c);
            f32x4 o;
#pragma unroll
            for (int e = 0; e < 4; ++e) o[e] = v[j][e] * rstd * w[e] * (1.0f + a1[e]) + a0[e];
            u32x2 p; p.x = pk2(o[0], o[1]); p.y = pk2(o[2], o[3]);
            *(u32x2*)(H + (size_t)row * D + c) = p; }
    }
}
__device__ __forceinline__ void phase_final_norm(float* X, const float* nw, int vcu, int G) {
    const int lane = threadIdx.x & 63, wave = __builtin_amdgcn_readfirstlane(threadIdx.x >> 6);
    const int gw = vcu * 8 + wave, NGW = G * 8;
    for (int row = gw; row < T; row += NGW) {
        float* xr = X + (size_t)row * D;
        f32x4 v[8]; float s = 0.f;
#pragma unroll
        for (int j = 0; j < 8; ++j) { v[j] = *(const f32x4*)(xr + 4 * lane + 256 * j); s += (v[j][0] * v[j][0] + v[j][1] * v[j][1]) + (v[j][2] * v[j][2] + v[j][3] * v[j][3]); }
        const float rstd = rsqrtf(wave_sum(s) * (1.0f / D) + 1e-6f);
#pragma unroll
        for (int j = 0; j < 8; ++j) { const int c = 4 * lane + 256 * j; const f32x4 w = *(const f32x4*)(nw + c); *(f32x4*)(xr + c) = v[j] * rstd * w; }
    }
}

constexpr int P128 = 136, P64 = 72;
constexpr int SC_QS = 0, SC_KS = SC_QS + 64 * P128 * 2, SC_QI = SC_KS + 64 * P128 * 2, SC_KO = SC_QI + 64 * P128 * 2, SC_VT = SC_KO + 128 * P64 * 2,
              SC_SC = SC_VT + 128 * P64 * 2, SC_ST = SC_SC + 64 * P64 * 2, SC_TOT = SC_ST + 128 * P128 * 2, SC_DEC = SC_TOT + 4 * 128 * 4, SC_END = SC_DEC + 128 * 4;
static_assert(SC_END <= LDS_BYTES, "scan LDS");
__device__ __forceinline__ void scan_item(const Args& a, LAS unsigned char* lds, int seqbase, int N, int b_state, int h, int dir, bool ctx, int b_out) {
    const int tid = threadIdx.x, lane = tid & 63, w = __builtin_amdgcn_readfirstlane(tid >> 6), fr = lane & 15, fq = lane >> 4;
    unsigned char* ws = a.ws;
    const bf16_t* Qg = (const bf16_t*)(ws + WS_Q) + h * 128; const bf16_t* Vg = (const bf16_t*)(ws + WS_V) + h * 128;
    const float* LFg = (const float*)(ws + WS_LF) + dir * 1024 + h * 128;
    float* Og = (float*)(ws + (dir ? WS_OB : WS_OF)) + h * 128;
    LAS bf16_t* QS = (LAS bf16_t*)(lds + SC_QS); LAS bf16_t* KS = (LAS bf16_t*)(lds + SC_KS); LAS bf16_t* QI = (LAS bf16_t*)(lds + SC_QI);
    LAS bf16_t* KO = (LAS bf16_t*)(lds + SC_KO); LAS bf16_t* VT = (LAS bf16_t*)(lds + SC_VT); LAS bf16_t* SCm = (LAS bf16_t*)(lds + SC_SC);
    LAS bf16_t* ST = (LAS bf16_t*)(lds + SC_ST); LAS float* TOT = (LAS float*)(lds + SC_TOT); LAS float* DEC = (LAS float*)(lds + SC_DEC);
    const int ch = tid & 127, seg = tid >> 7;
    f32x4 accS[8];
    if (ctx) {
#pragma unroll
        for (int kt = 0; kt < 8; ++kt) accS[kt] = (f32x4){0.f, 0.f, 0.f, 0.f};
    } else {
        const float* s0 = a.in[2] + ((size_t)(b_state * 2 + dir) * 8 + h) * 16384;
#pragma unroll
        for (int kt = 0; kt < 8; ++kt)
#pragma unroll
            for (int e = 0; e < 4; ++e) accS[kt][e] = s0[(16 * kt + 4 * fq + e) * 128 + 16 * w + fr];
    }
    __syncthreads();
#pragma unroll
    for (int kt = 0; kt < 8; ++kt) { u32x2 p; p.x = pk2(accS[kt][0], accS[kt][1]); p.y = pk2(accS[kt][2], accS[kt][3]); *(LAS u32x2*)(ST + (16 * w + fr) * P128 + 16 * kt + 4 * fq) = p; }
    const int nc = N >> 6;
    for (int c = 0; c < nc; ++c) {
        float lf[16], qv[16]; unsigned short vv16[16];
#pragma unroll
        for (int ii = 0; ii < 16; ++ii) {
            const int i = 64 * c + 16 * seg + ii; const int tok = seqbase + (dir ? N - 1 - i : i);
            lf[ii] = LFg[(size_t)tok * 2048 + ch]; qv[ii] = bf2f(Qg[(size_t)tok * 1024 + ch]); vv16[ii] = Vg[(size_t)tok * 1024 + ch];
        }
        float bcs[16]; float run = 0.f;
#pragma unroll
        for (int ii = 0; ii < 16; ++ii) { run += lf[ii]; bcs[ii] = run; }
        TOT[seg * 128 + ch] = run;
        __syncthreads();
        const float t0 = TOT[ch], t1 = TOT[128 + ch], t2 = TOT[256 + ch], t3 = TOT[384 + ch];
        const float offs = seg == 0 ? 0.f : seg == 1 ? t0 : seg == 2 ? t0 + t1 : t0 + t1 + t2;
        const float ref = t0 + t1, blast = (t0 + t1) + (t2 + t3);
        if (seg == 0) DEC[ch] = __expf(blast);
        unsigned kow[8], vtw[8];
#pragma unroll
        for (int ii = 0; ii < 16; ii += 2) {
            float ko2[2];
#pragma unroll
            for (int d = 0; d < 2; ++d) {
                const int i2 = ii + d, i = 16 * seg + i2; const float b = bcs[i2] + offs; const float kf = 1.0f - __expf(lf[i2]);
                QS[i * P128 + ch] = (bf16_t)f2bf(qv[i2] * __expf(b - ref));
                KS[i * P128 + ch] = (bf16_t)f2bf(kf * __expf(ref - b));
                QI[i * P128 + ch] = (bf16_t)f2bf(qv[i2] * __expf(b));
                ko2[d] = kf * __expf(blast - b);
            }
            kow[ii >> 1] = pk2(ko2[0], ko2[1]); vtw[ii >> 1] = (unsigned)vv16[ii] | ((unsigned)vv16[ii + 1] << 16);
        }
        *(LAS u32x4*)(KO + ch * P64 + 16 * seg) = (u32x4){kow[0], kow[1], kow[2], kow[3]}; *(LAS u32x4*)(KO + ch * P64 + 16 * seg + 8) = (u32x4){kow[4], kow[5], kow[6], kow[7]};
        *(LAS u32x4*)(VT + ch * P64 + 16 * seg) = (u32x4){vtw[0], vtw[1], vtw[2], vtw[3]}; *(LAS u32x4*)(VT + ch * P64 + 16 * seg + 8) = (u32x4){vtw[4], vtw[5], vtw[6], vtw[7]};
        __syncthreads();
        {
            const int it = w >> 1;
#pragma unroll
            for (int jj = 0; jj < 2; ++jj) {
                const int jt = 2 * (w & 1) + jj;
                f32x4 d = (f32x4){0.f, 0.f, 0.f, 0.f};
                if (jt <= it) {
#pragma unroll
                    for (int ks = 0; ks < 4; ++ks) {
                        const bf16x8 af = *(const LAS bf16x8*)(KS + (16 * jt + fr) * P128 + 32 * ks + 8 * fq);
                        const bf16x8 bf = *(const LAS bf16x8*)(QS + (16 * it + fr) * P128 + 32 * ks + 8 * fq);
                        d = __builtin_amdgcn_mfma_f32_16x16x32_bf16(af, bf, d, 0, 0, 0);
                    }
                }
                const int i = 16 * it + fr, j0 = 16 * jt + 4 * fq;
#pragma unroll
                for (int e = 0; e < 4; ++e) if (j0 + e > i) d[e] = 0.f;
                u32x2 p; p.x = pk2(d[0], d[1]); p.y = pk2(d[2], d[3]);
                *(LAS u32x2*)(SCm + i * P64 + j0) = p;
            }
        }
        __syncthreads();
        f32x4 oacc[4];
#pragma unroll
        for (int it = 0; it < 4; ++it) oacc[it] = (f32x4){0.f, 0.f, 0.f, 0.f};
        {
            bf16x8 stf[4], vtf[2];
#pragma unroll
            for (int ks = 0; ks < 4; ++ks) stf[ks] = *(const LAS bf16x8*)(ST + (16 * w + fr) * P128 + 32 * ks + 8 * fq);
#pragma unroll
            for (int ks = 0; ks < 2; ++ks) vtf[ks] = *(const LAS bf16x8*)(VT + (16 * w + fr) * P64 + 32 * ks + 8 * fq);
#pragma unroll
            for (int it = 0; it < 4; ++it) {
#pragma unroll
                for (int ks = 0; ks < 4; ++ks) { const bf16x8 qf = *(const LAS bf16x8*)(QI + (16 * it + fr) * P128 + 32 * ks + 8 * fq); oacc[it] = __builtin_amdgcn_mfma_f32_16x16x32_bf16(stf[ks], qf, oacc[it], 0, 0, 0); }
#pragma unroll
                for (int ks = 0; ks < 2; ++ks) { const bf16x8 sf = *(const LAS bf16x8*)(SCm + (16 * it + fr) * P64 + 32 * ks + 8 * fq); oacc[it] = __builtin_amdgcn_mfma_f32_16x16x32_bf16(vtf[ks], sf, oacc[it], 0, 0, 0); }
            }
#pragma unroll
            for (int kt = 0; kt < 8; ++kt) {
                const f32x4 dc = *(const LAS f32x4*)(DEC + 16 * kt + 4 * fq);
                accS[kt] = accS[kt] * dc;
#pragma unroll
                for (int ks = 0; ks < 2; ++ks) { const bf16x8 kf = *(const LAS bf16x8*)(KO + (16 * kt + fr) * P64 + 32 * ks + 8 * fq); accS[kt] = __builtin_amdgcn_mfma_f32_16x16x32_bf16(kf, vtf[ks], accS[kt], 0, 0, 0); }
            }
        }
#pragma unroll
        for (int it = 0; it < 4; ++it) { const int i = 64 * c + 16 * it + fr; const int tok = seqbase + (dir ? N - 1 - i : i); *(f32x4*)(Og + (size_t)tok * 1024 + 16 * w + 4 * fq) = oacc[it]; }
#pragma unroll
        for (int kt = 0; kt < 8; ++kt) { u32x2 p; p.x = pk2(accS[kt][0], accS[kt][1]); p.y = pk2(accS[kt][2], accS[kt][3]); *(LAS u32x2*)(ST + (16 * w + fr) * P128 + 16 * kt + 4 * fq) = p; }
    }
    if (ctx) {
        float* so = a.out + (size_t)T * D + ((size_t)(b_out * 2 + dir) * 8 + h) * 16384;
#pragma unroll
        for (int kt = 0; kt < 8; ++kt)
#pragma unroll
            for (int e = 0; e < 4; ++e) so[(16 * kt + 4 * fq + e) * 128 + 16 * w + fr] = accS[kt][e];
    }
}

constexpr int MB_WS = 0, MB_BV = 128 * P128 * 2, MB_END = MB_BV + 256 * P128 * 2;
static_assert(MB_END <= LDS_BYTES, "mixer-B LDS");
__device__ __forceinline__ void mixb_item(const Args& a, LAS unsigned char* lds, int cbk, int g) {
    const int tid = threadIdx.x, lane = tid & 63, w = __builtin_amdgcn_readfirstlane(tid >> 6), fr = lane & 15, fq = lane >> 4;
    unsigned char* ws = a.ws;
    LAS bf16_t* WSl = (LAS bf16_t*)(lds + MB_WS); LAS bf16_t* BV = (LAS bf16_t*)(lds + MB_BV);
    const bf16_t* VVg = (const bf16_t*)(ws + WS_VV) + (size_t)cbk * 128 * 1024 + g * 256;
    const bf16_t* Ug = (const bf16_t*)(ws + WS_U) + (size_t)cbk * 128 * 1024 + g * 256;
    bf16_t* CAT = (bf16_t*)(ws + WS_CAT) + (size_t)cbk * 128 * D + 1024 + g * 256;
    const float* wsg = a.in[12] + (size_t)g * 16384; const float* vn = a.in[11] + g * 256; const float* bsg = a.in[13] + g * 128;
    __syncthreads();
#pragma unroll
    for (int j = 0; j < 8; ++j) { const int idx = (tid + j * NT) * 4, p = idx >> 7, q = idx & 127; const f32x4 v = *(const f32x4*)(wsg + idx);
        u32x2 o; o.x = pk2(v[0], v[1]); o.y = pk2(v[2], v[3]); *(LAS u32x2*)(WSl + p * P128 + q) = o; }
    {
        const int q = tid >> 2, qt = tid & 3;
        u32x4 raw[8]; float ss = 0.f;
#pragma unroll
        for (int j = 0; j < 8; ++j) { raw[j] = *(const u32x4*)(VVg + (size_t)q * 1024 + qt * 64 + 8 * j);
#pragma unroll
            for (int e = 0; e < 4; ++e) { const float lo = bflo(raw[j][e]), hi = bfhi(raw[j][e]); ss += lo * lo + hi * hi; } }
        ss += __shfl_xor(ss, 1); ss += __shfl_xor(ss, 2);
        const float rstd = rsqrtf(ss * (1.0f / 256.0f) + 1e-6f);
#pragma unroll
        for (int j = 0; j < 8; ++j)
#pragma unroll
            for (int e = 0; e < 4; ++e) { const int c = qt * 64 + 8 * j + 2 * e;
                BV[c * P128 + q] = (bf16_t)f2bf(bflo(raw[j][e]) * rstd * vn[c]); BV[(c + 1) * P128 + q] = (bf16_t)f2bf(bfhi(raw[j][e]) * rstd * vn[c + 1]); }
    }
    __syncthreads();
    const int wr2 = w >> 2, wc2 = w & 3;
    f32x4 acc[4][4];
#pragma unroll
    for (int mt = 0; mt < 4; ++mt)
#pragma unroll
        for (int nt = 0; nt < 4; ++nt) acc[mt][nt] = (f32x4){0.f, 0.f, 0.f, 0.f};
#pragma unroll
    for (int ks = 0; ks < 4; ++ks) {
        bf16x8 wf[4], vf[4];
#pragma unroll
        for (int mt = 0; mt < 4; ++mt) wf[mt] = *(const LAS bf16x8*)(WSl + (64 * wr2 + 16 * mt + fr) * P128 + 32 * ks + 8 * fq);
#pragma unroll
        for (int nt = 0; nt < 4; ++nt) vf[nt] = *(const LAS bf16x8*)(BV + (64 * wc2 + 16 * nt + fr) * P128 + 32 * ks + 8 * fq);
#pragma unroll
        for (int mt = 0; mt < 4; ++mt)
#pragma unroll
            for (int nt = 0; nt < 4; ++nt) acc[mt][nt] = __builtin_amdgcn_mfma_f32_16x16x32_bf16(vf[nt], wf[mt], acc[mt][nt], 0, 0, 0);
    }
#pragma unroll
    for (int mt = 0; mt < 4; ++mt) {
        const int p = 64 * wr2 + 16 * mt + fr; const float bsv = bsg[p];
#pragma unroll
        for (int nt = 0; nt < 4; ++nt) { const int c = 64 * wc2 + 16 * nt + 4 * fq;
            const u32x2 uu = *(const u32x2*)(Ug + (size_t)p * 1024 + c);
            u32x2 o; o.x = pk2(bflo(uu.x) * (acc[mt][nt][0] + bsv), bfhi(uu.x) * (acc[mt][nt][1] + bsv)); o.y = pk2(bflo(uu.y) * (acc[mt][nt][2] + bsv), bfhi(uu.y) * (acc[mt][nt][3] + bsv));
            *(u32x2*)(CAT + (size_t)p * D + c) = o; }
    }
}
__device__ __forceinline__ void mixer_work(const Args& a, LAS unsigned char* lds, int it) {
    if (it < 128) { const int s = it >> 4, h = (it >> 1) & 7, dir = it & 1; scan_item(a, lds, TCTX + 1024 * s, 1024, s, h, dir, false, 0); }
    else if (it < 384) { const int j = it - 128, s = j >> 4, h = (j >> 1) & 7, dir = j & 1; scan_item(a, lds, 256 * s, 256, 0, h, dir, true, s); }
    else { const int j = it - 384; mixb_item(a, lds, j >> 2, j & 3); }
}
__device__ __forceinline__ void phase_mixers(const Args& a, LAS unsigned char* lds, int vcu, int G) {
    if (G == 256) {
        const int j = vcu - 128, n = vcu < 128 ? 1 : 5;
        for (int q = 0; q < n; ++q) { const int it = vcu < 128 ? vcu : (q < 2 ? 128 + 2 * j + q : 384 + 3 * j + (q - 2)); mixer_work(a, lds, it); }
    } else { for (int it = vcu; it < 768; it += G) mixer_work(a, lds, it); }
}
__device__ __forceinline__ void phase_finalize_a(const Args& a, int vcu, int G) {
    const int lane = threadIdx.x & 63, wave = __builtin_amdgcn_readfirstlane(threadIdx.x >> 6);
    const int gw = vcu * 8 + wave, NGW = G * 8;
    unsigned char* ws = a.ws;
    const float* OF = (const float*)(ws + WS_OF); const float* OB = (const float*)(ws + WS_OB); const bf16_t* GA = (const bf16_t*)(ws + WS_GA); bf16_t* CAT = (bf16_t*)(ws + WS_CAT);
    const int col = (lane >> 3) * 128 + (lane & 7) * 16, vc = (lane & 7) * 16;
    f32x4 gn[4];
#pragma unroll
    for (int j = 0; j < 4; ++j) gn[j] = *(const f32x4*)(a.in[10] + vc + 4 * j);
    for (int row = gw; row < T; row += NGW) {
        f32x4 v[4]; float ss = 0.f;
#pragma unroll
        for (int j = 0; j < 4; ++j) { v[j] = *(const f32x4*)(OF + (size_t)row * 1024 + col + 4 * j) + *(const f32x4*)(OB + (size_t)row * 1024 + col + 4 * j); ss += (v[j][0] * v[j][0] + v[j][1] * v[j][1]) + (v[j][2] * v[j][2] + v[j][3] * v[j][3]); }
        ss += __shfl_xor(ss, 1); ss += __shfl_xor(ss, 2); ss += __shfl_xor(ss, 4);
        const float rstd = rsqrtf(ss * (1.0f / 128.0f) + 1e-6f);
        const u32x4 g0 = *(const u32x4*)(GA + (size_t)row * 1024 + col), g1 = *(const u32x4*)(GA + (size_t)row * 1024 + col + 8);
        u32x4 o0, o1;
#pragma unroll
        for (int e = 0; e < 4; ++e) {
            const int j = e >> 1, k = (e & 1) * 2;
            o0[e] = pk2(v[j][k] * rstd * gn[j][k] * bflo(g0[e]), v[j][k + 1] * rstd * gn[j][k + 1] * bfhi(g0[e]));
            o1[e] = pk2(v[2 + j][k] * rstd * gn[2 + j][k] * bflo(g1[e]), v[2 + j][k + 1] * rstd * gn[2 + j][k + 1] * bfhi(g1[e]));
        }
        *(u32x4*)(CAT + (size_t)row * D + col) = o0; *(u32x4*)(CAT + (size_t)row * D + col + 8) = o1;
    }
}


#define XB_TMO      128
#define XB_XCNT(j)  (256  + 64 * (j))
#define XB_XSUB(j)  (1280 + 64 * (j))
#define XB_XGEN(j)  (2304 + 64 * (j))
#define XB_TOP      3328
#define XB_TOPGEN   3392
#define XCD_BAR_WORDS 3456
#define XB_SPIN_CAP (1u << 18)
__device__ __forceinline__ unsigned xb_ld(unsigned* p)              { return __hip_atomic_load(p, __ATOMIC_RELAXED, __HIP_MEMORY_SCOPE_AGENT); }
__device__ __forceinline__ unsigned xb_add(unsigned* p, unsigned v) { return __hip_atomic_fetch_add(p, v, __ATOMIC_RELAXED, __HIP_MEMORY_SCOPE_AGENT); }
__device__ __forceinline__ unsigned xb_xcc_id() { return (unsigned)__builtin_amdgcn_s_getreg((3 << 11) | 20) & 0xFu; }
#define XB_SPIN(cond, bar) do { unsigned _sp = 0; while (cond) { __builtin_amdgcn_s_sleep(1); \
    if ((++_sp & 255u) == 0u) { if (xb_ld(&(bar)[XB_TMO])) break; if (_sp > XB_SPIN_CAP) { atomicAdd(&(bar)[XB_TMO], 1u); break; } } } } while (0)
struct XcdBarrier { unsigned* bar; unsigned x; volatile LAS unsigned* st; };
__device__ __forceinline__ XcdBarrier xcd_barrier_post(unsigned* bar, volatile LAS unsigned* st) {
    XcdBarrier b; b.bar = bar; b.x = xb_xcc_id(); b.st = st;
    if (threadIdx.x == 0) (void)xb_add(&bar[XB_XCNT(b.x)], 1u);
    return b;
}
__device__ __forceinline__ void xcd_barrier_complete(unsigned* bar, unsigned x, unsigned& nloc, unsigned& nx) {
    const unsigned G = gridDim.x * gridDim.y * gridDim.z;
    unsigned sum, cnt, mine, sp = 0u;
    for (;;) {
        sum = 0u; cnt = 0u; mine = 0u;
#pragma unroll
        for (unsigned j = 0; j < 16; ++j) { const unsigned c = xb_ld(&bar[XB_XCNT(j)]); sum += c; cnt += (c > 0u) ? 1u : 0u; mine = (j == x) ? c : mine; }
        if (sum == G) break;
        __builtin_amdgcn_s_sleep(1);
        if ((++sp & 255u) == 0u) { if (xb_ld(&bar[XB_TMO])) break; if (sp > XB_SPIN_CAP) { atomicAdd(&bar[XB_TMO], 1u); break; } }
    }
    nloc = mine > 0u ? mine : 1u; nx = cnt > 0u ? cnt : 1u;
}
__device__ __forceinline__ void xcd_barrier(const XcdBarrier& b) {
    asm volatile("s_waitcnt vmcnt(0)" ::: "memory");
    __syncthreads();
    if (threadIdx.x == 0) {
        unsigned* bar = b.bar;
        __builtin_amdgcn_s_waitcnt(0);
        unsigned nloc = b.st[0], nx = b.st[1];
        if (nloc == 0u) { xcd_barrier_complete(bar, b.x, nloc, nx); b.st[0] = nloc; b.st[1] = nx; }
        const unsigned old = xb_add(&bar[XB_XSUB(b.x)], 1u);
        const unsigned gen = old / nloc;
        if (old + 1u == (gen + 1u) * nloc) {
            __builtin_amdgcn_fence(__ATOMIC_RELEASE, "agent");
            asm volatile("s_waitcnt vmcnt(0)" ::: "memory");
            const unsigned og = xb_add(&bar[XB_TOP], 1u);
            const unsigned tg = og / nx;
            if (og + 1u == (tg + 1u) * nx) xb_add(&bar[XB_TOPGEN], 1u);
            else XB_SPIN(xb_ld(&bar[XB_TOPGEN]) == tg, bar);
            __builtin_amdgcn_fence(__ATOMIC_ACQUIRE, "agent");
            xb_add(&bar[XB_XGEN(b.x)], 1u);
            asm volatile("s_waitcnt vmcnt(0)" ::: "memory");
        } else {
            XB_SPIN(xb_ld(&bar[XB_XGEN(b.x)]) == gen, bar);
            __builtin_amdgcn_fence(__ATOMIC_ACQUIRE, "agent");
            asm volatile("s_waitcnt vmcnt(0)" ::: "memory");
        }
    }
    __syncthreads();
}

#ifndef PG8_SP2
#define PG8_SP2 true
#endif
__global__ void __launch_bounds__(NT, 2) mk_fwd(Args a) {
    extern __shared__ __attribute__((aligned(16))) unsigned char lds_raw[];
    LAS unsigned char* lds = (LAS unsigned char*)lds_raw;
    cg::grid_group grid = cg::this_grid();
    const int G = gridDim.x, bx = blockIdx.x;
    const int vcu = (G % 8 == 0) ? (bx % 8) * (G / 8) + bx / 8 : bx;
    unsigned char* ws = a.ws;
    const int lo = a.ph_lo, hi = a.ph_hi;
    if (threadIdx.x < 16) ((LAS unsigned*)(lds + LDS_MISC))[threadIdx.x] = 0u;
    __syncthreads();
    (void)xcd_barrier_post((unsigned*)(ws + WS_CTL), (volatile LAS unsigned*)(lds + LDS_MISC));
    if (lo == -12345) grid.sync();
    float* X = a.out;
    const float* MOD0 = (const float*)(ws + WS_MOD); const float* MOD1 = MOD0 + 9 * 12288;
    bf16_t* Hb = (bf16_t*)(ws + WS_H); bf16_t* CAT = (bf16_t*)(ws + WS_CAT); bf16_t* ACT = (bf16_t*)(ws + WS_ACT); bf16_t* PQT = (bf16_t*)(ws + WS_PQT);
#ifndef PHMASK
#define PHMASK 0x1FFFF
#endif
#define IN(k) (((PHMASK >> (k)) & 1) && lo <= (k) && (k) < hi)
#ifndef REPMASK
#define REPMASK 0
#endif
#ifndef REPN
#define REPN 2
#endif
#define REPS(k) for (int rep_ = 0; rep_ < (((REPMASK >> (k)) & 1) ? REPN : 1); ++rep_)
#define SEAM(k) do { if (IN(k) && IN((k) + 1)) { XcdBarrier b_; b_.bar = (unsigned*)(a.ws + WS_CTL); b_.x = xb_xcc_id(); b_.st = (volatile LAS unsigned*)(lds + LDS_MISC); xcd_barrier(b_); } } while (0)

    if (IN(0)) REPS(0) phase_prologue(a, lds, vcu, G);
    SEAM(0);
    if (IN(1)) REPS(1) phase_norm_mod(a.in[0], a.in[1], a.in[7], MOD0, MOD0 + D, Hb, vcu, G);
    SEAM(1);
    if (IN(2)) {
        SchedDense S{48, INW / 256, G, bx, (const char*)Hb, (const char*)(ws + WS_WIN), (size_t)256 * D * 2, (size_t)256 * D * 2, ((REPMASK >> 2) & 1) ? REPN : 1};
        EpiInProj E{(bf16_t*)(ws + WS_Q), (bf16_t*)(ws + WS_V), (bf16_t*)(ws + WS_GA), (bf16_t*)(ws + WS_U), (bf16_t*)(ws + WS_VV), (float*)(ws + WS_LF), a.in[9]};
        pg8::gemm_phase<EpiInProj, SchedDense, PG8_SP2, 0>(lds, D, D, D / 64, (size_t)128 * D * 2, (size_t)128 * D * 2, S, E);
    }
    SEAM(2);
    if (IN(3)) REPS(3) phase_mixers(a, lds, vcu, G);
    SEAM(3);
    if (IN(4)) REPS(4) phase_finalize_a(a, vcu, G);
    SEAM(4);
    if (IN(5)) {
        SchedDense S{48, 8, G, bx, (const char*)CAT, (const char*)(ws + WS_WOUT0), (size_t)256 * D * 2, (size_t)256 * D * 2, ((REPMASK >> 5) & 1) ? REPN : 1};
        EpiResid E{a.in[0], a.in[1], X, MOD0 + 2 * D};
        pg8::gemm_phase<EpiResid, SchedDense, PG8_SP2, 0>(lds, D, D, D / 64, (size_t)128 * D * 2, (size_t)128 * D * 2, S, E);
    }
    SEAM(5);
    if (IN(6)) REPS(6) phase_norm_mod(X, X + (size_t)TCTX * D, a.in[15], MOD0 + 3 * D, MOD0 + 4 * D, Hb, vcu, G);
    SEAM(6);
    if (IN(7)) {
        SchedDense S{48, DFF / 128, G, bx, (const char*)Hb, (const char*)(ws + WS_WUP0), (size_t)256 * D * 2, (size_t)256 * D * 2, ((REPMASK >> 7) & 1) ? REPN : 1};
        EpiConv E{ACT, a.in[17], a.in[18], (LAS float*)(lds + LDS_XCH)};
        pg8::gemm_phase<EpiConv, SchedDense, PG8_SP2, 1>(lds, D, D, D / 64, (size_t)4 * D * 2, (size_t)128 * D * 2, S, E);
    }
    SEAM(7);
    if (IN(8)) {
        SchedDense S{48, 8, G, bx, (const char*)ACT, (const char*)(ws + WS_WDN0), (size_t)256 * DFF * 2, (size_t)256 * DFF * 2, ((REPMASK >> 8) & 1) ? REPN : 1};
        EpiResid E{X, X + (size_t)TCTX * D, X, MOD0 + 5 * D};
        pg8::gemm_phase<EpiResid, SchedDense, PG8_SP2, 0>(lds, DFF, DFF, DFF / 64, (size_t)128 * DFF * 2, (size_t)128 * DFF * 2, S, E);
    }
    SEAM(8);
    if (IN(9)) REPS(9) phase_norm_mod(X, X + (size_t)TCTX * D, a.in[22], MOD1, MOD1 + D, Hb, vcu, G);
    SEAM(9);
    if (IN(10)) REPS(10) {
        SchedF1 S{G, bx, (const char*)(ws + WS_DFTC), (const char*)Hb};
        EpiF1 E{PQT};
        pg8::gemm_phase<EpiF1, SchedF1, PG8_SP2, 0>(lds, 512, D, 8, (size_t)128 * 512 * 2, (size_t)128 * D * 2, S, E);
    }
    SEAM(10);
    if (IN(11)) REPS(11) {
        { SchedF2 S{G, bx, 1, (const char*)(ws + WS_DFT1024), (const char*)PQT}; EpiBf16 E{CAT, D};
          pg8::gemm_phase<EpiBf16, SchedF2, PG8_SP2, 0>(lds, 2048, 2 * T, 32, (size_t)128 * 2048 * 2, (size_t)128 * 2 * T * 2, S, E); }
        { SchedF2 S{G, bx, 0, (const char*)(ws + WS_DFT256), (const char*)PQT}; EpiBf16 E{CAT, D};
          pg8::gemm_phase<EpiBf16, SchedF2, PG8_SP2, 0>(lds, 512, 2 * T, 8, (size_t)128 * 512 * 2, (size_t)128 * 2 * T * 2, S, E); }
    }
    SEAM(11);
    if (IN(12)) {
        SchedDense S{48, 8, G, bx, (const char*)CAT, (const char*)(ws + WS_WOUT1), (size_t)256 * D * 2, (size_t)256 * D * 2, ((REPMASK >> 12) & 1) ? REPN : 1};
        EpiResid E{X, X + (size_t)TCTX * D, X, MOD1 + 2 * D};
        pg8::gemm_phase<EpiResid, SchedDense, PG8_SP2, 0>(lds, D, D, D / 64, (size_t)128 * D * 2, (size_t)128 * D * 2, S, E);
    }
    SEAM(12);
    if (IN(13)) REPS(13) phase_norm_mod(X, X + (size_t)TCTX * D, a.in[24], MOD1 + 3 * D, MOD1 + 4 * D, Hb, vcu, G);
    SEAM(13);
    if (IN(14)) {
        SchedDense S{48, DFF / 128, G, bx, (const char*)Hb, (const char*)(ws + WS_WUP1), (size_t)256 * D * 2, (size_t)256 * D * 2, ((REPMASK >> 14) & 1) ? REPN : 1};
        EpiConv E{ACT, a.in[26], a.in[27], (LAS float*)(lds + LDS_XCH)};
        pg8::gemm_phase<EpiConv, SchedDense, PG8_SP2, 1>(lds, D, D, D / 64, (size_t)4 * D * 2, (size_t)128 * D * 2, S, E);
    }
    SEAM(14);
    if (IN(15)) {
        SchedDense S{48, 8, G, bx, (const char*)ACT, (const char*)(ws + WS_WDN1), (size_t)256 * DFF * 2, (size_t)256 * DFF * 2, ((REPMASK >> 15) & 1) ? REPN : 1};
        EpiResid E{X, X + (size_t)TCTX * D, X, MOD1 + 5 * D};
        pg8::gemm_phase<EpiResid, SchedDense, PG8_SP2, 0>(lds, DFF, DFF, DFF / 64, (size_t)128 * DFF * 2, (size_t)128 * DFF * 2, S, E);
    }
    SEAM(15);
    if (IN(16)) REPS(16) phase_final_norm(X, a.in[29], vcu, G);
#undef IN
#undef SEAM
}

extern "C" void kernel_launch(void* const* d_in, const int* in_sizes, int n_in, void* d_out, int out_size, void* d_ws, size_t ws_size, hipStream_t stream) {
    static int grid = 0;
    if (grid == 0) {
        if (n_in != 30 || ws_size < WS_END) { fprintf(stderr, "kernel_launch: need 30 inputs and %zu bytes of workspace (got %d, %zu)\n", (size_t)WS_END, n_in, ws_size); grid = -1; return; }
        int dev = 0, cus = 0, per_cu = 0;
        if (hipGetDevice(&dev) != hipSuccess || hipDeviceGetAttribute(&cus, hipDeviceAttributeMultiprocessorCount, dev) != hipSuccess) { grid = -1; return; }
        if (hipFuncSetAttribute((const void*)mk_fwd, hipFuncAttributeMaxDynamicSharedMemorySize, LDS_BYTES) != hipSuccess) { fprintf(stderr, "kernel_launch: hipFuncSetAttribute failed\n"); grid = -1; return; }
        if (hipOccupancyMaxActiveBlocksPerMultiprocessor(&per_cu, (const void*)mk_fwd, NT, LDS_BYTES) != hipSuccess || per_cu < 1) { fprintf(stderr, "kernel_launch: occupancy query says %d blocks per CU\n", per_cu); grid = -1; return; }
        grid = cus;
    }
    if (grid < 0) return;
    if (hipMemsetAsync((char*)d_ws + WS_CTL, 0, 65536, stream) != hipSuccess) { fprintf(stderr, "kernel_launch: hipMemsetAsync failed\n"); return; }
    Args a{};
    for (int i = 0; i < 30; ++i) a.in[i] = (const float*)d_in[i];
    a.out = (float*)d_out; a.ws = (unsigned char*)d_ws;
#if MK_FUSED
    a.ph_lo = 0; a.ph_hi = NPH;
    void* args[] = {&a};
    hipError_t e = hipLaunchCooperativeKernel((const void*)mk_fwd, dim3(grid), dim3(NT), args, LDS_BYTES, stream);
    if (e != hipSuccess) fprintf(stderr, "cooperative launch failed: %s (grid %d)\n", hipGetErrorString(e), grid);
#else
    for (int p = 0; p < NPH; ++p) {
        a.ph_lo = p; a.ph_hi = p + 1;
        void* args[] = {&a};
        hipError_t e = hipLaunchCooperativeKernel((const void*)mk_fwd, dim3(grid), dim3(NT), args, LDS_BYTES, stream);
        if (e != hipSuccess) { fprintf(stderr, "launch %d failed: %s (grid %d)\n", p, hipGetErrorString(e), grid); break; }
    }
#endif
}
```

```cpp
#include <hip/hip_runtime.h>
#include <hip/hip_cooperative_groups.h>
#include <cstdio>
#include <cstdint>
namespace cg = cooperative_groups;

#ifndef MK_FUSED
#define MK_FUSED 1
#endif

#define LAS __attribute__((address_space(3)))
typedef unsigned short bf16_t;
typedef short bf16x8 __attribute__((ext_vector_type(8)));
typedef float f32x4 __attribute__((ext_vector_type(4)));
typedef float f32x2 __attribute__((ext_vector_type(2)));
typedef unsigned u32x4 __attribute__((ext_vector_type(4)));
typedef unsigned u32x2 __attribute__((ext_vector_type(2)));

constexpr int D = 2048, T = 12288, TCTX = 4096;
constexpr int DFF = 5632, DFF2 = 11264, INW = 7168, AW = 1024;
constexpr int NPH = 17;
constexpr int NT = 512;

constexpr size_t WS_CTL = 0;
constexpr size_t WS_MOD = 65536;
constexpr size_t WS_WIN = WS_MOD + (size_t)2 * 9 * 12288 * 4;
constexpr size_t WS_WOUT0 = WS_WIN + (size_t)INW * D * 2;
constexpr size_t WS_WUP0 = WS_WOUT0 + (size_t)D * D * 2;
constexpr size_t WS_WDN0 = WS_WUP0 + (size_t)DFF2 * D * 2;
constexpr size_t WS_WOUT1 = WS_WDN0 + (size_t)D * DFF * 2;
constexpr size_t WS_WUP1 = WS_WOUT1 + (size_t)D * D * 2;
constexpr size_t WS_WDN1 = WS_WUP1 + (size_t)DFF2 * D * 2;
constexpr size_t WS_DFTC = WS_WDN1 + (size_t)D * DFF * 2;
constexpr size_t WS_DFT256 = WS_DFTC + (size_t)1024 * 512 * 2;
constexpr size_t WS_DFT1024 = WS_DFT256 + (size_t)256 * 512 * 2;
constexpr size_t WS_H = WS_DFT1024 + (size_t)1024 * 2048 * 2;
constexpr size_t WS_CAT = WS_H + (size_t)T * D * 2;
constexpr size_t WS_R1 = WS_CAT + (size_t)T * D * 2;
constexpr size_t WS_Q = WS_R1;
constexpr size_t WS_V = WS_Q + (size_t)T * AW * 2;
constexpr size_t WS_GA = WS_V + (size_t)T * AW * 2;
constexpr size_t WS_U = WS_GA + (size_t)T * AW * 2;
constexpr size_t WS_VV = WS_U + (size_t)T * AW * 2;
constexpr size_t WS_LF = WS_VV + (size_t)T * AW * 2;
constexpr size_t WS_OF = WS_LF + (size_t)T * 2048 * 4;
constexpr size_t WS_OB = WS_OF + (size_t)T * AW * 4;
constexpr size_t WS_R1_END = WS_OB + (size_t)T * AW * 4;
constexpr size_t WS_ACT = WS_R1;
constexpr size_t WS_PQT = WS_R1;
constexpr size_t WS_END = WS_R1_END;
static_assert(WS_ACT + (size_t)T * DFF * 2 <= WS_R1_END && WS_PQT + (size_t)2048 * 2 * T * 2 <= WS_R1_END, "aliases fit");

constexpr int LDS_BYTES = 147456;
constexpr int LDS_XCH = 131072;
constexpr int LDS_MISC = 131072 + 8192;

__device__ __forceinline__ unsigned f2bf(float f) { unsigned u = __builtin_bit_cast(unsigned, f); return (u + 0x7fffu + ((u >> 16) & 1u)) >> 16; }
__device__ __forceinline__ unsigned pk2(float lo, float hi) { unsigned r; asm("v_cvt_pk_bf16_f32 %0, %1, %2" : "=v"(r) : "v"(lo), "v"(hi)); return r; }
__device__ __forceinline__ float bflo(unsigned w) { return __builtin_bit_cast(float, w << 16); }
__device__ __forceinline__ float bfhi(unsigned w) { return __builtin_bit_cast(float, w & 0xffff0000u); }
__device__ __forceinline__ float bf2f(bf16_t b) { return __builtin_bit_cast(float, (unsigned)b << 16); }
__device__ __forceinline__ float wave_sum(float v) {
#pragma unroll
    for (int o = 1; o < 64; o <<= 1) v += __shfl_xor(v, o);
    return v;
}
__device__ __forceinline__ float fast_sigmoid(float x) { return __builtin_amdgcn_rcpf(1.0f + __expf(-x)); }
__device__ __forceinline__ float silu_f(float x) { return x * fast_sigmoid(x); }
__device__ __forceinline__ float gelu_tanh_f(float x) { const float u = 1.5957691216057308f * (x + 0.044715f * x * x * x); return x * fast_sigmoid(u); }
__device__ __forceinline__ int row_bi(int pm) { return pm < 16 ? 0 : 1 + ((pm - 16) >> 2); }
#define LDS_WAIT() asm volatile("s_waitcnt lgkmcnt(0)" ::: "memory")

namespace pg8 {
constexpr int BM = 256, BK = 64, HALF = 128, HTB = HALF * BK * 2, NXCD = 8, WGM = 8;
__device__ __forceinline__ int lds_byte(int r, int c) { const int st = (r >> 4) * 2 + (c >> 5), rr = r & 15, cc = c & 31, ob = rr * 64 + cc * 2; return st * 1024 + (ob ^ (((ob >> 9) & 1) << 5)); }
__device__ __forceinline__ void stage_rc(int b, int& R, int& C) { const int st = b / 1024, sb = b % 1024, swz = sb ^ (((sb >> 9) & 1) << 5); R = (st >> 1) * 16 + swz / 64; C = (st & 1) * 32 + (swz % 64) / 2; }
__device__ __forceinline__ int perm32(int rho) { const int n = rho >> 4, i = rho & 15; return 8 * (i >> 2) + 4 * n + (i & 3); }
__device__ __forceinline__ int permA_conv(int R) { return 8 * (16 * (R >> 6) + (R & 15)) + ((R >> 4) & 3); }

struct Unit { const char* A; const char* B; int e0, e1, e2, e3; };

__device__ __forceinline__ void tile_order(int L, int nM, int nN, int& pm, int& pn) {
    const int nwg = nM * nN; int wgid = L;
    { const int q = nwg / NXCD, r = nwg % NXCD, xcd = wgid % NXCD, off = wgid / NXCD; wgid = (xcd < r ? xcd * (q + 1) : r * (q + 1) + (xcd - r) * q) + off; }
    const int nig = WGM * nN, gid = wgid / nig, fm = gid * WGM, gsz = (nM - fm) < WGM ? (nM - fm) : WGM;
    pm = fm + ((wgid % nig) % gsz); pn = (wgid % nig) / gsz;
}

template <class Epi, class Sched, bool SP2, int PERMA>
__device__ __forceinline__ void gemm_phase(LAS unsigned char* lds, const int lda, const int ldb, const int nt, const size_t hstepA, const size_t hstepB, const Sched& S, const Epi& E) {
    const int tid = threadIdx.x, wid = __builtin_amdgcn_readfirstlane(tid >> 6), lane = tid & 63, wr = wid >> 2, wc = wid & 3, fr = lane & 15, fq = lane >> 4;
    unsigned voffA[2], voffB[2];
#pragma unroll
    for (int i = 0; i < 2; ++i) { int R, C; stage_rc(tid * 16 + i * 8192, R, C); const int Ra = PERMA ? permA_conv(R) : R; const int Rb = (R & ~31) + perm32(R & 31);
        voffA[i] = (unsigned)(Ra * lda + C) * 2u; voffB[i] = (unsigned)(Rb * ldb + C) * 2u; }
    const size_t kstep = (size_t)(BK * 2);
    const unsigned ldsw = (unsigned)wid * 1024u;
    const int aoff = lds_byte(wr * 64 + fr, fq * 8), boff = lds_byte(wc * 32 + fr, fq * 8);
#define PG8_SA(b, h) (((b) * 2 + (h)) * HTB)
#define PG8_SB(b, h) ((4 + (b) * 2 + (h)) * HTB)
#define PG8_STAGE(bufoff, gbase, voff) do { _Pragma("unroll") for (int _i = 0; _i < 2; ++_i) \
        __builtin_amdgcn_global_load_lds((const unsigned*)((const char*)(gbase) + (voff)[_i]), (LAS unsigned*)(lds + (bufoff) + ldsw + _i * 8192), 16, 0, 0); } while (0)
#define PG8_LDA(dst, b, h) do { _Pragma("unroll") for (int m = 0; m < 4; ++m) _Pragma("unroll") for (int k = 0; k < 2; ++k) dst[m][k] = *(const LAS bf16x8*)(lds + PG8_SA(b, h) + aoff + m * 2048 + k * 1024); } while (0)
#define PG8_LDB(dst, b, h) do { _Pragma("unroll") for (int n = 0; n < 2; ++n) _Pragma("unroll") for (int k = 0; k < 2; ++k) dst[n][k] = *(const LAS bf16x8*)(lds + PG8_SB(b, h) + boff + n * 2048 + k * 1024); } while (0)
#define PG8_MMA(ai, bj, At, Bt) do { __builtin_amdgcn_s_setprio(1); _Pragma("unroll") for (int m = 0; m < 4; ++m) _Pragma("unroll") for (int n = 0; n < 2; ++n) _Pragma("unroll") for (int k = 0; k < 2; ++k) \
        acc[ai][bj][m][n] = __builtin_amdgcn_mfma_f32_16x16x32_bf16(Bt[n][k], At[m][k], acc[ai][bj][m][n], 0, 0, 0); __builtin_amdgcn_s_setprio(0); } while (0)
#define PG8_WAIT_V(n) asm volatile("s_waitcnt vmcnt(" #n ")" ::: "memory")
#define PG8_WAIT_L(n) asm volatile("s_waitcnt lgkmcnt(" #n ")" ::: "memory")
#define PG8_BAR __builtin_amdgcn_s_barrier()
#define PG8_SCHED __builtin_amdgcn_sched_barrier(0)
    Unit cur, nxt; int ui = 0;
    if (!S.next(0, cur)) return;
    f32x4 acc[2][2][4][2];
#pragma unroll
    for (int a = 0; a < 2; ++a)
#pragma unroll
        for (int b = 0; b < 2; ++b)
#pragma unroll
            for (int m = 0; m < 4; ++m)
#pragma unroll
                for (int n = 0; n < 2; ++n) acc[a][b][m][n] = (f32x4){0.f, 0.f, 0.f, 0.f};
    bf16x8 At[4][2], B0[2][2], B1[2][2];
    const char* cA = cur.A; const char* cB = cur.B;
    if constexpr (SP2) {
        PG8_STAGE(PG8_SB(0, 0), cB, voffB); PG8_STAGE(PG8_SB(0, 1), cB + hstepB, voffB); PG8_STAGE(PG8_SA(0, 0), cA, voffA); PG8_STAGE(PG8_SA(0, 1), cA + hstepA, voffA);
        if (wr == 1) PG8_BAR;
        PG8_WAIT_V(2); PG8_BAR;
        PG8_STAGE(PG8_SB(1, 0), cB + kstep, voffB); PG8_STAGE(PG8_SA(1, 0), cA + kstep, voffA); PG8_STAGE(PG8_SB(1, 1), cB + hstepB + kstep, voffB);
        PG8_WAIT_V(6); PG8_BAR;
    } else {
        PG8_STAGE(PG8_SB(0, 0), cB, voffB); PG8_STAGE(PG8_SA(0, 0), cA, voffA); PG8_STAGE(PG8_SB(0, 1), cB + hstepB, voffB); PG8_STAGE(PG8_SA(0, 1), cA + hstepA, voffA);
        if (wr == 1) PG8_BAR;
        PG8_WAIT_V(4); PG8_BAR;
        PG8_STAGE(PG8_SB(1, 0), cB + kstep, voffB); PG8_STAGE(PG8_SA(1, 0), cA + kstep, voffA); PG8_STAGE(PG8_SB(1, 1), cB + hstepB + kstep, voffB);
        PG8_WAIT_V(6); PG8_BAR;
    }
    for (;;) {
        const bool has_next = S.next(ui + 1, nxt);
        const char* nA = has_next ? nxt.A : cA; const char* nB = has_next ? nxt.B : cB;
        for (int t = 0; t < nt; t += 2) {
            const bool last = (t == nt - 2);
            const char* a1 = cA + (size_t)(t + 1) * kstep;
            const char* a2 = last ? nA : cA + (size_t)(t + 2) * kstep; const char* b2 = last ? nB : cB + (size_t)(t + 2) * kstep;
            const char* a3 = a2 + kstep; const char* b3 = b2 + kstep;
            if constexpr (SP2) {
            PG8_LDB(B0, 0, 0); PG8_LDB(B1, 0, 1); PG8_SCHED; PG8_LDA(At, 0, 0); PG8_STAGE(PG8_SA(1, 1), a1 + hstepA, voffA);
            PG8_WAIT_V(8); PG8_WAIT_L(0); PG8_BAR; PG8_MMA(0, 0, At, B0); PG8_MMA(0, 1, At, B1); PG8_BAR; PG8_SCHED;
            PG8_LDA(At, 0, 1); PG8_STAGE(PG8_SB(0, 0), b2, voffB); PG8_STAGE(PG8_SB(0, 1), b2 + hstepB, voffB); PG8_STAGE(PG8_SA(0, 0), a2, voffA);
            PG8_WAIT_V(8); PG8_WAIT_L(0); PG8_BAR; PG8_MMA(1, 0, At, B0); PG8_MMA(1, 1, At, B1); PG8_BAR; PG8_SCHED;
            PG8_LDB(B0, 1, 0); PG8_LDB(B1, 1, 1); PG8_SCHED; PG8_LDA(At, 1, 0); PG8_STAGE(PG8_SA(0, 1), a2 + hstepA, voffA);
            PG8_WAIT_V(8); PG8_WAIT_L(0); PG8_BAR; PG8_MMA(0, 0, At, B0); PG8_MMA(0, 1, At, B1); PG8_BAR; PG8_SCHED;
            PG8_LDA(At, 1, 1); PG8_STAGE(PG8_SB(1, 0), b3, voffB); PG8_STAGE(PG8_SB(1, 1), b3 + hstepB, voffB); PG8_STAGE(PG8_SA(1, 0), a3, voffA);
            PG8_WAIT_V(8); PG8_WAIT_L(0); PG8_BAR; PG8_MMA(1, 0, At, B0); PG8_MMA(1, 1, At, B1); PG8_BAR; PG8_SCHED;
            } else {
            PG8_LDB(B0, 0, 0); PG8_SCHED; PG8_LDA(At, 0, 0); PG8_STAGE(PG8_SA(1, 1), a1 + hstepA, voffA);
            PG8_WAIT_L(8); PG8_BAR; PG8_WAIT_L(0); PG8_MMA(0, 0, At, B0); PG8_BAR; PG8_SCHED;
            PG8_LDB(B1, 0, 1); PG8_STAGE(PG8_SB(0, 0), b2, voffB);
            PG8_BAR; PG8_WAIT_L(0); PG8_MMA(0, 1, At, B1); PG8_BAR;
            PG8_LDA(At, 0, 1); PG8_STAGE(PG8_SA(0, 0), a2, voffA);
            PG8_BAR; PG8_WAIT_L(0); PG8_MMA(1, 0, At, B0); PG8_BAR; PG8_SCHED;
            PG8_STAGE(PG8_SB(0, 1), b2 + hstepB, voffB);
            PG8_WAIT_V(6); PG8_BAR; PG8_MMA(1, 1, At, B1); PG8_BAR;
            PG8_LDB(B0, 1, 0); PG8_SCHED; PG8_LDA(At, 1, 0); PG8_STAGE(PG8_SA(0, 1), a2 + hstepA, voffA);
            PG8_WAIT_L(8); PG8_BAR; PG8_WAIT_L(0); PG8_MMA(0, 0, At, B0); PG8_BAR; PG8_SCHED;
            PG8_LDB(B1, 1, 1); PG8_STAGE(PG8_SB(1, 0), b3, voffB);
            PG8_BAR; PG8_WAIT_L(0); PG8_MMA(0, 1, At, B1); PG8_BAR;
            PG8_LDA(At, 1, 1); PG8_STAGE(PG8_SA(1, 0), a3, voffA);
            PG8_BAR; PG8_WAIT_L(0); PG8_MMA(1, 0, At, B0); PG8_BAR; PG8_SCHED;
            PG8_STAGE(PG8_SB(1, 1), b3 + hstepB, voffB);
            PG8_WAIT_V(6); PG8_BAR; PG8_MMA(1, 1, At, B1); PG8_BAR;
            }
        }
        if (wr == 0) PG8_BAR;
        E(acc, cur, wr, wc, fr, fq);
        if (!has_next) break;
#pragma unroll
        for (int a = 0; a < 2; ++a)
#pragma unroll
            for (int b = 0; b < 2; ++b)
#pragma unroll
                for (int m = 0; m < 4; ++m)
#pragma unroll
                    for (int n = 0; n < 2; ++n) acc[a][b][m][n] = (f32x4){0.f, 0.f, 0.f, 0.f};
        cur = nxt; cA = nA; cB = nB; ++ui;
        if (wr == 1) PG8_BAR;
    }
    PG8_WAIT_V(0);
    PG8_BAR;
#undef PG8_SA
#undef PG8_SB
#undef PG8_STAGE
#undef PG8_LDA
#undef PG8_LDB
#undef PG8_MMA
#undef PG8_WAIT_V
#undef PG8_WAIT_L
#undef PG8_BAR
#undef PG8_SCHED
}
}
using pg8::Unit;
typedef f32x4 Acc[2][2][4][2];

struct SchedDense {
    int nM, nN, G, c; const char* A; const char* B; size_t astep, bstep; int reps;
    __device__ __forceinline__ bool next(int i, Unit& u) const {
        long L = (long)i * G + c; if (L >= (long)reps * nM * nN) return false; L %= (long)nM * nN;
        int pm, pn; pg8::tile_order((int)L, nM, nN, pm, pn);
        u.A = A + (size_t)pm * astep; u.B = B + (size_t)pn * bstep; u.e0 = pm; u.e1 = pn; u.e2 = 0; u.e3 = 0; return true;
    }
};
struct SchedF1 {
    int G, c; const char* A; const char* B;
    __device__ __forceinline__ bool next(int i, Unit& u) const {
        const long L = (long)i * G + c; if (L >= 16 * 48) return false;
        int pmm, pn; pg8::tile_order((int)L, 16, 48, pmm, pn);
        const int g = pmm >> 2, pmd = pmm & 3;
        u.A = A + (size_t)pmd * 256 * 512 * 2; u.B = B + ((size_t)pn * 256 * D + (size_t)g * 512) * 2; u.e0 = pmd; u.e1 = pn; u.e2 = g; u.e3 = 0; return true;
    }
};
struct SchedF2 {
    int G, c, smp; const char* A; const char* B;
    __device__ __forceinline__ bool next(int i, Unit& u) const {
        const long L = (long)i * G + c;
        if (smp) { if (L >= 256) return false; const int l = (int)L, pn2 = l & 1, pm = (l >> 1) & 3, g = (l >> 3) & 3, s = l >> 5;
            u.A = A + (size_t)pm * 256 * 2048 * 2; u.B = B + (((size_t)(g * 512 + pn2 * 256)) * (2 * T) + 2 * (size_t)(TCTX + 1024 * s)) * 2;
            u.e0 = (TCTX + 1024 * s + 256 * pm) >> 8; u.e1 = g * 2 + pn2; u.e2 = 0; u.e3 = 0; return true; }
        if (L >= 128) return false; const int l = (int)L, pn2 = l & 1, g = (l >> 1) & 3, s = l >> 3;
        u.A = A; u.B = B + (((size_t)(g * 512 + pn2 * 256)) * (2 * T) + 2 * (size_t)(256 * s)) * 2;
        u.e0 = s; u.e1 = g * 2 + pn2; u.e2 = 0; u.e3 = 0; return true;
    }
};

struct EpiInProj {
    bf16_t *Q, *V, *GA, *U, *VV; float* LF; const float* lbraw;
    __device__ __forceinline__ void operator()(Acc& acc, const Unit& u, int wr, int wc, int fr, int fq) const {
        const int pm = u.e0, pn = u.e1, seg = pn >> 2;
        const int row0 = pm * 256 + wr * 64 + fr, cs0 = (pn & 3) * 256 + wc * 32 + 8 * fq;
#pragma unroll
        for (int bj = 0; bj < 2; ++bj) {
            const int col = cs0 + bj * 128;
            if (seg == 1 || seg == 2) {
                const float* l0 = lbraw + (seg - 1) * 2048 + col;
                float lb[8];
#pragma unroll
                for (int j = 0; j < 8; ++j) lb[j] = fast_sigmoid(l0[j] - l0[1024 + j]);
#pragma unroll
                for (int ai = 0; ai < 2; ++ai)
#pragma unroll
                    for (int m = 0; m < 4; ++m) {
                        const int row = row0 + ai * 128 + m * 16;
                        f32x4 o0, o1;
#pragma unroll
                        for (int e = 0; e < 4; ++e) { o0[e] = __logf(lb[e] + (1.f - lb[e]) * fast_sigmoid(acc[ai][bj][m][0][e])); o1[e] = __logf(lb[4 + e] + (1.f - lb[4 + e]) * fast_sigmoid(acc[ai][bj][m][1][e])); }
                        float* p = LF + (size_t)row * 2048 + (seg - 1) * 1024 + col;
                        *(f32x4*)p = o0; *(f32x4*)(p + 4) = o1;
                    }
            } else {
                bf16_t* base = seg == 0 ? Q : seg == 3 ? V : seg == 4 ? GA : seg == 5 ? U : VV;
#pragma unroll
                for (int ai = 0; ai < 2; ++ai)
#pragma unroll
                    for (int m = 0; m < 4; ++m) {
                        const int row = row0 + ai * 128 + m * 16;
                        f32x4 v0 = acc[ai][bj][m][0], v1 = acc[ai][bj][m][1];
                        if (seg == 0) {
#pragma unroll
                            for (int e = 0; e < 4; ++e) { v0[e] = silu_f(v0[e]) * 0.08838834764831845f; v1[e] = silu_f(v1[e]) * 0.08838834764831845f; }
                        } else if (seg == 4) {
#pragma unroll
                            for (int e = 0; e < 4; ++e) { v0[e] = silu_f(v0[e]); v1[e] = silu_f(v1[e]); }
                        } else if (seg >= 5) {
#pragma unroll
                            for (int e = 0; e < 4; ++e) { v0[e] = gelu_tanh_f(v0[e]); v1[e] = gelu_tanh_f(v1[e]); }
                        }
                        u32x4 w; w.x = pk2(v0[0], v0[1]); w.y = pk2(v0[2], v0[3]); w.z = pk2(v1[0], v1[1]); w.w = pk2(v1[2], v1[3]);
                        *(u32x4*)(base + (size_t)row * 1024 + col) = w;
                    }
            }
        }
    }
};
struct EpiResid {
    const float* xin0; const float* xin1; float* xout; const float* gate;
    __device__ __forceinline__ void operator()(Acc& acc, const Unit& u, int wr, int wc, int fr, int fq) const {
        const int pm = u.e0, pn = u.e1;
        const int row0 = pm * 256 + wr * 64 + fr, col0 = pn * 256 + wc * 32 + 8 * fq;
        const float* g = gate + (size_t)row_bi(pm) * 12288 + col0;
        const float* xin = pm < 16 ? xin0 : xin1 - (size_t)TCTX * D;
#pragma unroll
        for (int bj = 0; bj < 2; ++bj) {
            const f32x4 g0 = *(const f32x4*)(g + bj * 128), g1 = *(const f32x4*)(g + bj * 128 + 4);
#pragma unroll
            for (int ai = 0; ai < 2; ++ai)
#pragma unroll
                for (int m = 0; m < 4; ++m) {
                    const size_t off = (size_t)(row0 + ai * 128 + m * 16) * D + col0 + bj * 128;
                    const f32x4 x0 = *(const f32x4*)(xin + off), x1 = *(const f32x4*)(xin + off + 4);
                    *(f32x4*)(xout + off) = x0 + g0 * acc[ai][bj][m][0]; *(f32x4*)(xout + off + 4) = x1 + g1 * acc[ai][bj][m][1];
                }
        }
    }
};
__device__ __forceinline__ float dpp_shr1(float src, float old) { return __builtin_bit_cast(float, __builtin_amdgcn_update_dpp(__builtin_bit_cast(int, old), __builtin_bit_cast(int, src), 0x111, 0xf, 0xf, false)); }
__device__ __forceinline__ float dpp_shl1(float src, float old) { return __builtin_bit_cast(float, __builtin_amdgcn_update_dpp(__builtin_bit_cast(int, old), __builtin_bit_cast(int, src), 0x101, 0xf, 0xf, false)); }
struct EpiConv {
    bf16_t* ACT; const float* cw; const float* cb; LAS float* xch;
    __device__ __forceinline__ void operator()(Acc& acc, const Unit& u, int wr, int wc, int fr, int fq) const {
        const int pm = u.e0, pn = u.e1; const bool ctx = pm < 16;
        LAS float* mine = xch + (wr * 4 + wc) * 64; const LAS float* other = xch + ((wr ^ 1) * 4 + wc) * 64;
        if (wr == 0) { if (fr == 15) {
#pragma unroll
            for (int bj = 0; bj < 2; ++bj)
#pragma unroll
                for (int n = 0; n < 2; ++n) *(LAS f32x4*)(mine + ((bj * 2 + n) * 4 + fq) * 4) = acc[1][bj][3][n]; } }
        else { if (fr == 0) {
#pragma unroll
            for (int bj = 0; bj < 2; ++bj)
#pragma unroll
                for (int n = 0; n < 2; ++n) *(LAS f32x4*)(mine + ((bj * 2 + n) * 4 + fq) * 4) = acc[0][bj][0][n]; } }
        LDS_WAIT(); __builtin_amdgcn_s_barrier(); asm volatile("" ::: "memory");
        const bool zl = !ctx && fr == 8, zr = !ctx && fr == 7;
        const int wcol0 = 128 * pn + 32 * wc + 8 * fq;
#pragma unroll
        for (int bj = 0; bj < 2; ++bj)
#pragma unroll
            for (int n = 0; n < 2; ++n) {
                const float* wp = cw + bj * DFF + wcol0 + 4 * n; const float* bp = cb + bj * DFF + wcol0 + 4 * n;
                f32x4 hv = *(const LAS f32x4*)(other + ((bj * 2 + n) * 4 + fq) * 4); if (!ctx) hv = (f32x4){0.f, 0.f, 0.f, 0.f};
#pragma unroll
                for (int e = 0; e < 4; ++e) {
                    const float w0 = wp[e], w1 = wp[DFF2 + e], w2 = wp[2 * DFF2 + e], bb = bp[e];
                    float x[8];
#pragma unroll
                    for (int j = 0; j < 8; ++j) x[j] = acc[j >> 2][bj][j & 3][n][e];
                    float left = dpp_shr1(x[7], wr == 1 ? hv[e] : 0.f);
                    float right = dpp_shl1(x[0], wr == 0 ? hv[e] : 0.f);
                    if (zl) left = 0.f; if (zr) right = 0.f;
#pragma unroll
                    for (int j = 0; j < 8; ++j) {
                        const float xm = j == 0 ? left : x[j - 1], xp = j == 7 ? right : x[j + 1];
                        acc[j >> 2][bj][j & 3][n][e] = w0 * xm + w1 * x[j] + w2 * xp + bb;
                    }
                }
                asm volatile("" ::: "memory");
            }
#pragma unroll
        for (int ai = 0; ai < 2; ++ai)
#pragma unroll
            for (int m = 0; m < 4; ++m) {
                const int tok = pm * 256 + 8 * (16 * wr + fr) + 4 * ai + m;
                f32x4 o0, o1;
#pragma unroll
                for (int e = 0; e < 4; ++e) { o0[e] = silu_f(acc[ai][0][m][0][e]) * acc[ai][1][m][0][e]; o1[e] = silu_f(acc[ai][0][m][1][e]) * acc[ai][1][m][1][e]; }
                u32x4 w; w.x = pk2(o0[0], o0[1]); w.y = pk2(o0[2], o0[3]); w.z = pk2(o1[0], o1[1]); w.w = pk2(o1[2], o1[3]);
                *(u32x4*)(ACT + (size_t)tok * DFF + wcol0) = w;
                asm volatile("" ::: "memory");
            }
    }
};
struct EpiF1 {
    bf16_t* PQT;
    __device__ __forceinline__ void operator()(Acc& acc, const Unit& u, int wr, int wc, int fr, int fq) const {
        const int pmd = u.e0, pn = u.e1, g = u.e2, which = pmd >> 1;
        int sb2, N, n0;
        if (pn < 16) { sb2 = 2 * 256 * pn; N = 256; n0 = 0; } else { const int s = (pn - 16) >> 2; sb2 = 2 * (TCTX + 1024 * s); N = 1024; n0 = ((pn - 16) & 3) * 256; }
        const int c0 = g * 512 + (pmd & 1) * 256 + wr * 64 + fr;
        bf16_t* base = PQT + (size_t)sb2 + which * N + n0 + wc * 32 + 8 * fq;
#pragma unroll
        for (int ai = 0; ai < 2; ++ai)
#pragma unroll
            for (int m = 0; m < 4; ++m) {
                bf16_t* rowp = base + (size_t)(c0 + ai * 128 + m * 16) * (2 * T);
#pragma unroll
                for (int bj = 0; bj < 2; ++bj) { const f32x4 v0 = acc[ai][bj][m][0], v1 = acc[ai][bj][m][1];
                    u32x4 w; w.x = pk2(v0[0], v0[1]); w.y = pk2(v0[2], v0[3]); w.z = pk2(v1[0], v1[1]); w.w = pk2(v1[2], v1[3]);
                    *(u32x4*)(rowp + bj * 128) = w; }
            }
    }
};
struct EpiBf16 {
    bf16_t* O; int ldo;
    __device__ __forceinline__ void operator()(Acc& acc, const Unit& u, int wr, int wc, int fr, int fq) const {
        const int row0 = u.e0 * 256 + wr * 64 + fr, col0 = u.e1 * 256 + wc * 32 + 8 * fq;
#pragma unroll
        for (int ai = 0; ai < 2; ++ai)
#pragma unroll
            for (int m = 0; m < 4; ++m) {
                bf16_t* rowp = O + (size_t)(row0 + ai * 128 + m * 16) * ldo + col0;
#pragma unroll
                for (int bj = 0; bj < 2; ++bj) { const f32x4 v0 = acc[ai][bj][m][0], v1 = acc[ai][bj][m][1];
                    u32x4 w; w.x = pk2(v0[0], v0[1]); w.y = pk2(v0[2], v0[3]); w.z = pk2(v1[0], v1[1]); w.w = pk2(v1[2], v1[3]);
                    *(u32x4*)(rowp + bj * 128) = w; }
            }
    }
};

struct Args { const float* in[30]; float* out; unsigned char* ws; int ph_lo, ph_hi; };
typedef const __attribute__((address_space(4))) Args* KA;
__device__ __forceinline__ KA kargs() { auto kp = __builtin_amdgcn_kernarg_segment_ptr(); asm volatile("" : "+s"(kp)); return (KA)kp; }

struct CvtSrc { const float* W; bf16_t* WT; int K, N, up, item; };
__device__ __forceinline__ void cvt_load(const CvtSrc& c, int lane, f32x4 (&r)[16]) {
    const int nblk = c.N / 64, kb = c.item / nblk, nb = c.item % nblk, k0 = 64 * kb, n0 = 64 * nb;
    const int cc = lane & 15, q = lane >> 4;
#pragma unroll
    for (int i = 0; i < 16; ++i) { const int kk = 8 * (i >> 1) + 2 * q + (i & 1); r[i] = *(const f32x4*)(c.W + (size_t)(k0 + kk) * c.N + n0 + 4 * cc); }
}
__device__ __forceinline__ void cvt_store(const CvtSrc& c, int lane, const f32x4 (&r)[16], LAS unsigned* scr) {
    const int nblk = c.N / 64, kb = c.item / nblk, nb = c.item % nblk, k0 = 64 * kb, n0 = 64 * nb;
    const int cc = lane & 15, q = lane >> 4;
#pragma unroll
    for (int ip = 0; ip < 8; ++ip)
#pragma unroll
        for (int e = 0; e < 4; ++e) scr[(4 * cc + e) * 33 + 4 * ip + q] = pk2(r[2 * ip][e], r[2 * ip + 1][e]);
    LDS_WAIT(); asm volatile("" ::: "memory");
    const int c8 = lane & 7;
#pragma unroll
    for (int j = 0; j < 8; ++j) { const int n = (lane >> 3) + 8 * j; const LAS unsigned* sp = scr + n * 33 + 4 * c8;
        u32x4 o; o.x = sp[0]; o.y = sp[1]; o.z = sp[2]; o.w = sp[3];
        int nn = n0 + n;
        if (c.up) { const int bjj = nn >= DFF ? 1 : 0, cgc = nn - bjj * DFF; nn = (cgc >> 7) * 256 + bjj * 128 + (cgc & 127); }
        *(u32x4*)(c.WT + (size_t)nn * c.K + k0 + 8 * c8) = o; }
    LDS_WAIT(); asm volatile("" ::: "memory");
}
__device__ __forceinline__ bool cvt_pick(KA a, int set, int it, CvtSrc& c) {
    unsigned char* ws = a->ws;
    constexpr int I_IN = 32 * (INW / 64), I_O = 32 * (D / 64), I_UP = 32 * (DFF2 / 64), I_DN = (DFF / 64) * (D / 64);
    if (set == 0) { if (it >= I_IN) return false; c.W = a->in[8]; c.WT = (bf16_t*)(ws + WS_WIN); c.K = D; c.N = INW; c.up = 0; c.item = it; return true; }
    if (it >= I_O + I_UP + I_DN) return false;
    int r = it;
    if (r < I_O) { c.W = a->in[set == 1 ? 14 : 23]; c.WT = (bf16_t*)(ws + (set == 1 ? WS_WOUT0 : WS_WOUT1)); c.K = D; c.N = D; c.up = 0; c.item = r; return true; } r -= I_O;
    if (r < I_UP) { c.W = a->in[set == 1 ? 16 : 25]; c.WT = (bf16_t*)(ws + (set == 1 ? WS_WUP0 : WS_WUP1)); c.K = D; c.N = DFF2; c.up = 1; c.item = r; return true; } r -= I_UP;
    c.W = a->in[set == 1 ? 19 : 28]; c.WT = (bf16_t*)(ws + (set == 1 ? WS_WDN0 : WS_WDN1)); c.K = DFF; c.N = D; c.up = 0; c.item = r; return true;
}
__device__ __forceinline__ void convert_set(KA a, LAS unsigned char* lds, int set, int gw, int NGW, int i0 = 0, int i1 = 1 << 30) {
    const int lane = threadIdx.x & 63, wave = __builtin_amdgcn_readfirstlane(threadIdx.x >> 6);
    LAS unsigned* scr = (LAS unsigned*)(lds + wave * 8448);
    CvtSrc cur, nxt; f32x4 r0[16], r1[16];
    int it = i0 + gw;
    if (it >= i1 || !cvt_pick(a, set, it, cur)) return;
    cvt_load(cur, lane, r0);
    for (;;) {
        it += NGW; const bool h1 = it < i1 && cvt_pick(a, set, it, nxt);
        if (h1) cvt_load(nxt, lane, r1);
        cvt_store(cur, lane, r0, scr);
        if (!h1) break;
        it += NGW; const bool h2 = it < i1 && cvt_pick(a, set, it, cur);
        if (h2) cvt_load(cur, lane, r0);
        cvt_store(nxt, lane, r1, scr);
        if (!h2) break;
    }
}
__device__ __forceinline__ void dft_tables(unsigned char* ws, int gt, int GT) {
    bf16_t* DC = (bf16_t*)(ws + WS_DFTC); bf16_t* D256 = (bf16_t*)(ws + WS_DFT256); bf16_t* D1024 = (bf16_t*)(ws + WS_DFT1024);
    for (int i = gt; i < 1024 * 512; i += GT) { const int r = i >> 9, k = i & 511, c = r & 511; const float ang = 2.0f * (float)((c * k) & 511) * (1.0f / 512.0f);
        const float v = (r < 512 ? cospif(ang) : sinpif(ang)) * 0.04419417382415922f; DC[i] = (bf16_t)f2bf(v); }
    for (int i = gt; i < 256 * 512; i += GT) { const int p = i >> 9, k = i & 511, n = k & 255; const float ang = 2.0f * (float)((p * n) & 255) * (1.0f / 256.0f);
        const float v = (k < 256 ? cospif(ang) : -sinpif(ang)) * 0.0625f; D256[i] = (bf16_t)f2bf(v); }
    for (int i = gt; i < 1024 * 2048; i += GT) { const int p = i >> 11, k = i & 2047, n = k & 1023; const float ang = 2.0f * (float)((p * n) & 1023) * (1.0f / 1024.0f);
        const float v = (k < 1024 ? cospif(ang) : -sinpif(ang)) * 0.03125f; D1024[i] = (bf16_t)f2bf(v); }
}
__device__ __forceinline__ void phase_prologue(KA a, LAS unsigned char* lds, int vcu, int G) {
    const int tid = threadIdx.x, lane = tid & 63, wave = __builtin_amdgcn_readfirstlane(tid >> 6);
    unsigned char* ws = a->ws;
    __syncthreads();
    if (vcu < 192) {
        const int l = vcu / 96, n0 = (vcu % 96) * 128;
        const float* Wm = a->in[l ? 20 : 5]; const float* bm = a->in[l ? 21 : 6];
        LAS float* S = (LAS float*)lds;
        for (int i = tid; i < 2048 * 9; i += NT) { const int k = i / 9, bi = i % 9; const float cv = bi == 0 ? a->in[4][k] : a->in[3][(bi - 1) * 2048 + k]; S[k * 12 + bi] = silu_f(cv); }
        __syncthreads();
        const int l4 = tid & 31, rg = tid >> 5;
        f32x4 accm[9];
#pragma unroll
        for (int bi = 0; bi < 9; ++bi) accm[bi] = (f32x4){0.f, 0.f, 0.f, 0.f};
#pragma unroll 8
        for (int kk = 0; kk < 128; ++kk) {
            const int k = rg + 16 * kk;
            const f32x4 w = *(const f32x4*)(Wm + (size_t)k * 12288 + n0 + 4 * l4);
            const f32x4 s0 = *(const LAS f32x4*)(S + k * 12), s1 = *(const LAS f32x4*)(S + k * 12 + 4); const float s8 = S[k * 12 + 8];
            accm[0] += s0[0] * w; accm[1] += s0[1] * w; accm[2] += s0[2] * w; accm[3] += s0[3] * w;
            accm[4] += s1[0] * w; accm[5] += s1[1] * w; accm[6] += s1[2] * w; accm[7] += s1[3] * w; accm[8] += s8 * w;
        }
        __syncthreads();
        LAS float* red = (LAS float*)lds;
#pragma unroll
        for (int bi = 0; bi < 9; ++bi) *(LAS f32x4*)(red + (rg * 9 + bi) * 128 + 4 * l4) = accm[bi];
        __syncthreads();
        float* MOD = (float*)(ws + WS_MOD) + (size_t)l * 9 * 12288;
        for (int o = tid; o < 9 * 128; o += NT) { const int bi = o >> 7, n = o & 127; float s = bm[n0 + n];
#pragma unroll
            for (int r = 0; r < 16; ++r) s += red[(r * 9 + bi) * 128 + n];
            MOD[(size_t)bi * 12288 + n0 + n] = s; }
        __syncthreads();
    }
    __syncthreads();
    if (G == 256) { if (vcu >= 192) convert_set(a, lds, 0, (vcu - 192) * 8 + wave, 64 * 8); }
    else convert_set(a, lds, 0, vcu * 8 + wave, G * 8);
    if (G != 256) { convert_set(a, lds, 1, vcu * 8 + wave, G * 8); convert_set(a, lds, 2, vcu * 8 + wave, G * 8); dft_tables(ws, vcu * NT + tid, G * NT); }
}

__device__ __forceinline__ void phase_norm_mod(const float* x0, const float* x1, const float* nw, const float* sh, const float* sc, bf16_t* H, int vcu, int G) {
    const int lane = threadIdx.x & 63, wave = __builtin_amdgcn_readfirstlane(threadIdx.x >> 6);
    const int gw = vcu * 8 + wave, NGW = G * 8;
    for (int row = gw; row < T; row += NGW) {
        const float* xr = row < TCTX ? x0 + (size_t)row * D : x1 + (size_t)(row - TCTX) * D;
        const int bi = row < TCTX ? 0 : 1 + ((row - TCTX) >> 10);
        f32x4 v[8]; float s = 0.f;
#pragma unroll
        for (int j = 0; j < 8; ++j) { v[j] = *(const f32x4*)(xr + 4 * lane + 256 * j); s += (v[j][0] * v[j][0] + v[j][1] * v[j][1]) + (v[j][2] * v[j][2] + v[j][3] * v[j][3]); }
        const float rstd = rsqrtf(wave_sum(s) * (1.0f / D) + 1e-6f);
        const float* shp = sh + (size_t)bi * 12288; const float* scp = sc + (size_t)bi * 12288;
#pragma unroll
        for (int j = 0; j < 8; ++j) { const int c = 4 * lane + 256 * j;
            const f32x4 w = *(const f32x4*)(nw + c), a1 = *(const f32x4*)(scp + c), a0 = *(const f32x4*)(shp + c);
            f32x4 o;
#pragma unroll
            for (int e = 0; e < 4; ++e) o[e] = v[j][e] * rstd * w[e] * (1.0f + a1[e]) + a0[e];
            u32x2 p; p.x = pk2(o[0], o[1]); p.y = pk2(o[2], o[3]);
            *(u32x2*)(H + (size_t)row * D + c) = p; }
    }
}
__device__ __forceinline__ void phase_final_norm(float* X, const float* nw, int vcu, int G) {
    const int lane = threadIdx.x & 63, wave = __builtin_amdgcn_readfirstlane(threadIdx.x >> 6);
    const int gw = vcu * 8 + wave, NGW = G * 8;
    for (int row = gw; row < T; row += NGW) {
        float* xr = X + (size_t)row * D;
        f32x4 v[8]; float s = 0.f;
#pragma unroll
        for (int j = 0; j < 8; ++j) { v[j] = *(const f32x4*)(xr + 4 * lane + 256 * j); s += (v[j][0] * v[j][0] + v[j][1] * v[j][1]) + (v[j][2] * v[j][2] + v[j][3] * v[j][3]); }
        const float rstd = rsqrtf(wave_sum(s) * (1.0f / D) + 1e-6f);
#pragma unroll
        for (int j = 0; j < 8; ++j) { const int c = 4 * lane + 256 * j; const f32x4 w = *(const f32x4*)(nw + c); *(f32x4*)(xr + c) = v[j] * rstd * w; }
    }
}

constexpr int P128 = 136, P64 = 72;
constexpr int SC_QS = 0, SC_KS = SC_QS + 64 * P128 * 2, SC_QI = SC_KS + 64 * P128 * 2, SC_KO = SC_QI + 64 * P128 * 2, SC_VT = SC_KO + 128 * P64 * 2,
              SC_SC = SC_VT + 128 * P64 * 2, SC_ST = SC_SC + 64 * P64 * 2, SC_TOT = SC_ST + 128 * P128 * 2, SC_DEC = SC_TOT + 4 * 128 * 4, SC_END = SC_DEC + 128 * 4;
static_assert(SC_END <= LDS_BYTES, "scan LDS");
__device__ __forceinline__ void scan_item(KA a, LAS unsigned char* lds, int seqbase, int N, int b_state, int h, int dir, bool ctx, int b_out) {
    const int tid = threadIdx.x, lane = tid & 63, w = __builtin_amdgcn_readfirstlane(tid >> 6), fr = lane & 15, fq = lane >> 4;
    unsigned char* ws = a->ws;
    const bf16_t* Qg = (const bf16_t*)(ws + WS_Q) + h * 128; const bf16_t* Vg = (const bf16_t*)(ws + WS_V) + h * 128;
    const float* LFg = (const float*)(ws + WS_LF) + dir * 1024 + h * 128;
    float* Og = (float*)(ws + (dir ? WS_OB : WS_OF)) + h * 128;
    LAS bf16_t* QS = (LAS bf16_t*)(lds + SC_QS); LAS bf16_t* KS = (LAS bf16_t*)(lds + SC_KS); LAS bf16_t* QI = (LAS bf16_t*)(lds + SC_QI);
    LAS bf16_t* KO = (LAS bf16_t*)(lds + SC_KO); LAS bf16_t* VT = (LAS bf16_t*)(lds + SC_VT); LAS bf16_t* SCm = (LAS bf16_t*)(lds + SC_SC);
    LAS bf16_t* ST = (LAS bf16_t*)(lds + SC_ST); LAS float* TOT = (LAS float*)(lds + SC_TOT); LAS float* DEC = (LAS float*)(lds + SC_DEC);
    const int ch = tid & 127, seg = tid >> 7;
    f32x4 accS[8];
    if (ctx) {
#pragma unroll
        for (int kt = 0; kt < 8; ++kt) accS[kt] = (f32x4){0.f, 0.f, 0.f, 0.f};
    } else {
        const float* s0 = a->in[2] + ((size_t)(b_state * 2 + dir) * 8 + h) * 16384;
#pragma unroll
        for (int kt = 0; kt < 8; ++kt)
#pragma unroll
            for (int e = 0; e < 4; ++e) accS[kt][e] = s0[(16 * kt + 4 * fq + e) * 128 + 16 * w + fr];
    }
    __syncthreads();
#pragma unroll
    for (int kt = 0; kt < 8; ++kt) { u32x2 p; p.x = pk2(accS[kt][0], accS[kt][1]); p.y = pk2(accS[kt][2], accS[kt][3]); *(LAS u32x2*)(ST + (16 * w + fr) * P128 + 16 * kt + 4 * fq) = p; }
    const int nc = N >> 6;
    for (int c = 0; c < nc; ++c) {
        float lf[16], qv[16]; unsigned short vv16[16];
#pragma unroll
        for (int ii = 0; ii < 16; ++ii) {
            const int i = 64 * c + 16 * seg + ii; const int tok = seqbase + (dir ? N - 1 - i : i);
            lf[ii] = LFg[(unsigned)tok * 2048u + (unsigned)ch]; qv[ii] = bf2f(Qg[(unsigned)tok * 1024u + (unsigned)ch]); vv16[ii] = Vg[(unsigned)tok * 1024u + (unsigned)ch];
        }
        float run = 0.f;
#pragma unroll
        for (int ii = 0; ii < 16; ++ii) run += lf[ii];
        TOT[seg * 128 + ch] = run;
        __syncthreads();
        const float t0 = TOT[ch], t1 = TOT[128 + ch], t2 = TOT[256 + ch], t3 = TOT[384 + ch];
        const float offs = seg == 0 ? 0.f : seg == 1 ? t0 : seg == 2 ? t0 + t1 : t0 + t1 + t2;
        const float ref = t0 + t1, blast = (t0 + t1) + (t2 + t3);
        if (seg == 0) DEC[ch] = __expf(blast);
        float brun = offs;
        unsigned kow[8], vtw[8];
#pragma unroll
        for (int ii = 0; ii < 16; ii += 2) {
            float ko2[2];
#pragma unroll
            for (int d = 0; d < 2; ++d) {
                const int i2 = ii + d, i = 16 * seg + i2; brun += lf[i2]; const float b = brun; const float kf = 1.0f - __expf(lf[i2]);
                QS[i * P128 + ch] = (bf16_t)f2bf(qv[i2] * __expf(b - ref));
                KS[i * P128 + ch] = (bf16_t)f2bf(kf * __expf(ref - b));
                QI[i * P128 + ch] = (bf16_t)f2bf(qv[i2] * __expf(b));
                ko2[d] = kf * __expf(blast - b);
            }
            kow[ii >> 1] = pk2(ko2[0], ko2[1]); vtw[ii >> 1] = (unsigned)vv16[ii] | ((unsigned)vv16[ii + 1] << 16);
        }
        *(LAS u32x4*)(KO + ch * P64 + 16 * seg) = (u32x4){kow[0], kow[1], kow[2], kow[3]}; *(LAS u32x4*)(KO + ch * P64 + 16 * seg + 8) = (u32x4){kow[4], kow[5], kow[6], kow[7]};
        *(LAS u32x4*)(VT + ch * P64 + 16 * seg) = (u32x4){vtw[0], vtw[1], vtw[2], vtw[3]}; *(LAS u32x4*)(VT + ch * P64 + 16 * seg + 8) = (u32x4){vtw[4], vtw[5], vtw[6], vtw[7]};
        __syncthreads();
        {
            const int it = w >> 1;
#pragma unroll
            for (int jj = 0; jj < 2; ++jj) {
                const int jt = 2 * (w & 1) + jj;
                f32x4 d = (f32x4){0.f, 0.f, 0.f, 0.f};
                if (jt <= it) {
#pragma unroll
                    for (int ks = 0; ks < 4; ++ks) {
                        const bf16x8 af = *(const LAS bf16x8*)(KS + (16 * jt + fr) * P128 + 32 * ks + 8 * fq);
                        const bf16x8 bf = *(const LAS bf16x8*)(QS + (16 * it + fr) * P128 + 32 * ks + 8 * fq);
                        d = __builtin_amdgcn_mfma_f32_16x16x32_bf16(af, bf, d, 0, 0, 0);
                    }
                }
                const int i = 16 * it + fr, j0 = 16 * jt + 4 * fq;
#pragma unroll
                for (int e = 0; e < 4; ++e) if (j0 + e > i) d[e] = 0.f;
                u32x2 p; p.x = pk2(d[0], d[1]); p.y = pk2(d[2], d[3]);
                *(LAS u32x2*)(SCm + i * P64 + j0) = p;
            }
        }
        __syncthreads();
        f32x4 oacc[4];
#pragma unroll
        for (int it = 0; it < 4; ++it) oacc[it] = (f32x4){0.f, 0.f, 0.f, 0.f};
        {
            bf16x8 stf[4], vtf[2];
#pragma unroll
            for (int ks = 0; ks < 4; ++ks) stf[ks] = *(const LAS bf16x8*)(ST + (16 * w + fr) * P128 + 32 * ks + 8 * fq);
#pragma unroll
            for (int ks = 0; ks < 2; ++ks) vtf[ks] = *(const LAS bf16x8*)(VT + (16 * w + fr) * P64 + 32 * ks + 8 * fq);
#pragma unroll
            for (int it = 0; it < 4; ++it) {
#pragma unroll
                for (int ks = 0; ks < 4; ++ks) { const bf16x8 qf = *(const LAS bf16x8*)(QI + (16 * it + fr) * P128 + 32 * ks + 8 * fq); oacc[it] = __builtin_amdgcn_mfma_f32_16x16x32_bf16(stf[ks], qf, oacc[it], 0, 0, 0); }
#pragma unroll
                for (int ks = 0; ks < 2; ++ks) { const bf16x8 sf = *(const LAS bf16x8*)(SCm + (16 * it + fr) * P64 + 32 * ks + 8 * fq); oacc[it] = __builtin_amdgcn_mfma_f32_16x16x32_bf16(vtf[ks], sf, oacc[it], 0, 0, 0); }
            }
#pragma unroll
            for (int kt = 0; kt < 8; ++kt) {
                const f32x4 dc = *(const LAS f32x4*)(DEC + 16 * kt + 4 * fq);
                accS[kt] = accS[kt] * dc;
#pragma unroll
                for (int ks = 0; ks < 2; ++ks) { const bf16x8 kf = *(const LAS bf16x8*)(KO + (16 * kt + fr) * P64 + 32 * ks + 8 * fq); accS[kt] = __builtin_amdgcn_mfma_f32_16x16x32_bf16(kf, vtf[ks], accS[kt], 0, 0, 0); }
            }
        }
#pragma unroll
        for (int it = 0; it < 4; ++it) { const int i = 64 * c + 16 * it + fr; const int tok = seqbase + (dir ? N - 1 - i : i); *(f32x4*)(Og + (size_t)tok * 1024 + 16 * w + 4 * fq) = oacc[it]; }
#pragma unroll
        for (int kt = 0; kt < 8; ++kt) { u32x2 p; p.x = pk2(accS[kt][0], accS[kt][1]); p.y = pk2(accS[kt][2], accS[kt][3]); *(LAS u32x2*)(ST + (16 * w + fr) * P128 + 16 * kt + 4 * fq) = p; }
    }
    if (ctx) {
        float* so = a->out + (size_t)T * D + ((size_t)(b_out * 2 + dir) * 8 + h) * 16384;
#pragma unroll
        for (int kt = 0; kt < 8; ++kt)
#pragma unroll
            for (int e = 0; e < 4; ++e) so[(16 * kt + 4 * fq + e) * 128 + 16 * w + fr] = accS[kt][e];
    }
}

constexpr int MB_WS = 0, MB_BV = 128 * P128 * 2, MB_END = MB_BV + 256 * P128 * 2;
static_assert(MB_END <= LDS_BYTES, "mixer-B LDS");
__device__ __forceinline__ void mixb_item(KA a, LAS unsigned char* lds, int cbk, int g) {
    const int tid = threadIdx.x, lane = tid & 63, w = __builtin_amdgcn_readfirstlane(tid >> 6), fr = lane & 15, fq = lane >> 4;
    unsigned char* ws = a->ws;
    LAS bf16_t* WSl = (LAS bf16_t*)(lds + MB_WS); LAS bf16_t* BV = (LAS bf16_t*)(lds + MB_BV);
    const bf16_t* VVg = (const bf16_t*)(ws + WS_VV) + (size_t)cbk * 128 * 1024 + g * 256;
    const bf16_t* Ug = (const bf16_t*)(ws + WS_U) + (size_t)cbk * 128 * 1024 + g * 256;
    bf16_t* CAT = (bf16_t*)(ws + WS_CAT) + (size_t)cbk * 128 * D + 1024 + g * 256;
    const float* wsg = a->in[12] + (size_t)g * 16384; const float* vn = a->in[11] + g * 256; const float* bsg = a->in[13] + g * 128;
    __syncthreads();
#pragma unroll
    for (int j = 0; j < 8; ++j) { const int idx = (tid + j * NT) * 4, p = idx >> 7, q = idx & 127; const f32x4 v = *(const f32x4*)(wsg + idx);
        u32x2 o; o.x = pk2(v[0], v[1]); o.y = pk2(v[2], v[3]); *(LAS u32x2*)(WSl + p * P128 + q) = o; }
    {
        const int q = tid >> 2, qt = tid & 3;
        u32x4 raw[8]; float ss = 0.f;
#pragma unroll
        for (int j = 0; j < 8; ++j) { raw[j] = *(const u32x4*)(VVg + (size_t)q * 1024 + qt * 64 + 8 * j);
#pragma unroll
            for (int e = 0; e < 4; ++e) { const float lo = bflo(raw[j][e]), hi = bfhi(raw[j][e]); ss += lo * lo + hi * hi; } }
        ss += __shfl_xor(ss, 1); ss += __shfl_xor(ss, 2);
        const float rstd = rsqrtf(ss * (1.0f / 256.0f) + 1e-6f);
#pragma unroll
        for (int j = 0; j < 8; ++j)
#pragma unroll
            for (int e = 0; e < 4; ++e) { const int c = qt * 64 + 8 * j + 2 * e;
                BV[c * P128 + q] = (bf16_t)f2bf(bflo(raw[j][e]) * rstd * vn[c]); BV[(c + 1) * P128 + q] = (bf16_t)f2bf(bfhi(raw[j][e]) * rstd * vn[c + 1]); }
    }
    __syncthreads();
    const int wr2 = w >> 2, wc2 = w & 3;
    f32x4 acc[4][4];
#pragma unroll
    for (int mt = 0; mt < 4; ++mt)
#pragma unroll
        for (int nt = 0; nt < 4; ++nt) acc[mt][nt] = (f32x4){0.f, 0.f, 0.f, 0.f};
#pragma unroll
    for (int ks = 0; ks < 4; ++ks) {
        bf16x8 wf[4], vf[4];
#pragma unroll
        for (int mt = 0; mt < 4; ++mt) wf[mt] = *(const LAS bf16x8*)(WSl + (64 * wr2 + 16 * mt + fr) * P128 + 32 * ks + 8 * fq);
#pragma unroll
        for (int nt = 0; nt < 4; ++nt) vf[nt] = *(const LAS bf16x8*)(BV + (64 * wc2 + 16 * nt + fr) * P128 + 32 * ks + 8 * fq);
#pragma unroll
        for (int mt = 0; mt < 4; ++mt)
#pragma unroll
            for (int nt = 0; nt < 4; ++nt) acc[mt][nt] = __builtin_amdgcn_mfma_f32_16x16x32_bf16(vf[nt], wf[mt], acc[mt][nt], 0, 0, 0);
    }
#pragma unroll
    for (int mt = 0; mt < 4; ++mt) {
        const int p = 64 * wr2 + 16 * mt + fr; const float bsv = bsg[p];
#pragma unroll
        for (int nt = 0; nt < 4; ++nt) { const int c = 64 * wc2 + 16 * nt + 4 * fq;
            const u32x2 uu = *(const u32x2*)(Ug + (size_t)p * 1024 + c);
            u32x2 o; o.x = pk2(bflo(uu.x) * (acc[mt][nt][0] + bsv), bfhi(uu.x) * (acc[mt][nt][1] + bsv)); o.y = pk2(bflo(uu.y) * (acc[mt][nt][2] + bsv), bfhi(uu.y) * (acc[mt][nt][3] + bsv));
            *(u32x2*)(CAT + (size_t)p * D + c) = o; }
    }
}
__device__ __forceinline__ void mixer_work(KA a, LAS unsigned char* lds, int it) {
    if (it < 128) { const int s = it >> 4, h = (it >> 1) & 7, dir = it & 1; scan_item(a, lds, TCTX + 1024 * s, 1024, s, h, dir, false, 0); }
    else if (it < 384) { const int j = it - 128, s = j >> 4, h = (j >> 1) & 7, dir = j & 1; scan_item(a, lds, 256 * s, 256, 0, h, dir, true, s); }
    else { const int j = it - 384; mixb_item(a, lds, j >> 2, j & 3); }
}
__device__ __forceinline__ void phase_mixers(KA a, LAS unsigned char* lds, int vcu, int G) {
    if (G == 256) {
        const int j = vcu - 128, n = vcu < 128 ? 1 : 5;
        for (int q = 0; q < n; ++q) { const int it = vcu < 128 ? vcu : (q < 2 ? 128 + 2 * j + q : 384 + 3 * j + (q - 2)); mixer_work(a, lds, it); }
    } else { for (int it = vcu; it < 768; it += G) mixer_work(a, lds, it); }
}
__device__ __forceinline__ void phase_finalize_a(KA a, int vcu, int G) {
    const int lane = threadIdx.x & 63, wave = __builtin_amdgcn_readfirstlane(threadIdx.x >> 6);
    const int gw = vcu * 8 + wave, NGW = G * 8;
    unsigned char* ws = a->ws;
    const float* OF = (const float*)(ws + WS_OF); const float* OB = (const float*)(ws + WS_OB); const bf16_t* GA = (const bf16_t*)(ws + WS_GA); bf16_t* CAT = (bf16_t*)(ws + WS_CAT);
    const int col = (lane >> 3) * 128 + (lane & 7) * 16, vc = (lane & 7) * 16;
    f32x4 gn[4];
#pragma unroll
    for (int j = 0; j < 4; ++j) gn[j] = *(const f32x4*)(a->in[10] + vc + 4 * j);
    for (int row = gw; row < T; row += NGW) {
        f32x4 v[4]; float ss = 0.f;
#pragma unroll
        for (int j = 0; j < 4; ++j) { v[j] = *(const f32x4*)(OF + (size_t)row * 1024 + col + 4 * j) + *(const f32x4*)(OB + (size_t)row * 1024 + col + 4 * j); ss += (v[j][0] * v[j][0] + v[j][1] * v[j][1]) + (v[j][2] * v[j][2] + v[j][3] * v[j][3]); }
        ss += __shfl_xor(ss, 1); ss += __shfl_xor(ss, 2); ss += __shfl_xor(ss, 4);
        const float rstd = rsqrtf(ss * (1.0f / 128.0f) + 1e-6f);
        const u32x4 g0 = *(const u32x4*)(GA + (size_t)row * 1024 + col), g1 = *(const u32x4*)(GA + (size_t)row * 1024 + col + 8);
        u32x4 o0, o1;
#pragma unroll
        for (int e = 0; e < 4; ++e) {
            const int j = e >> 1, k = (e & 1) * 2;
            o0[e] = pk2(v[j][k] * rstd * gn[j][k] * bflo(g0[e]), v[j][k + 1] * rstd * gn[j][k + 1] * bfhi(g0[e]));
            o1[e] = pk2(v[2 + j][k] * rstd * gn[2 + j][k] * bflo(g1[e]), v[2 + j][k + 1] * rstd * gn[2 + j][k + 1] * bfhi(g1[e]));
        }
        *(u32x4*)(CAT + (size_t)row * D + col) = o0; *(u32x4*)(CAT + (size_t)row * D + col + 8) = o1;
    }
}


#define XB_TMO      128
#define XB_XCNT(j)  (256  + 64 * (j))
#define XB_XSUB(j)  (1280 + 64 * (j))
#define XB_XGEN(j)  (2304 + 64 * (j))
#define XB_TOP      3328
#define XB_TOPGEN   3392
#define XCD_BAR_WORDS 3456
#define XB_SPIN_CAP (1u << 18)
__device__ __forceinline__ unsigned xb_ld(unsigned* p)              { return __hip_atomic_load(p, __ATOMIC_RELAXED, __HIP_MEMORY_SCOPE_AGENT); }
__device__ __forceinline__ unsigned xb_add(unsigned* p, unsigned v) { return __hip_atomic_fetch_add(p, v, __ATOMIC_RELAXED, __HIP_MEMORY_SCOPE_AGENT); }
__device__ __forceinline__ unsigned xb_xcc_id() { return (unsigned)__builtin_amdgcn_s_getreg((3 << 11) | 20) & 0xFu; }
#define XB_SPIN(cond, bar) do { unsigned _sp = 0; while (cond) { __builtin_amdgcn_s_sleep(1); \
    if ((++_sp & 255u) == 0u) { if (xb_ld(&(bar)[XB_TMO])) break; if (_sp > XB_SPIN_CAP) { atomicAdd(&(bar)[XB_TMO], 1u); break; } } } } while (0)
struct XcdBarrier { unsigned* bar; unsigned x; volatile LAS unsigned* st; };
__device__ __forceinline__ XcdBarrier xcd_barrier_post(unsigned* bar, volatile LAS unsigned* st) {
    XcdBarrier b; b.bar = bar; b.x = xb_xcc_id(); b.st = st;
    if (threadIdx.x == 0) (void)xb_add(&bar[XB_XCNT(b.x)], 1u);
    return b;
}
__device__ __forceinline__ void xcd_barrier_complete(unsigned* bar, unsigned x, unsigned& nloc, unsigned& nx) {
    const unsigned G = gridDim.x * gridDim.y * gridDim.z;
    unsigned sum, cnt, mine, sp = 0u;
    for (;;) {
        sum = 0u; cnt = 0u; mine = 0u;
#pragma unroll
        for (unsigned j = 0; j < 16; ++j) { const unsigned c = xb_ld(&bar[XB_XCNT(j)]); sum += c; cnt += (c > 0u) ? 1u : 0u; mine = (j == x) ? c : mine; }
        if (sum == G) break;
        __builtin_amdgcn_s_sleep(1);
        if ((++sp & 255u) == 0u) { if (xb_ld(&bar[XB_TMO])) break; if (sp > XB_SPIN_CAP) { atomicAdd(&bar[XB_TMO], 1u); break; } }
    }
    nloc = mine > 0u ? mine : 1u; nx = cnt > 0u ? cnt : 1u;
}
__device__ __forceinline__ void xcd_barrier(const XcdBarrier& b) {
    asm volatile("s_waitcnt vmcnt(0)" ::: "memory");
    __syncthreads();
    if (threadIdx.x == 0) {
        unsigned* bar = b.bar;
        __builtin_amdgcn_s_waitcnt(0);
        unsigned nloc = b.st[0], nx = b.st[1];
        if (nloc == 0u) { xcd_barrier_complete(bar, b.x, nloc, nx); b.st[0] = nloc; b.st[1] = nx; }
        const unsigned old = xb_add(&bar[XB_XSUB(b.x)], 1u);
        const unsigned gen = old / nloc;
        if (old + 1u == (gen + 1u) * nloc) {
            __builtin_amdgcn_fence(__ATOMIC_RELEASE, "agent");
            asm volatile("s_waitcnt vmcnt(0)" ::: "memory");
            const unsigned og = xb_add(&bar[XB_TOP], 1u);
            const unsigned tg = og / nx;
            if (og + 1u == (tg + 1u) * nx) xb_add(&bar[XB_TOPGEN], 1u);
            else XB_SPIN(xb_ld(&bar[XB_TOPGEN]) == tg, bar);
            __builtin_amdgcn_fence(__ATOMIC_ACQUIRE, "agent");
            xb_add(&bar[XB_XGEN(b.x)], 1u);
            asm volatile("s_waitcnt vmcnt(0)" ::: "memory");
        } else {
            XB_SPIN(xb_ld(&bar[XB_XGEN(b.x)]) == gen, bar);
            __builtin_amdgcn_fence(__ATOMIC_ACQUIRE, "agent");
            asm volatile("s_waitcnt vmcnt(0)" ::: "memory");
        }
    }
    __syncthreads();
}

#ifndef PG8_SP2
#ifndef PG8_SP2
#define PG8_SP2 true
#endif
#endif
__global__ void __launch_bounds__(NT, 2) mk_fwd(Args a_) {
    KA a = kargs();
    extern __shared__ __attribute__((aligned(16))) unsigned char lds_raw[];
    LAS unsigned char* lds = (LAS unsigned char*)lds_raw;
    cg::grid_group grid = cg::this_grid();
    const int G = gridDim.x, bx = blockIdx.x;
    const int vcu = (G % 8 == 0) ? (bx % 8) * (G / 8) + bx / 8 : bx;
#define ws (a->ws)
    const int lo = a->ph_lo, hi = a->ph_hi;
    if (threadIdx.x < 16) ((LAS unsigned*)(lds + LDS_MISC))[threadIdx.x] = 0u;
    __syncthreads();
    (void)xcd_barrier_post((unsigned*)(ws + WS_CTL), (volatile LAS unsigned*)(lds + LDS_MISC));
    if (lo == -12345) grid.sync();
#define X (a->out)
#define MOD0 ((const float*)(ws + WS_MOD))
#define MOD1 (MOD0 + 9 * 12288)
#define Hb ((bf16_t*)(ws + WS_H))
#define CAT ((bf16_t*)(ws + WS_CAT))
#define ACT ((bf16_t*)(ws + WS_ACT))
#define PQT ((bf16_t*)(ws + WS_PQT))
#ifndef PHMASK
#define PHMASK 0x1FFFF
#endif
#define IN(k) (((PHMASK >> (k)) & 1) && lo <= (k) && (k) < hi)
#ifndef REPMASK
#define REPMASK 0
#endif
#ifndef REPN
#define REPN 2
#endif
#define REPS(k) for (int rep_ = 0; rep_ < (((REPMASK >> (k)) & 1) ? REPN : 1); ++rep_)
#define SEAM(k) do { if (IN(k) && IN((k) + 1)) { XcdBarrier b_; b_.bar = (unsigned*)(ws + WS_CTL); b_.x = xb_xcc_id(); b_.st = (volatile LAS unsigned*)(lds + LDS_MISC); xcd_barrier(b_); } a = kargs(); } while (0)

    if (IN(0)) REPS(0) phase_prologue(a, lds, vcu, G);
    SEAM(0);
    if (IN(1)) REPS(1) phase_norm_mod(a->in[0], a->in[1], a->in[7], MOD0, MOD0 + D, Hb, vcu, G);
    SEAM(1);
    if (IN(2)) {
        const int GG = G == 256 ? 224 : G;
        if (bx < GG) {
            SchedDense S{48, INW / 256, GG, bx, (const char*)Hb, (const char*)(ws + WS_WIN), (size_t)256 * D * 2, (size_t)256 * D * 2, ((REPMASK >> 2) & 1) ? REPN : 1};
            EpiInProj E{(bf16_t*)(ws + WS_Q), (bf16_t*)(ws + WS_V), (bf16_t*)(ws + WS_GA), (bf16_t*)(ws + WS_U), (bf16_t*)(ws + WS_VV), (float*)(ws + WS_LF), a->in[9]};
            pg8::gemm_phase<EpiInProj, SchedDense, PG8_SP2, 0>(lds, D, D, D / 64, (size_t)128 * D * 2, (size_t)128 * D * 2, S, E);
        } else {
            const int hw = (bx - GG) * 8 + __builtin_amdgcn_readfirstlane(threadIdx.x >> 6);
            convert_set(a, lds, 1, hw, (G - GG) * 8);
            convert_set(a, lds, 2, hw, (G - GG) * 8, 0, 4096);
            dft_tables(ws, (bx - GG) * NT + threadIdx.x, (G - GG) * NT);
        }
    }
    SEAM(2);
    if (IN(3)) REPS(3) phase_mixers(a, lds, vcu, G);
    SEAM(3);
    if (IN(4)) REPS(4) phase_finalize_a(a, vcu, G);
    SEAM(4);
    if (IN(5)) {
        SchedDense S{48, 8, G, bx, (const char*)CAT, (const char*)(ws + WS_WOUT0), (size_t)256 * D * 2, (size_t)256 * D * 2, ((REPMASK >> 5) & 1) ? REPN : 1};
        EpiResid E{a->in[0], a->in[1], X, MOD0 + 2 * D};
        pg8::gemm_phase<EpiResid, SchedDense, PG8_SP2, 0>(lds, D, D, D / 64, (size_t)128 * D * 2, (size_t)128 * D * 2, S, E);
    }
    SEAM(5);
    if (IN(6)) REPS(6) phase_norm_mod(X, X + (size_t)TCTX * D, a->in[15], MOD0 + 3 * D, MOD0 + 4 * D, Hb, vcu, G);
    SEAM(6);
    if (IN(7)) {
        const int GG = G == 256 ? 240 : G;
        if (bx < GG) {
            SchedDense S{48, DFF / 128, GG, bx, (const char*)Hb, (const char*)(ws + WS_WUP0), (size_t)256 * D * 2, (size_t)256 * D * 2, ((REPMASK >> 7) & 1) ? REPN : 1};
            EpiConv E{ACT, a->in[17], a->in[18], (LAS float*)(lds + LDS_XCH)};
            pg8::gemm_phase<EpiConv, SchedDense, PG8_SP2, 1>(lds, D, D, D / 64, (size_t)4 * D * 2, (size_t)128 * D * 2, S, E);
        } else convert_set(a, lds, 2, (bx - GG) * 8 + __builtin_amdgcn_readfirstlane(threadIdx.x >> 6), (G - GG) * 8, 4096);
    }
    SEAM(7);
    if (IN(8)) {
        SchedDense S{48, 8, G, bx, (const char*)ACT, (const char*)(ws + WS_WDN0), (size_t)256 * DFF * 2, (size_t)256 * DFF * 2, ((REPMASK >> 8) & 1) ? REPN : 1};
        EpiResid E{X, X + (size_t)TCTX * D, X, MOD0 + 5 * D};
        pg8::gemm_phase<EpiResid, SchedDense, PG8_SP2, 0>(lds, DFF, DFF, DFF / 64, (size_t)128 * DFF * 2, (size_t)128 * DFF * 2, S, E);
    }
    SEAM(8);
    if (IN(9)) REPS(9) phase_norm_mod(X, X + (size_t)TCTX * D, a->in[22], MOD1, MOD1 + D, Hb, vcu, G);
    SEAM(9);
    if (IN(10)) REPS(10) {
        SchedF1 S{G, bx, (const char*)(ws + WS_DFTC), (const char*)Hb};
        EpiF1 E{PQT};
        pg8::gemm_phase<EpiF1, SchedF1, PG8_SP2, 0>(lds, 512, D, 8, (size_t)128 * 512 * 2, (size_t)128 * D * 2, S, E);
    }
    SEAM(10);
    if (IN(11)) REPS(11) {
        { SchedF2 S{G, bx, 1, (const char*)(ws + WS_DFT1024), (const char*)PQT}; EpiBf16 E{CAT, D};
          pg8::gemm_phase<EpiBf16, SchedF2, PG8_SP2, 0>(lds, 2048, 2 * T, 32, (size_t)128 * 2048 * 2, (size_t)128 * 2 * T * 2, S, E); }
        { SchedF2 S{G, bx, 0, (const char*)(ws + WS_DFT256), (const char*)PQT}; EpiBf16 E{CAT, D};
          pg8::gemm_phase<EpiBf16, SchedF2, PG8_SP2, 0>(lds, 512, 2 * T, 8, (size_t)128 * 512 * 2, (size_t)128 * 2 * T * 2, S, E); }
    }
    SEAM(11);
    if (IN(12)) {
        SchedDense S{48, 8, G, bx, (const char*)CAT, (const char*)(ws + WS_WOUT1), (size_t)256 * D * 2, (size_t)256 * D * 2, ((REPMASK >> 12) & 1) ? REPN : 1};
        EpiResid E{X, X + (size_t)TCTX * D, X, MOD1 + 2 * D};
        pg8::gemm_phase<EpiResid, SchedDense, PG8_SP2, 0>(lds, D, D, D / 64, (size_t)128 * D * 2, (size_t)128 * D * 2, S, E);
    }
    SEAM(12);
    if (IN(13)) REPS(13) phase_norm_mod(X, X + (size_t)TCTX * D, a->in[24], MOD1 + 3 * D, MOD1 + 4 * D, Hb, vcu, G);
    SEAM(13);
    if (IN(14)) {
        SchedDense S{48, DFF / 128, G, bx, (const char*)Hb, (const char*)(ws + WS_WUP1), (size_t)256 * D * 2, (size_t)256 * D * 2, ((REPMASK >> 14) & 1) ? REPN : 1};
        EpiConv E{ACT, a->in[26], a->in[27], (LAS float*)(lds + LDS_XCH)};
        pg8::gemm_phase<EpiConv, SchedDense, PG8_SP2, 1>(lds, D, D, D / 64, (size_t)4 * D * 2, (size_t)128 * D * 2, S, E);
    }
    SEAM(14);
    if (IN(15)) {
        SchedDense S{48, 8, G, bx, (const char*)ACT, (const char*)(ws + WS_WDN1), (size_t)256 * DFF * 2, (size_t)256 * DFF * 2, ((REPMASK >> 15) & 1) ? REPN : 1};
        EpiResid E{X, X + (size_t)TCTX * D, X, MOD1 + 5 * D};
        pg8::gemm_phase<EpiResid, SchedDense, PG8_SP2, 0>(lds, DFF, DFF, DFF / 64, (size_t)128 * DFF * 2, (size_t)128 * DFF * 2, S, E);
    }
    SEAM(15);
    if (IN(16)) REPS(16) phase_final_norm(X, a->in[29], vcu, G);
#undef IN
#undef SEAM
#undef ws
#undef X
#undef MOD0
#undef MOD1
#undef Hb
#undef CAT
#undef ACT
#undef PQT
}

extern "C" void kernel_launch(void* const* d_in, const int* in_sizes, int n_in, void* d_out, int out_size, void* d_ws, size_t ws_size, hipStream_t stream) {
    static int grid = 0;
    if (grid == 0) {
        if (n_in != 30 || ws_size < WS_END) { fprintf(stderr, "kernel_launch: need 30 inputs and %zu bytes of workspace (got %d, %zu)\n", (size_t)WS_END, n_in, ws_size); grid = -1; return; }
        int dev = 0, cus = 0, per_cu = 0;
        if (hipGetDevice(&dev) != hipSuccess || hipDeviceGetAttribute(&cus, hipDeviceAttributeMultiprocessorCount, dev) != hipSuccess) { grid = -1; return; }
        if (hipFuncSetAttribute((const void*)mk_fwd, hipFuncAttributeMaxDynamicSharedMemorySize, LDS_BYTES) != hipSuccess) { fprintf(stderr, "kernel_launch: hipFuncSetAttribute failed\n"); grid = -1; return; }
        if (hipOccupancyMaxActiveBlocksPerMultiprocessor(&per_cu, (const void*)mk_fwd, NT, LDS_BYTES) != hipSuccess || per_cu < 1) { fprintf(stderr, "kernel_launch: occupancy query says %d blocks per CU\n", per_cu); grid = -1; return; }
        grid = cus;
    }
    if (grid < 0) return;
    if (hipMemsetAsync((char*)d_ws + WS_CTL, 0, 65536, stream) != hipSuccess) { fprintf(stderr, "kernel_launch: hipMemsetAsync failed\n"); return; }
    Args a{};
    for (int i = 0; i < 30; ++i) a.in[i] = (const float*)d_in[i];
    a.out = (float*)d_out; a.ws = (unsigned char*)d_ws;
#if MK_FUSED
    a.ph_lo = 0; a.ph_hi = NPH;
    void* args[] = {&a};
    hipError_t e = hipLaunchCooperativeKernel((const void*)mk_fwd, dim3(grid), dim3(NT), args, LDS_BYTES, stream);
    if (e != hipSuccess) fprintf(stderr, "cooperative launch failed: %s (grid %d)\n", hipGetErrorString(e), grid);
#else
    for (int p = 0; p < NPH; ++p) {
        a.ph_lo = p; a.ph_hi = p + 1;
        void* args[] = {&a};
        hipError_t e = hipLaunchCooperativeKernel((const void*)mk_fwd, dim3(grid), dim3(NT), args, LDS_BYTES, stream);
        if (e != hipSuccess) { fprintf(stderr, "launch %d failed: %s (grid %d)\n", p, hipGetErrorString(e), grid); break; }
    }
#endif
}
```

```cpp
#include <hip/hip_runtime.h>
#include <hip/hip_cooperative_groups.h>
#include <cstdio>
#include <cstdint>
namespace cg = cooperative_groups;

#ifndef MK_FUSED
#define MK_FUSED 1
#endif

#define LAS __attribute__((address_space(3)))
typedef unsigned short bf16_t;
typedef short bf16x8 __attribute__((ext_vector_type(8)));
typedef float f32x4 __attribute__((ext_vector_type(4)));
typedef float f32x2 __attribute__((ext_vector_type(2)));
typedef unsigned u32x4 __attribute__((ext_vector_type(4)));
typedef unsigned u32x2 __attribute__((ext_vector_type(2)));

constexpr int D = 2048, T = 12288, TCTX = 4096;
constexpr int DFF = 5632, DFF2 = 11264, INW = 7168, AW = 1024;
constexpr int NPH = 17;
constexpr int NT = 512;

constexpr size_t WS_CTL = 0;
constexpr size_t WS_MOD = 65536;
constexpr size_t WS_WIN = WS_MOD + (size_t)2 * 9 * 12288 * 4;
constexpr size_t WS_WOUT0 = WS_WIN + (size_t)INW * D * 2;
constexpr size_t WS_WUP0 = WS_WOUT0 + (size_t)D * D * 2;
constexpr size_t WS_WDN0 = WS_WUP0 + (size_t)DFF2 * D * 2;
constexpr size_t WS_WOUT1 = WS_WDN0 + (size_t)D * DFF * 2;
constexpr size_t WS_WUP1 = WS_WOUT1 + (size_t)D * D * 2;
constexpr size_t WS_WDN1 = WS_WUP1 + (size_t)DFF2 * D * 2;
constexpr size_t WS_DFTC = WS_WDN1 + (size_t)D * DFF * 2;
constexpr size_t WS_DFT256 = WS_DFTC + (size_t)1024 * 512 * 2;
constexpr size_t WS_DFT1024 = WS_DFT256 + (size_t)256 * 512 * 2;
constexpr size_t WS_H = WS_DFT1024 + (size_t)1024 * 2048 * 2;
constexpr size_t WS_CAT = WS_H + (size_t)T * D * 2;
constexpr size_t WS_R1 = WS_CAT + (size_t)T * D * 2;
constexpr size_t WS_Q = WS_R1;
constexpr size_t WS_V = WS_Q + (size_t)T * AW * 2;
constexpr size_t WS_GA = WS_V + (size_t)T * AW * 2;
constexpr size_t WS_U = WS_GA + (size_t)T * AW * 2;
constexpr size_t WS_VV = WS_U + (size_t)T * AW * 2;
constexpr size_t WS_LF = WS_VV + (size_t)T * AW * 2;
constexpr size_t WS_OF = WS_LF + (size_t)T * 2048 * 4;
constexpr size_t WS_OB = WS_OF + (size_t)T * AW * 4;
constexpr size_t WS_R1_END = WS_OB + (size_t)T * AW * 4;
constexpr size_t WS_ACT = WS_R1;
constexpr size_t WS_PQT = WS_R1;
constexpr size_t WS_END = WS_R1_END;
static_assert(WS_ACT + (size_t)T * DFF * 2 <= WS_R1_END && WS_PQT + (size_t)2048 * 2 * T * 2 <= WS_R1_END, "aliases fit");

constexpr int LDS_BYTES = 147456;
constexpr int LDS_XCH = 131072;
constexpr int LDS_MISC = 131072 + 8192;

__device__ __forceinline__ unsigned f2bf(float f) { unsigned u = __builtin_bit_cast(unsigned, f); return (u + 0x7fffu + ((u >> 16) & 1u)) >> 16; }
__device__ __forceinline__ unsigned pk2(float lo, float hi) { unsigned r; asm("v_cvt_pk_bf16_f32 %0, %1, %2" : "=v"(r) : "v"(lo), "v"(hi)); return r; }
__device__ __forceinline__ float bflo(unsigned w) { return __builtin_bit_cast(float, w << 16); }
__device__ __forceinline__ float bfhi(unsigned w) { return __builtin_bit_cast(float, w & 0xffff0000u); }
__device__ __forceinline__ float bf2f(bf16_t b) { return __builtin_bit_cast(float, (unsigned)b << 16); }
__device__ __forceinline__ float wave_sum(float v) {
#pragma unroll
    for (int o = 1; o < 64; o <<= 1) v += __shfl_xor(v, o);
    return v;
}
__device__ __forceinline__ float fast_sigmoid(float x) { return __builtin_amdgcn_rcpf(1.0f + __expf(-x)); }
__device__ __forceinline__ float silu_f(float x) { return x * fast_sigmoid(x); }
__device__ __forceinline__ float gelu_tanh_f(float x) { const float u = 1.5957691216057308f * (x + 0.044715f * x * x * x); return x * fast_sigmoid(u); }
__device__ __forceinline__ int row_bi(int pm) { return pm < 16 ? 0 : 1 + ((pm - 16) >> 2); }
#define LDS_WAIT() asm volatile("s_waitcnt lgkmcnt(0)" ::: "memory")

namespace pg8 {
constexpr int BM = 256, BK = 64, HALF = 128, HTB = HALF * BK * 2, NXCD = 8, WGM = 8;
__device__ __forceinline__ int lds_byte(int r, int c) { const int st = (r >> 4) * 2 + (c >> 5), rr = r & 15, cc = c & 31, ob = rr * 64 + cc * 2; return st * 1024 + (ob ^ (((ob >> 9) & 1) << 5)); }
__device__ __forceinline__ void stage_rc(int b, int& R, int& C) { const int st = b / 1024, sb = b % 1024, swz = sb ^ (((sb >> 9) & 1) << 5); R = (st >> 1) * 16 + swz / 64; C = (st & 1) * 32 + (swz % 64) / 2; }
__device__ __forceinline__ int perm32(int rho) { const int n = rho >> 4, i = rho & 15; return 8 * (i >> 2) + 4 * n + (i & 3); }
__device__ __forceinline__ int permA_conv(int R) { return 8 * (16 * (R >> 6) + (R & 15)) + ((R >> 4) & 3); }

struct Unit { const char* A; const char* B; int e0, e1, e2, nt, sp; };

__device__ __forceinline__ void tile_order(int L, int nM, int nN, int& pm, int& pn) {
    const int nwg = nM * nN; int wgid = L;
    { const int q = nwg / NXCD, r = nwg % NXCD, xcd = wgid % NXCD, off = wgid / NXCD; wgid = (xcd < r ? xcd * (q + 1) : r * (q + 1) + (xcd - r) * q) + off; }
    const int nig = WGM * nN, gid = wgid / nig, fm = gid * WGM, gsz = (nM - fm) < WGM ? (nM - fm) : WGM;
    pm = fm + ((wgid % nig) % gsz); pn = (wgid % nig) / gsz;
}

template <class Epi, class Sched, bool SP2, int PERMA, bool SPLIT = false>
__device__ __forceinline__ void gemm_phase(LAS unsigned char* lds, const int lda, const int ldb, const size_t hstepA, const size_t hstepB, const Sched& S, const Epi& E, float* slabs = nullptr, unsigned* scnt = nullptr) {
    const int tid = threadIdx.x, wid = __builtin_amdgcn_readfirstlane(tid >> 6), lane = tid & 63, wr = wid >> 2, wc = wid & 3, fr = lane & 15, fq = lane >> 4;
    unsigned voffA[2], voffB[2];
#pragma unroll
    for (int i = 0; i < 2; ++i) { int R, C; stage_rc(tid * 16 + i * 8192, R, C); const int Ra = PERMA ? permA_conv(R) : R; const int Rb = (R & ~31) + perm32(R & 31);
        voffA[i] = (unsigned)(Ra * lda + C) * 2u; voffB[i] = (unsigned)(Rb * ldb + C) * 2u; }
    const size_t kstep = (size_t)(BK * 2);
    const unsigned ldsw = (unsigned)wid * 1024u;
    const int aoff = lds_byte(wr * 64 + fr, fq * 8), boff = lds_byte(wc * 32 + fr, fq * 8);
#define PG8_SA(b, h) (((b) * 2 + (h)) * HTB)
#define PG8_SB(b, h) ((4 + (b) * 2 + (h)) * HTB)
#define PG8_STAGE(bufoff, gbase, voff) do { _Pragma("unroll") for (int _i = 0; _i < 2; ++_i) \
        __builtin_amdgcn_global_load_lds((const unsigned*)((const char*)(gbase) + (voff)[_i]), (LAS unsigned*)(lds + (bufoff) + ldsw + _i * 8192), 16, 0, 0); } while (0)
#define PG8_LDA(dst, b, h) do { _Pragma("unroll") for (int m = 0; m < 4; ++m) _Pragma("unroll") for (int k = 0; k < 2; ++k) dst[m][k] = *(const LAS bf16x8*)(lds + PG8_SA(b, h) + aoff + m * 2048 + k * 1024); } while (0)
#define PG8_LDB(dst, b, h) do { _Pragma("unroll") for (int n = 0; n < 2; ++n) _Pragma("unroll") for (int k = 0; k < 2; ++k) dst[n][k] = *(const LAS bf16x8*)(lds + PG8_SB(b, h) + boff + n * 2048 + k * 1024); } while (0)
#define PG8_MMA(ai, bj, At, Bt) do { __builtin_amdgcn_s_setprio(1); _Pragma("unroll") for (int m = 0; m < 4; ++m) _Pragma("unroll") for (int n = 0; n < 2; ++n) _Pragma("unroll") for (int k = 0; k < 2; ++k) \
        acc[ai][bj][m][n] = __builtin_amdgcn_mfma_f32_16x16x32_bf16(Bt[n][k], At[m][k], acc[ai][bj][m][n], 0, 0, 0); __builtin_amdgcn_s_setprio(0); } while (0)
#define PG8_WAIT_V(n) asm volatile("s_waitcnt vmcnt(" #n ")" ::: "memory")
#define PG8_WAIT_L(n) asm volatile("s_waitcnt lgkmcnt(" #n ")" ::: "memory")
#define PG8_BAR __builtin_amdgcn_s_barrier()
#define PG8_SCHED __builtin_amdgcn_sched_barrier(0)
    Unit cur, nxt; int ui = 0;
    if (!S.next(0, cur)) return;
    f32x4 acc[2][2][4][2];
#pragma unroll
    for (int a = 0; a < 2; ++a)
#pragma unroll
        for (int b = 0; b < 2; ++b)
#pragma unroll
            for (int m = 0; m < 4; ++m)
#pragma unroll
                for (int n = 0; n < 2; ++n) acc[a][b][m][n] = (f32x4){0.f, 0.f, 0.f, 0.f};
    bf16x8 At[4][2], B0[2][2], B1[2][2];
    const char* cA = cur.A; const char* cB = cur.B;
    if constexpr (SP2) {
        PG8_STAGE(PG8_SB(0, 0), cB, voffB); PG8_STAGE(PG8_SB(0, 1), cB + hstepB, voffB); PG8_STAGE(PG8_SA(0, 0), cA, voffA); PG8_STAGE(PG8_SA(0, 1), cA + hstepA, voffA);
        if (wr == 1) PG8_BAR;
        PG8_WAIT_V(2); PG8_BAR;
        PG8_STAGE(PG8_SB(1, 0), cB + kstep, voffB); PG8_STAGE(PG8_SA(1, 0), cA + kstep, voffA); PG8_STAGE(PG8_SB(1, 1), cB + hstepB + kstep, voffB);
        PG8_WAIT_V(6); PG8_BAR;
    } else {
        PG8_STAGE(PG8_SB(0, 0), cB, voffB); PG8_STAGE(PG8_SA(0, 0), cA, voffA); PG8_STAGE(PG8_SB(0, 1), cB + hstepB, voffB); PG8_STAGE(PG8_SA(0, 1), cA + hstepA, voffA);
        if (wr == 1) PG8_BAR;
        PG8_WAIT_V(4); PG8_BAR;
        PG8_STAGE(PG8_SB(1, 0), cB + kstep, voffB); PG8_STAGE(PG8_SA(1, 0), cA + kstep, voffA); PG8_STAGE(PG8_SB(1, 1), cB + hstepB + kstep, voffB);
        PG8_WAIT_V(6); PG8_BAR;
    }
    for (;;) {
        const bool has_next = S.next(ui + 1, nxt);
        const char* nA = has_next ? nxt.A : cA; const char* nB = has_next ? nxt.B : cB;
        const int nt = SPLIT ? cur.nt : S.nt;
        for (int t = 0; t < nt; t += 2) {
            const bool last = (t == nt - 2);
            const char* a1 = cA + (size_t)(t + 1) * kstep;
            const char* a2 = last ? nA : cA + (size_t)(t + 2) * kstep; const char* b2 = last ? nB : cB + (size_t)(t + 2) * kstep;
            const char* a3 = a2 + kstep; const char* b3 = b2 + kstep;
            if constexpr (SP2) {
            PG8_LDB(B0, 0, 0); PG8_LDB(B1, 0, 1); PG8_SCHED; PG8_LDA(At, 0, 0); PG8_STAGE(PG8_SA(1, 1), a1 + hstepA, voffA);
            PG8_WAIT_V(8); PG8_WAIT_L(0); PG8_BAR; PG8_MMA(0, 0, At, B0); PG8_MMA(0, 1, At, B1); PG8_BAR; PG8_SCHED;
            PG8_LDA(At, 0, 1); PG8_STAGE(PG8_SB(0, 0), b2, voffB); PG8_STAGE(PG8_SB(0, 1), b2 + hstepB, voffB); PG8_STAGE(PG8_SA(0, 0), a2, voffA);
            PG8_WAIT_V(8); PG8_WAIT_L(0); PG8_BAR; PG8_MMA(1, 0, At, B0); PG8_MMA(1, 1, At, B1); PG8_BAR; PG8_SCHED;
            PG8_LDB(B0, 1, 0); PG8_LDB(B1, 1, 1); PG8_SCHED; PG8_LDA(At, 1, 0); PG8_STAGE(PG8_SA(0, 1), a2 + hstepA, voffA);
            PG8_WAIT_V(8); PG8_WAIT_L(0); PG8_BAR; PG8_MMA(0, 0, At, B0); PG8_MMA(0, 1, At, B1); PG8_BAR; PG8_SCHED;
            PG8_LDA(At, 1, 1); PG8_STAGE(PG8_SB(1, 0), b3, voffB); PG8_STAGE(PG8_SB(1, 1), b3 + hstepB, voffB); PG8_STAGE(PG8_SA(1, 0), a3, voffA);
            PG8_WAIT_V(8); PG8_WAIT_L(0); PG8_BAR; PG8_MMA(1, 0, At, B0); PG8_MMA(1, 1, At, B1); PG8_BAR; PG8_SCHED;
            } else {
            PG8_LDB(B0, 0, 0); PG8_SCHED; PG8_LDA(At, 0, 0); PG8_STAGE(PG8_SA(1, 1), a1 + hstepA, voffA);
            PG8_WAIT_L(8); PG8_BAR; PG8_WAIT_L(0); PG8_MMA(0, 0, At, B0); PG8_BAR; PG8_SCHED;
            PG8_LDB(B1, 0, 1); PG8_STAGE(PG8_SB(0, 0), b2, voffB);
            PG8_BAR; PG8_WAIT_L(0); PG8_MMA(0, 1, At, B1); PG8_BAR;
            PG8_LDA(At, 0, 1); PG8_STAGE(PG8_SA(0, 0), a2, voffA);
            PG8_BAR; PG8_WAIT_L(0); PG8_MMA(1, 0, At, B0); PG8_BAR; PG8_SCHED;
            PG8_STAGE(PG8_SB(0, 1), b2 + hstepB, voffB);
            PG8_WAIT_V(6); PG8_BAR; PG8_MMA(1, 1, At, B1); PG8_BAR;
            PG8_LDB(B0, 1, 0); PG8_SCHED; PG8_LDA(At, 1, 0); PG8_STAGE(PG8_SA(0, 1), a2 + hstepA, voffA);
            PG8_WAIT_L(8); PG8_BAR; PG8_WAIT_L(0); PG8_MMA(0, 0, At, B0); PG8_BAR; PG8_SCHED;
            PG8_LDB(B1, 1, 1); PG8_STAGE(PG8_SB(1, 0), b3, voffB);
            PG8_BAR; PG8_WAIT_L(0); PG8_MMA(0, 1, At, B1); PG8_BAR;
            PG8_LDA(At, 1, 1); PG8_STAGE(PG8_SA(1, 0), a3, voffA);
            PG8_BAR; PG8_WAIT_L(0); PG8_MMA(1, 0, At, B0); PG8_BAR; PG8_SCHED;
            PG8_STAGE(PG8_SB(1, 1), b3 + hstepB, voffB);
            PG8_WAIT_V(6); PG8_BAR; PG8_MMA(1, 1, At, B1); PG8_BAR;
            }
        }
        if (wr == 0) PG8_BAR;
        bool do_epi = true;
        if constexpr (SPLIT) if (cur.sp) {
            const int pair = (cur.sp - 1) >> 1, kpart = (cur.sp - 1) & 1;
            {
                const __amdgpu_buffer_rsrc_t rs = __builtin_amdgcn_make_buffer_rsrc((void*)slabs, (short)0, 256 * 32 * 512 * 16, 0x00020000);
                const unsigned v0 = (unsigned)(((pair * 2 + kpart) * 32 * 512 + tid) * 16);
#pragma unroll
                for (int r = 0; r < 32; ++r) __builtin_amdgcn_raw_buffer_store_b128(__builtin_bit_cast(u32x4, acc[r >> 4][(r >> 3) & 1][(r >> 1) & 3][r & 1]), rs, v0 + (unsigned)r * 8192u, 0, 16);
            }
            asm volatile("s_waitcnt vmcnt(0)" ::: "memory");
            PG8_BAR;
            LAS unsigned* flag = (LAS unsigned*)(lds + 131072 + 8192 + 64);
            if (tid == 0) {
                const unsigned old = __hip_atomic_fetch_add(scnt + pair, 1u, __ATOMIC_RELAXED, __HIP_MEMORY_SCOPE_AGENT);
                if (old == 1u) { __builtin_amdgcn_fence(__ATOMIC_ACQUIRE, "agent"); asm volatile("s_waitcnt vmcnt(0)" ::: "memory"); }
                *flag = old;
            }
            asm volatile("s_waitcnt lgkmcnt(0)" ::: "memory");
            PG8_BAR;
            asm volatile("" ::: "memory");
            do_epi = (*(volatile LAS unsigned*)flag == 1u);
            if (do_epi) {
                const float* s0 = slabs + ((size_t)(pair * 2) * 32 * 512 + tid) * 4; const float* s1 = s0 + (size_t)32 * 512 * 4;
#pragma unroll
                for (int r = 0; r < 32; ++r) acc[r >> 4][(r >> 3) & 1][(r >> 1) & 3][r & 1] = *(const f32x4*)(s0 + (size_t)r * 2048);
#pragma unroll
                for (int rb = 0; rb < 32; rb += 16) {
                    f32x4 t[16];
#pragma unroll
                    for (int r = 0; r < 16; ++r) t[r] = *(const f32x4*)(s1 + (size_t)(rb + r) * 2048);
                    asm volatile("" ::: "memory");
#pragma unroll
                    for (int r = 0; r < 16; ++r) acc[(rb + r) >> 4][((rb + r) >> 3) & 1][((rb + r) >> 1) & 3][(rb + r) & 1] += t[r];
                }
            }
        }
        if (do_epi) E(acc, cur, wr, wc, fr, fq);
        if (!has_next) break;
#pragma unroll
        for (int a = 0; a < 2; ++a)
#pragma unroll
            for (int b = 0; b < 2; ++b)
#pragma unroll
                for (int m = 0; m < 4; ++m)
#pragma unroll
                    for (int n = 0; n < 2; ++n) acc[a][b][m][n] = (f32x4){0.f, 0.f, 0.f, 0.f};
        cur = nxt; cA = nA; cB = nB; ++ui;
        if (wr == 1) PG8_BAR;
    }
    PG8_WAIT_V(0);
    PG8_BAR;
#undef PG8_SA
#undef PG8_SB
#undef PG8_STAGE
#undef PG8_LDA
#undef PG8_LDB
#undef PG8_MMA
#undef PG8_WAIT_V
#undef PG8_WAIT_L
#undef PG8_BAR
#undef PG8_SCHED
}
}
using pg8::Unit;
typedef f32x4 Acc[2][2][4][2];

struct SchedDense {
    int nM, nN, G, c; const char* A; const char* B; size_t astep, bstep; int reps, nt;
    __device__ __forceinline__ bool next(int i, Unit& u) const {
        long L = (long)i * G + c; if (L >= (long)reps * nM * nN) return false; L %= (long)nM * nN;
        int pm, pn; pg8::tile_order((int)L, nM, nN, pm, pn);
        u.A = A + (size_t)pm * astep; u.B = B + (size_t)pn * bstep; u.e0 = pm; u.e1 = pn; u.e2 = 0; u.nt = nt; u.sp = 0; return true;
    }
};
struct SchedSplit2 {
    int G, c; const char* A; const char* B; size_t astep, bstep; int nt;
    __device__ __forceinline__ bool next(int i, Unit& u) const {
        int L = c, kpart = 0, sp = 0, n = nt; size_t koff = 0;
        if (G != 256) { L = i * G + c; if (L >= 384) return false; }
        else if (i > 1) return false;
        else if (i == 1) { const int x = c & 7, t = c >> 3, j = t >> 1; kpart = t & 1; L = 256 + 8 * j + x; sp = 1 + 2 * (8 * j + x) + kpart; n = nt / 2; koff = (size_t)kpart * n * 128; }
        int pm, pn; pg8::tile_order(L, 48, 8, pm, pn);
        u.A = A + (size_t)pm * astep + koff; u.B = B + (size_t)pn * bstep + koff; u.e0 = pm; u.e1 = pn; u.e2 = 0; u.nt = n; u.sp = sp; return true;
    }
};
struct SchedF1 {
    int G, c; const char* A; const char* B; int nt;
    __device__ __forceinline__ bool next(int i, Unit& u) const {
        const long L = (long)i * G + c; if (L >= 16 * 48) return false;
        int pmm, pn; pg8::tile_order((int)L, 16, 48, pmm, pn);
        const int g = pmm >> 2, pmd = pmm & 3;
        u.A = A + (size_t)pmd * 256 * 512 * 2; u.B = B + ((size_t)pn * 256 * D + (size_t)g * 512) * 2; u.e0 = pmd; u.e1 = pn; u.e2 = g; u.nt = 8; u.sp = 0; return true;
    }
};
struct SchedF2 {
    int G, c, smp; const char* A; const char* B; int nt;
    __device__ __forceinline__ bool next(int i, Unit& u) const {
        const long L = (long)i * G + c;
        if (smp) { if (L >= 256) return false; const int l = (int)L, pn2 = l & 1, pm = (l >> 1) & 3, g = (l >> 3) & 3, s = l >> 5;
            u.A = A + (size_t)pm * 256 * 2048 * 2; u.B = B + (((size_t)(g * 512 + pn2 * 256)) * (2 * T) + 2 * (size_t)(TCTX + 1024 * s)) * 2;
            u.e0 = (TCTX + 1024 * s + 256 * pm) >> 8; u.e1 = g * 2 + pn2; u.e2 = 0; u.nt = 32; u.sp = 0; return true; }
        if (L >= 128) return false; const int l = (int)L, pn2 = l & 1, g = (l >> 1) & 3, s = l >> 3;
        u.A = A; u.B = B + (((size_t)(g * 512 + pn2 * 256)) * (2 * T) + 2 * (size_t)(256 * s)) * 2;
        u.e0 = s; u.e1 = g * 2 + pn2; u.e2 = 0; u.nt = 8; u.sp = 0; return true;
    }
};

struct EpiInProj {
    bf16_t *Q, *V, *GA, *U, *VV; float* LF; const float* lbraw;
    __device__ __forceinline__ void operator()(Acc& acc, const Unit& u, int wr, int wc, int fr, int fq) const {
        const int pm = u.e0, pn = u.e1, seg = pn >> 2;
        const int row0 = pm * 256 + wr * 64 + fr, cs0 = (pn & 3) * 256 + wc * 32 + 8 * fq;
#pragma unroll
        for (int bj = 0; bj < 2; ++bj) {
            const int col = cs0 + bj * 128;
            if (seg == 1 || seg == 2) {
                const float* l0 = lbraw + (seg - 1) * 2048 + col;
                float lb[8];
#pragma unroll
                for (int j = 0; j < 8; ++j) lb[j] = fast_sigmoid(l0[j] - l0[1024 + j]);
#pragma unroll
                for (int ai = 0; ai < 2; ++ai)
#pragma unroll
                    for (int m = 0; m < 4; ++m) {
                        const int row = row0 + ai * 128 + m * 16;
                        f32x4 o0, o1;
#pragma unroll
                        for (int e = 0; e < 4; ++e) { o0[e] = __logf(lb[e] + (1.f - lb[e]) * fast_sigmoid(acc[ai][bj][m][0][e])); o1[e] = __logf(lb[4 + e] + (1.f - lb[4 + e]) * fast_sigmoid(acc[ai][bj][m][1][e])); }
                        float* p = LF + (size_t)row * 2048 + (seg - 1) * 1024 + col;
                        *(f32x4*)p = o0; *(f32x4*)(p + 4) = o1;
                    }
            } else {
                bf16_t* base = seg == 0 ? Q : seg == 3 ? V : seg == 4 ? GA : seg == 5 ? U : VV;
#pragma unroll
                for (int ai = 0; ai < 2; ++ai)
#pragma unroll
                    for (int m = 0; m < 4; ++m) {
                        const int row = row0 + ai * 128 + m * 16;
                        f32x4 v0 = acc[ai][bj][m][0], v1 = acc[ai][bj][m][1];
                        if (seg == 0) {
#pragma unroll
                            for (int e = 0; e < 4; ++e) { v0[e] = silu_f(v0[e]) * 0.08838834764831845f; v1[e] = silu_f(v1[e]) * 0.08838834764831845f; }
                        } else if (seg == 4) {
#pragma unroll
                            for (int e = 0; e < 4; ++e) { v0[e] = silu_f(v0[e]); v1[e] = silu_f(v1[e]); }
                        } else if (seg >= 5) {
#pragma unroll
                            for (int e = 0; e < 4; ++e) { v0[e] = gelu_tanh_f(v0[e]); v1[e] = gelu_tanh_f(v1[e]); }
                        }
                        u32x4 w; w.x = pk2(v0[0], v0[1]); w.y = pk2(v0[2], v0[3]); w.z = pk2(v1[0], v1[1]); w.w = pk2(v1[2], v1[3]);
                        *(u32x4*)(base + (size_t)row * 1024 + col) = w;
                    }
            }
        }
    }
};
struct EpiResid {
    const float* xin0; const float* xin1; float* xout; const float* gate;
    __device__ __forceinline__ void operator()(Acc& acc, const Unit& u, int wr, int wc, int fr, int fq) const {
        const int pm = u.e0, pn = u.e1;
        const int row0 = pm * 256 + wr * 64 + fr, col0 = pn * 256 + wc * 32 + 8 * fq;
        const float* g = gate + (size_t)row_bi(pm) * 12288 + col0;
        const float* xin = pm < 16 ? xin0 : xin1 - (size_t)TCTX * D;
        f32x4 gv[2][2];
#pragma unroll
        for (int bj = 0; bj < 2; ++bj) { gv[bj][0] = *(const f32x4*)(g + bj * 128); gv[bj][1] = *(const f32x4*)(g + bj * 128 + 4); }
#pragma unroll
        for (int ai = 0; ai < 2; ++ai) {
            f32x4 xv[4][2][2];
#pragma unroll
            for (int m = 0; m < 4; ++m)
#pragma unroll
                for (int bj = 0; bj < 2; ++bj) { const float* p = xin + (size_t)(row0 + ai * 128 + m * 16) * D + col0 + bj * 128; xv[m][bj][0] = *(const f32x4*)p; xv[m][bj][1] = *(const f32x4*)(p + 4); }
            asm volatile("" ::: "memory");
#pragma unroll
            for (int m = 0; m < 4; ++m)
#pragma unroll
                for (int bj = 0; bj < 2; ++bj) { float* p = xout + (size_t)(row0 + ai * 128 + m * 16) * D + col0 + bj * 128;
                    *(f32x4*)p = xv[m][bj][0] + gv[bj][0] * acc[ai][bj][m][0]; *(f32x4*)(p + 4) = xv[m][bj][1] + gv[bj][1] * acc[ai][bj][m][1]; }
            asm volatile("" ::: "memory");
        }
    }
};
__device__ __forceinline__ float dpp_shr1(float src, float old) { return __builtin_bit_cast(float, __builtin_amdgcn_update_dpp(__builtin_bit_cast(int, old), __builtin_bit_cast(int, src), 0x111, 0xf, 0xf, false)); }
__device__ __forceinline__ float dpp_shl1(float src, float old) { return __builtin_bit_cast(float, __builtin_amdgcn_update_dpp(__builtin_bit_cast(int, old), __builtin_bit_cast(int, src), 0x101, 0xf, 0xf, false)); }
struct EpiConv {
    bf16_t* ACT; const float* cw; const float* cb; LAS float* xch;
    __device__ __forceinline__ void operator()(Acc& acc, const Unit& u, int wr, int wc, int fr, int fq) const {
        const int pm = u.e0, pn = u.e1; const bool ctx = pm < 16;
        LAS float* mine = xch + (wr * 4 + wc) * 64; const LAS float* other = xch + ((wr ^ 1) * 4 + wc) * 64;
        if (wr == 0) { if (fr == 15) {
#pragma unroll
            for (int bj = 0; bj < 2; ++bj)
#pragma unroll
                for (int n = 0; n < 2; ++n) *(LAS f32x4*)(mine + ((bj * 2 + n) * 4 + fq) * 4) = acc[1][bj][3][n]; } }
        else { if (fr == 0) {
#pragma unroll
            for (int bj = 0; bj < 2; ++bj)
#pragma unroll
                for (int n = 0; n < 2; ++n) *(LAS f32x4*)(mine + ((bj * 2 + n) * 4 + fq) * 4) = acc[0][bj][0][n]; } }
        LDS_WAIT(); __builtin_amdgcn_s_barrier(); asm volatile("" ::: "memory");
        const bool zl = !ctx && fr == 8, zr = !ctx && fr == 7;
        const int wcol0 = 128 * pn + 32 * wc + 8 * fq;
#pragma unroll
        for (int bj = 0; bj < 2; ++bj)
#pragma unroll
            for (int n = 0; n < 2; ++n) {
                const float* wp = cw + bj * DFF + wcol0 + 4 * n; const float* bp = cb + bj * DFF + wcol0 + 4 * n;
                f32x4 hv = *(const LAS f32x4*)(other + ((bj * 2 + n) * 4 + fq) * 4); if (!ctx) hv = (f32x4){0.f, 0.f, 0.f, 0.f};
#pragma unroll
                for (int e = 0; e < 4; ++e) {
                    const float w0 = wp[e], w1 = wp[DFF2 + e], w2 = wp[2 * DFF2 + e], bb = bp[e];
                    float x[8];
#pragma unroll
                    for (int j = 0; j < 8; ++j) x[j] = acc[j >> 2][bj][j & 3][n][e];
                    float left = dpp_shr1(x[7], wr == 1 ? hv[e] : 0.f);
                    float right = dpp_shl1(x[0], wr == 0 ? hv[e] : 0.f);
                    if (zl) left = 0.f; if (zr) right = 0.f;
#pragma unroll
                    for (int j = 0; j < 8; ++j) {
                        const float xm = j == 0 ? left : x[j - 1], xp = j == 7 ? right : x[j + 1];
                        acc[j >> 2][bj][j & 3][n][e] = w0 * xm + w1 * x[j] + w2 * xp + bb;
                    }
                }
                asm volatile("" ::: "memory");
            }
#pragma unroll
        for (int ai = 0; ai < 2; ++ai)
#pragma unroll
            for (int m = 0; m < 4; ++m) {
                const int tok = pm * 256 + 8 * (16 * wr + fr) + 4 * ai + m;
                f32x4 o0, o1;
#pragma unroll
                for (int e = 0; e < 4; ++e) { o0[e] = silu_f(acc[ai][0][m][0][e]) * acc[ai][1][m][0][e]; o1[e] = silu_f(acc[ai][0][m][1][e]) * acc[ai][1][m][1][e]; }
                u32x4 w; w.x = pk2(o0[0], o0[1]); w.y = pk2(o0[2], o0[3]); w.z = pk2(o1[0], o1[1]); w.w = pk2(o1[2], o1[3]);
                *(u32x4*)(ACT + (size_t)tok * DFF + wcol0) = w;
                asm volatile("" ::: "memory");
            }
    }
};
struct EpiF1 {
    bf16_t* PQT;
    __device__ __forceinline__ void operator()(Acc& acc, const Unit& u, int wr, int wc, int fr, int fq) const {
        const int pmd = u.e0, pn = u.e1, g = u.e2, which = pmd >> 1;
        int sb2, N, n0;
        if (pn < 16) { sb2 = 2 * 256 * pn; N = 256; n0 = 0; } else { const int s = (pn - 16) >> 2; sb2 = 2 * (TCTX + 1024 * s); N = 1024; n0 = ((pn - 16) & 3) * 256; }
        const int c0 = g * 512 + (pmd & 1) * 256 + wr * 64 + fr;
        bf16_t* base = PQT + (size_t)sb2 + which * N + n0 + wc * 32 + 8 * fq;
#pragma unroll
        for (int ai = 0; ai < 2; ++ai)
#pragma unroll
            for (int m = 0; m < 4; ++m) {
                bf16_t* rowp = base + (size_t)(c0 + ai * 128 + m * 16) * (2 * T);
#pragma unroll
                for (int bj = 0; bj < 2; ++bj) { const f32x4 v0 = acc[ai][bj][m][0], v1 = acc[ai][bj][m][1];
                    u32x4 w; w.x = pk2(v0[0], v0[1]); w.y = pk2(v0[2], v0[3]); w.z = pk2(v1[0], v1[1]); w.w = pk2(v1[2], v1[3]);
                    *(u32x4*)(rowp + bj * 128) = w; }
            }
    }
};
struct EpiBf16 {
    bf16_t* O; int ldo;
    __device__ __forceinline__ void operator()(Acc& acc, const Unit& u, int wr, int wc, int fr, int fq) const {
        const int row0 = u.e0 * 256 + wr * 64 + fr, col0 = u.e1 * 256 + wc * 32 + 8 * fq;
#pragma unroll
        for (int ai = 0; ai < 2; ++ai)
#pragma unroll
            for (int m = 0; m < 4; ++m) {
                bf16_t* rowp = O + (size_t)(row0 + ai * 128 + m * 16) * ldo + col0;
#pragma unroll
                for (int bj = 0; bj < 2; ++bj) { const f32x4 v0 = acc[ai][bj][m][0], v1 = acc[ai][bj][m][1];
                    u32x4 w; w.x = pk2(v0[0], v0[1]); w.y = pk2(v0[2], v0[3]); w.z = pk2(v1[0], v1[1]); w.w = pk2(v1[2], v1[3]);
                    *(u32x4*)(rowp + bj * 128) = w; }
            }
    }
};

struct Args { const float* in[30]; float* out; unsigned char* ws; int ph_lo, ph_hi; };
typedef const __attribute__((address_space(4))) Args* KA;
__device__ __forceinline__ KA kargs() { auto kp = __builtin_amdgcn_kernarg_segment_ptr(); asm volatile("" : "+s"(kp)); return (KA)kp; }

struct CvtSrc { const float* W; bf16_t* WT; int K, N, up, item; };
__device__ __forceinline__ void cvt_load(const CvtSrc& c, int lane, f32x4 (&r)[16]) {
    const int nblk = c.N / 64, kb = c.item / nblk, nb = c.item % nblk, k0 = 64 * kb, n0 = 64 * nb;
    const int cc = lane & 15, q = lane >> 4;
#pragma unroll
    for (int i = 0; i < 16; ++i) { const int kk = 8 * (i >> 1) + 2 * q + (i & 1); r[i] = *(const f32x4*)(c.W + (size_t)(k0 + kk) * c.N + n0 + 4 * cc); }
}
__device__ __forceinline__ void cvt_store(const CvtSrc& c, int lane, const f32x4 (&r)[16], LAS unsigned* scr) {
    const int nblk = c.N / 64, kb = c.item / nblk, nb = c.item % nblk, k0 = 64 * kb, n0 = 64 * nb;
    const int cc = lane & 15, q = lane >> 4;
#pragma unroll
    for (int ip = 0; ip < 8; ++ip)
#pragma unroll
        for (int e = 0; e < 4; ++e) scr[(4 * cc + e) * 33 + 4 * ip + q] = pk2(r[2 * ip][e], r[2 * ip + 1][e]);
    LDS_WAIT(); asm volatile("" ::: "memory");
    const int c8 = lane & 7;
#pragma unroll
    for (int j = 0; j < 8; ++j) { const int n = (lane >> 3) + 8 * j; const LAS unsigned* sp = scr + n * 33 + 4 * c8;
        u32x4 o; o.x = sp[0]; o.y = sp[1]; o.z = sp[2]; o.w = sp[3];
        int nn = n0 + n;
        if (c.up) { const int bjj = nn >= DFF ? 1 : 0, cgc = nn - bjj * DFF; nn = (cgc >> 7) * 256 + bjj * 128 + (cgc & 127); }
        *(u32x4*)(c.WT + (size_t)nn * c.K + k0 + 8 * c8) = o; }
    LDS_WAIT(); asm volatile("" ::: "memory");
}
__device__ __forceinline__ bool cvt_pick(KA a, int set, int it, CvtSrc& c) {
    unsigned char* ws = a->ws;
    constexpr int I_IN = 32 * (INW / 64), I_O = 32 * (D / 64), I_UP = 32 * (DFF2 / 64), I_DN = (DFF / 64) * (D / 64);
    if (set == 0) { if (it >= I_IN) return false; c.W = a->in[8]; c.WT = (bf16_t*)(ws + WS_WIN); c.K = D; c.N = INW; c.up = 0; c.item = it; return true; }
    if (it >= I_O + I_UP + I_DN) return false;
    int r = it;
    if (r < I_O) { c.W = a->in[set == 1 ? 14 : 23]; c.WT = (bf16_t*)(ws + (set == 1 ? WS_WOUT0 : WS_WOUT1)); c.K = D; c.N = D; c.up = 0; c.item = r; return true; } r -= I_O;
    if (r < I_UP) { c.W = a->in[set == 1 ? 16 : 25]; c.WT = (bf16_t*)(ws + (set == 1 ? WS_WUP0 : WS_WUP1)); c.K = D; c.N = DFF2; c.up = 1; c.item = r; return true; } r -= I_UP;
    c.W = a->in[set == 1 ? 19 : 28]; c.WT = (bf16_t*)(ws + (set == 1 ? WS_WDN0 : WS_WDN1)); c.K = DFF; c.N = D; c.up = 0; c.item = r; return true;
}
__device__ __forceinline__ void convert_set(KA a, LAS unsigned char* lds, int set, int gw, int NGW, int i0 = 0, int i1 = 1 << 30) {
    const int lane = threadIdx.x & 63, wave = __builtin_amdgcn_readfirstlane(threadIdx.x >> 6);
    LAS unsigned* scr = (LAS unsigned*)(lds + wave * 8448);
    CvtSrc cur, nxt; f32x4 r0[16], r1[16];
    int it = i0 + gw;
    if (it >= i1 || !cvt_pick(a, set, it, cur)) return;
    cvt_load(cur, lane, r0);
    for (;;) {
        it += NGW; const bool h1 = it < i1 && cvt_pick(a, set, it, nxt);
        if (h1) cvt_load(nxt, lane, r1);
        cvt_store(cur, lane, r0, scr);
        if (!h1) break;
        it += NGW; const bool h2 = it < i1 && cvt_pick(a, set, it, cur);
        if (h2) cvt_load(cur, lane, r0);
        cvt_store(nxt, lane, r1, scr);
        if (!h2) break;
    }
}
__device__ __forceinline__ void dft_tables(unsigned char* ws, int gt, int GT) {
    bf16_t* DC = (bf16_t*)(ws + WS_DFTC); bf16_t* D256 = (bf16_t*)(ws + WS_DFT256); bf16_t* D1024 = (bf16_t*)(ws + WS_DFT1024);
    for (int i = gt; i < 1024 * 512; i += GT) { const int r = i >> 9, k = i & 511, c = r & 511; const float ang = 2.0f * (float)((c * k) & 511) * (1.0f / 512.0f);
        const float v = (r < 512 ? cospif(ang) : sinpif(ang)) * 0.04419417382415922f; DC[i] = (bf16_t)f2bf(v); }
    for (int i = gt; i < 256 * 512; i += GT) { const int p = i >> 9, k = i & 511, n = k & 255; const float ang = 2.0f * (float)((p * n) & 255) * (1.0f / 256.0f);
        const float v = (k < 256 ? cospif(ang) : -sinpif(ang)) * 0.0625f; D256[i] = (bf16_t)f2bf(v); }
    for (int i = gt; i < 1024 * 2048; i += GT) { const int p = i >> 11, k = i & 2047, n = k & 1023; const float ang = 2.0f * (float)((p * n) & 1023) * (1.0f / 1024.0f);
        const float v = (k < 1024 ? cospif(ang) : -sinpif(ang)) * 0.03125f; D1024[i] = (bf16_t)f2bf(v); }
}
__device__ __forceinline__ void phase_prologue(KA a, LAS unsigned char* lds, int vcu, int G) {
    const int tid = threadIdx.x, lane = tid & 63, wave = __builtin_amdgcn_readfirstlane(tid >> 6);
    unsigned char* ws = a->ws;
    __syncthreads();
    if (vcu < 192) {
        const int l = vcu / 96, n0 = (vcu % 96) * 128;
        const float* Wm = a->in[l ? 20 : 5]; const float* bm = a->in[l ? 21 : 6];
        LAS float* S = (LAS float*)lds;
        {
            const float* cc = a->in[4]; const float* cs = a->in[3];
            float cv[4][9];
#pragma unroll
            for (int j = 0; j < 4; ++j) { const int k = tid + NT * j; cv[j][0] = cc[k];
#pragma unroll
                for (int bi = 1; bi < 9; ++bi) cv[j][bi] = cs[(bi - 1) * 2048 + k]; }
#pragma unroll
            for (int j = 0; j < 4; ++j) { const int k = tid + NT * j;
#pragma unroll
                for (int bi = 0; bi < 9; ++bi) S[k * 12 + bi] = silu_f(cv[j][bi]); }
        }
        __syncthreads();
        const int l4 = tid & 31, rg = tid >> 5;
        f32x4 accm[9];
#pragma unroll
        for (int bi = 0; bi < 9; ++bi) accm[bi] = (f32x4){0.f, 0.f, 0.f, 0.f};
#pragma unroll 8
        for (int kk = 0; kk < 128; ++kk) {
            const int k = rg + 16 * kk;
            const f32x4 w = *(const f32x4*)(Wm + (size_t)k * 12288 + n0 + 4 * l4);
            const f32x4 s0 = *(const LAS f32x4*)(S + k * 12), s1 = *(const LAS f32x4*)(S + k * 12 + 4); const float s8 = S[k * 12 + 8];
            accm[0] += s0[0] * w; accm[1] += s0[1] * w; accm[2] += s0[2] * w; accm[3] += s0[3] * w;
            accm[4] += s1[0] * w; accm[5] += s1[1] * w; accm[6] += s1[2] * w; accm[7] += s1[3] * w; accm[8] += s8 * w;
        }
        __syncthreads();
        LAS float* red = (LAS float*)lds;
#pragma unroll
        for (int bi = 0; bi < 9; ++bi) *(LAS f32x4*)(red + (rg * 9 + bi) * 128 + 4 * l4) = accm[bi];
        __syncthreads();
        float* MOD = (float*)(ws + WS_MOD) + (size_t)l * 9 * 12288;
        for (int o = tid; o < 9 * 128; o += NT) { const int bi = o >> 7, n = o & 127; float s = bm[n0 + n];
#pragma unroll
            for (int r = 0; r < 16; ++r) s += red[(r * 9 + bi) * 128 + n];
            MOD[(size_t)bi * 12288 + n0 + n] = s; }
        __syncthreads();
    }
    __syncthreads();
    if (G == 256) { if (vcu >= 192) convert_set(a, lds, 0, (vcu - 192) * 8 + wave, 64 * 8); }
    else convert_set(a, lds, 0, vcu * 8 + wave, G * 8);
    if (G != 256) { convert_set(a, lds, 1, vcu * 8 + wave, G * 8); convert_set(a, lds, 2, vcu * 8 + wave, G * 8); dft_tables(ws, vcu * NT + tid, G * NT); }
}

__device__ __forceinline__ void phase_norm_mod(const float* x0, const float* x1, const float* nw, const float* sh, const float* sc, bf16_t* H, int vcu, int G) {
    const int lane = threadIdx.x & 63, wave = __builtin_amdgcn_readfirstlane(threadIdx.x >> 6);
    const int gw = vcu * 8 + wave, NGW = G * 8;
    for (int row = gw; row < T; row += NGW) {
        const float* xr = row < TCTX ? x0 + (size_t)row * D : x1 + (size_t)(row - TCTX) * D;
        const int bi = row < TCTX ? 0 : 1 + ((row - TCTX) >> 10);
        f32x4 v[8]; float s = 0.f;
#pragma unroll
        for (int j = 0; j < 8; ++j) { v[j] = *(const f32x4*)(xr + 4 * lane + 256 * j); s += (v[j][0] * v[j][0] + v[j][1] * v[j][1]) + (v[j][2] * v[j][2] + v[j][3] * v[j][3]); }
        const float rstd = rsqrtf(wave_sum(s) * (1.0f / D) + 1e-6f);
        const float* shp = sh + (size_t)bi * 12288; const float* scp = sc + (size_t)bi * 12288;
#pragma unroll
        for (int j = 0; j < 8; ++j) { const int c = 4 * lane + 256 * j;
            const f32x4 w = *(const f32x4*)(nw + c), a1 = *(const f32x4*)(scp + c), a0 = *(const f32x4*)(shp + c);
            f32x4 o;
#pragma unroll
            for (int e = 0; e < 4; ++e) o[e] = v[j][e] * rstd * w[e] * (1.0f + a1[e]) + a0[e];
            u32x2 p; p.x = pk2(o[0], o[1]); p.y = pk2(o[2], o[3]);
            *(u32x2*)(H + (size_t)row * D + c) = p; }
    }
}
__device__ __forceinline__ void phase_final_norm(float* X, const float* nw, int vcu, int G) {
    const int lane = threadIdx.x & 63, wave = __builtin_amdgcn_readfirstlane(threadIdx.x >> 6);
    const int gw = vcu * 8 + wave, NGW = G * 8;
    for (int row = gw; row < T; row += NGW) {
        float* xr = X + (size_t)row * D;
        f32x4 v[8]; float s = 0.f;
#pragma unroll
        for (int j = 0; j < 8; ++j) { v[j] = *(const f32x4*)(xr + 4 * lane + 256 * j); s += (v[j][0] * v[j][0] + v[j][1] * v[j][1]) + (v[j][2] * v[j][2] + v[j][3] * v[j][3]); }
        const float rstd = rsqrtf(wave_sum(s) * (1.0f / D) + 1e-6f);
#pragma unroll
        for (int j = 0; j < 8; ++j) { const int c = 4 * lane + 256 * j; const f32x4 w = *(const f32x4*)(nw + c); *(f32x4*)(xr + c) = v[j] * rstd * w; }
    }
}

constexpr int P128 = 136, P64 = 72;
constexpr int SC_QS = 0, SC_KS = SC_QS + 64 * P128 * 2, SC_QI = SC_KS + 64 * P128 * 2, SC_KO = SC_QI + 64 * P128 * 2, SC_VT = SC_KO + 128 * P64 * 2,
              SC_SC = SC_VT + 128 * P64 * 2, SC_ST = SC_SC + 64 * P64 * 2, SC_TOT = SC_ST + 128 * P128 * 2, SC_DEC = SC_TOT + 4 * 128 * 4, SC_END = SC_DEC + 128 * 4;
static_assert(SC_END <= LDS_BYTES, "scan LDS");
__device__ __forceinline__ void scan_item(KA a, LAS unsigned char* lds, int seqbase, int N, int b_state, int h, int dir, bool ctx, int b_out) {
    const int tid = threadIdx.x, lane = tid & 63, w = __builtin_amdgcn_readfirstlane(tid >> 6), fr = lane & 15, fq = lane >> 4;
    unsigned char* ws = a->ws;
    const bf16_t* Qg = (const bf16_t*)(ws + WS_Q) + h * 128; const bf16_t* Vg = (const bf16_t*)(ws + WS_V) + h * 128;
    const float* LFg = (const float*)(ws + WS_LF) + dir * 1024 + h * 128;
    float* Og = (float*)(ws + (dir ? WS_OB : WS_OF)) + h * 128;
    LAS bf16_t* QS = (LAS bf16_t*)(lds + SC_QS); LAS bf16_t* KS = (LAS bf16_t*)(lds + SC_KS); LAS bf16_t* QI = (LAS bf16_t*)(lds + SC_QI);
    LAS bf16_t* KO = (LAS bf16_t*)(lds + SC_KO); LAS bf16_t* VT = (LAS bf16_t*)(lds + SC_VT); LAS bf16_t* SCm = (LAS bf16_t*)(lds + SC_SC);
    LAS bf16_t* ST = (LAS bf16_t*)(lds + SC_ST); LAS float* TOT = (LAS float*)(lds + SC_TOT); LAS float* DEC = (LAS float*)(lds + SC_DEC);
    const int ch = tid & 127, seg = tid >> 7;
    f32x4 accS[8];
    if (ctx) {
#pragma unroll
        for (int kt = 0; kt < 8; ++kt) accS[kt] = (f32x4){0.f, 0.f, 0.f, 0.f};
    } else {
        const float* s0 = a->in[2] + ((size_t)(b_state * 2 + dir) * 8 + h) * 16384;
#pragma unroll
        for (int kt = 0; kt < 8; ++kt)
#pragma unroll
            for (int e = 0; e < 4; ++e) accS[kt][e] = s0[(16 * kt + 4 * fq + e) * 128 + 16 * w + fr];
    }
    __syncthreads();
#pragma unroll
    for (int kt = 0; kt < 8; ++kt) { u32x2 p; p.x = pk2(accS[kt][0], accS[kt][1]); p.y = pk2(accS[kt][2], accS[kt][3]); *(LAS u32x2*)(ST + (16 * w + fr) * P128 + 16 * kt + 4 * fq) = p; }
    const int nc = N >> 6;
    for (int c = 0; c < nc; ++c) {
        float lf[16], qv[16]; unsigned short vv16[16];
#pragma unroll
        for (int ii = 0; ii < 16; ++ii) {
            const int i = 64 * c + 16 * seg + ii; const int tok = seqbase + (dir ? N - 1 - i : i);
            lf[ii] = LFg[(unsigned)tok * 2048u + (unsigned)ch]; qv[ii] = bf2f(Qg[(unsigned)tok * 1024u + (unsigned)ch]); vv16[ii] = Vg[(unsigned)tok * 1024u + (unsigned)ch];
        }
        float run = 0.f;
#pragma unroll
        for (int ii = 0; ii < 16; ++ii) run += lf[ii];
        TOT[seg * 128 + ch] = run;
        __syncthreads();
        const float t0 = TOT[ch], t1 = TOT[128 + ch], t2 = TOT[256 + ch], t3 = TOT[384 + ch];
        const float offs = seg == 0 ? 0.f : seg == 1 ? t0 : seg == 2 ? t0 + t1 : t0 + t1 + t2;
        const float ref = t0 + t1, blast = (t0 + t1) + (t2 + t3);
        if (seg == 0) DEC[ch] = __expf(blast);
        float brun = offs;
        unsigned kow[8], vtw[8];
#pragma unroll
        for (int ii = 0; ii < 16; ii += 2) {
            float ko2[2];
#pragma unroll
            for (int d = 0; d < 2; ++d) {
                const int i2 = ii + d, i = 16 * seg + i2; brun += lf[i2]; const float b = brun; const float kf = 1.0f - __expf(lf[i2]);
                QS[i * P128 + ch] = (bf16_t)f2bf(qv[i2] * __expf(b - ref));
                KS[i * P128 + ch] = (bf16_t)f2bf(kf * __expf(ref - b));
                QI[i * P128 + ch] = (bf16_t)f2bf(qv[i2] * __expf(b));
                ko2[d] = kf * __expf(blast - b);
            }
            kow[ii >> 1] = pk2(ko2[0], ko2[1]); vtw[ii >> 1] = (unsigned)vv16[ii] | ((unsigned)vv16[ii + 1] << 16);
        }
        *(LAS u32x4*)(KO + ch * P64 + 16 * seg) = (u32x4){kow[0], kow[1], kow[2], kow[3]}; *(LAS u32x4*)(KO + ch * P64 + 16 * seg + 8) = (u32x4){kow[4], kow[5], kow[6], kow[7]};
        *(LAS u32x4*)(VT + ch * P64 + 16 * seg) = (u32x4){vtw[0], vtw[1], vtw[2], vtw[3]}; *(LAS u32x4*)(VT + ch * P64 + 16 * seg + 8) = (u32x4){vtw[4], vtw[5], vtw[6], vtw[7]};
        __syncthreads();
        {
            const int it = w >> 1;
#pragma unroll
            for (int jj = 0; jj < 2; ++jj) {
                const int jt = 2 * (w & 1) + jj;
                f32x4 d = (f32x4){0.f, 0.f, 0.f, 0.f};
                if (jt <= it) {
#pragma unroll
                    for (int ks = 0; ks < 4; ++ks) {
                        const bf16x8 af = *(const LAS bf16x8*)(KS + (16 * jt + fr) * P128 + 32 * ks + 8 * fq);
                        const bf16x8 bf = *(const LAS bf16x8*)(QS + (16 * it + fr) * P128 + 32 * ks + 8 * fq);
                        d = __builtin_amdgcn_mfma_f32_16x16x32_bf16(af, bf, d, 0, 0, 0);
                    }
                }
                const int i = 16 * it + fr, j0 = 16 * jt + 4 * fq;
#pragma unroll
                for (int e = 0; e < 4; ++e) if (j0 + e > i) d[e] = 0.f;
                u32x2 p; p.x = pk2(d[0], d[1]); p.y = pk2(d[2], d[3]);
                *(LAS u32x2*)(SCm + i * P64 + j0) = p;
            }
        }
        __syncthreads();
        f32x4 oacc[4];
#pragma unroll
        for (int it = 0; it < 4; ++it) oacc[it] = (f32x4){0.f, 0.f, 0.f, 0.f};
        {
            bf16x8 stf[4], vtf[2];
#pragma unroll
            for (int ks = 0; ks < 4; ++ks) stf[ks] = *(const LAS bf16x8*)(ST + (16 * w + fr) * P128 + 32 * ks + 8 * fq);
#pragma unroll
            for (int ks = 0; ks < 2; ++ks) vtf[ks] = *(const LAS bf16x8*)(VT + (16 * w + fr) * P64 + 32 * ks + 8 * fq);
#pragma unroll
            for (int it = 0; it < 4; ++it) {
#pragma unroll
                for (int ks = 0; ks < 4; ++ks) { const bf16x8 qf = *(const LAS bf16x8*)(QI + (16 * it + fr) * P128 + 32 * ks + 8 * fq); oacc[it] = __builtin_amdgcn_mfma_f32_16x16x32_bf16(stf[ks], qf, oacc[it], 0, 0, 0); }
#pragma unroll
                for (int ks = 0; ks < 2; ++ks) { const bf16x8 sf = *(const LAS bf16x8*)(SCm + (16 * it + fr) * P64 + 32 * ks + 8 * fq); oacc[it] = __builtin_amdgcn_mfma_f32_16x16x32_bf16(vtf[ks], sf, oacc[it], 0, 0, 0); }
            }
#pragma unroll
            for (int kt = 0; kt < 8; ++kt) {
                const f32x4 dc = *(const LAS f32x4*)(DEC + 16 * kt + 4 * fq);
                accS[kt] = accS[kt] * dc;
#pragma unroll
                for (int ks = 0; ks < 2; ++ks) { const bf16x8 kf = *(const LAS bf16x8*)(KO + (16 * kt + fr) * P64 + 32 * ks + 8 * fq); accS[kt] = __builtin_amdgcn_mfma_f32_16x16x32_bf16(kf, vtf[ks], accS[kt], 0, 0, 0); }
            }
        }
#pragma unroll
        for (int it = 0; it < 4; ++it) { const int i = 64 * c + 16 * it + fr; const int tok = seqbase + (dir ? N - 1 - i : i); *(f32x4*)(Og + (size_t)tok * 1024 + 16 * w + 4 * fq) = oacc[it]; }
#pragma unroll
        for (int kt = 0; kt < 8; ++kt) { u32x2 p; p.x = pk2(accS[kt][0], accS[kt][1]); p.y = pk2(accS[kt][2], accS[kt][3]); *(LAS u32x2*)(ST + (16 * w + fr) * P128 + 16 * kt + 4 * fq) = p; }
    }
    if (ctx) {
        float* so = a->out + (size_t)T * D + ((size_t)(b_out * 2 + dir) * 8 + h) * 16384;
#pragma unroll
        for (int kt = 0; kt < 8; ++kt)
#pragma unroll
            for (int e = 0; e < 4; ++e) so[(16 * kt + 4 * fq + e) * 128 + 16 * w + fr] = accS[kt][e];
    }
}

constexpr int MB_WS = 0, MB_BV = 128 * P128 * 2, MB_END = MB_BV + 256 * P128 * 2;
static_assert(MB_END <= LDS_BYTES, "mixer-B LDS");
__device__ __forceinline__ void mixb_item(KA a, LAS unsigned char* lds, int cbk, int g) {
    const int tid = threadIdx.x, lane = tid & 63, w = __builtin_amdgcn_readfirstlane(tid >> 6), fr = lane & 15, fq = lane >> 4;
    unsigned char* ws = a->ws;
    LAS bf16_t* WSl = (LAS bf16_t*)(lds + MB_WS); LAS bf16_t* BV = (LAS bf16_t*)(lds + MB_BV);
    const bf16_t* VVg = (const bf16_t*)(ws + WS_VV) + (size_t)cbk * 128 * 1024 + g * 256;
    const bf16_t* Ug = (const bf16_t*)(ws + WS_U) + (size_t)cbk * 128 * 1024 + g * 256;
    bf16_t* CAT = (bf16_t*)(ws + WS_CAT) + (size_t)cbk * 128 * D + 1024 + g * 256;
    const float* wsg = a->in[12] + (size_t)g * 16384; const float* vn = a->in[11] + g * 256; const float* bsg = a->in[13] + g * 128;
    __syncthreads();
#pragma unroll
    for (int j = 0; j < 8; ++j) { const int idx = (tid + j * NT) * 4, p = idx >> 7, q = idx & 127; const f32x4 v = *(const f32x4*)(wsg + idx);
        u32x2 o; o.x = pk2(v[0], v[1]); o.y = pk2(v[2], v[3]); *(LAS u32x2*)(WSl + p * P128 + q) = o; }
    {
        const int q = tid >> 2, qt = tid & 3;
        u32x4 raw[8]; float ss = 0.f;
#pragma unroll
        for (int j = 0; j < 8; ++j) { raw[j] = *(const u32x4*)(VVg + (size_t)q * 1024 + qt * 64 + 8 * j);
#pragma unroll
            for (int e = 0; e < 4; ++e) { const float lo = bflo(raw[j][e]), hi = bfhi(raw[j][e]); ss += lo * lo + hi * hi; } }
        ss += __shfl_xor(ss, 1); ss += __shfl_xor(ss, 2);
        const float rstd = rsqrtf(ss * (1.0f / 256.0f) + 1e-6f);
#pragma unroll
        for (int j = 0; j < 8; ++j)
#pragma unroll
            for (int e = 0; e < 4; ++e) { const int c = qt * 64 + 8 * j + 2 * e;
                BV[c * P128 + q] = (bf16_t)f2bf(bflo(raw[j][e]) * rstd * vn[c]); BV[(c + 1) * P128 + q] = (bf16_t)f2bf(bfhi(raw[j][e]) * rstd * vn[c + 1]); }
    }
    __syncthreads();
    const int wr2 = w >> 2, wc2 = w & 3;
    f32x4 acc[4][4];
#pragma unroll
    for (int mt = 0; mt < 4; ++mt)
#pragma unroll
        for (int nt = 0; nt < 4; ++nt) acc[mt][nt] = (f32x4){0.f, 0.f, 0.f, 0.f};
#pragma unroll
    for (int ks = 0; ks < 4; ++ks) {
        bf16x8 wf[4], vf[4];
#pragma unroll
        for (int mt = 0; mt < 4; ++mt) wf[mt] = *(const LAS bf16x8*)(WSl + (64 * wr2 + 16 * mt + fr) * P128 + 32 * ks + 8 * fq);
#pragma unroll
        for (int nt = 0; nt < 4; ++nt) vf[nt] = *(const LAS bf16x8*)(BV + (64 * wc2 + 16 * nt + fr) * P128 + 32 * ks + 8 * fq);
#pragma unroll
        for (int mt = 0; mt < 4; ++mt)
#pragma unroll
            for (int nt = 0; nt < 4; ++nt) acc[mt][nt] = __builtin_amdgcn_mfma_f32_16x16x32_bf16(vf[nt], wf[mt], acc[mt][nt], 0, 0, 0);
    }
#pragma unroll
    for (int mt = 0; mt < 4; ++mt) {
        const int p = 64 * wr2 + 16 * mt + fr; const float bsv = bsg[p];
#pragma unroll
        for (int nt = 0; nt < 4; ++nt) { const int c = 64 * wc2 + 16 * nt + 4 * fq;
            const u32x2 uu = *(const u32x2*)(Ug + (size_t)p * 1024 + c);
            u32x2 o; o.x = pk2(bflo(uu.x) * (acc[mt][nt][0] + bsv), bfhi(uu.x) * (acc[mt][nt][1] + bsv)); o.y = pk2(bflo(uu.y) * (acc[mt][nt][2] + bsv), bfhi(uu.y) * (acc[mt][nt][3] + bsv));
            *(u32x2*)(CAT + (size_t)p * D + c) = o; }
    }
}
__device__ __forceinline__ void mixer_work(KA a, LAS unsigned char* lds, int it) {
    if (it < 128) { const int s = it >> 4, h = (it >> 1) & 7, dir = it & 1; scan_item(a, lds, TCTX + 1024 * s, 1024, s, h, dir, false, 0); }
    else if (it < 384) { const int j = it - 128, s = j >> 4, h = (j >> 1) & 7, dir = j & 1; scan_item(a, lds, 256 * s, 256, 0, h, dir, true, s); }
    else { const int j = it - 384; mixb_item(a, lds, j >> 2, j & 3); }
}
__device__ __forceinline__ void phase_mixers(KA a, LAS unsigned char* lds, int vcu, int G) {
    if (G == 256) {
        const int j = vcu - 128, n = vcu < 128 ? 1 : 5;
        for (int q = 0; q < n; ++q) { const int it = vcu < 128 ? vcu : (q < 2 ? 128 + 2 * j + q : 384 + 3 * j + (q - 2)); mixer_work(a, lds, it); }
    } else { for (int it = vcu; it < 768; it += G) mixer_work(a, lds, it); }
}
__device__ __forceinline__ void phase_finalize_a(KA a, int vcu, int G) {
    const int lane = threadIdx.x & 63, wave = __builtin_amdgcn_readfirstlane(threadIdx.x >> 6);
    const int gw = vcu * 8 + wave, NGW = G * 8;
    unsigned char* ws = a->ws;
    const float* OF = (const float*)(ws + WS_OF); const float* OB = (const float*)(ws + WS_OB); const bf16_t* GA = (const bf16_t*)(ws + WS_GA); bf16_t* CAT = (bf16_t*)(ws + WS_CAT);
    const int col = (lane >> 3) * 128 + (lane & 7) * 16, vc = (lane & 7) * 16;
    f32x4 gn[4];
#pragma unroll
    for (int j = 0; j < 4; ++j) gn[j] = *(const f32x4*)(a->in[10] + vc + 4 * j);
    for (int row = gw; row < T; row += NGW) {
        f32x4 v[4]; float ss = 0.f;
#pragma unroll
        for (int j = 0; j < 4; ++j) { v[j] = *(const f32x4*)(OF + (size_t)row * 1024 + col + 4 * j) + *(const f32x4*)(OB + (size_t)row * 1024 + col + 4 * j); ss += (v[j][0] * v[j][0] + v[j][1] * v[j][1]) + (v[j][2] * v[j][2] + v[j][3] * v[j][3]); }
        ss += __shfl_xor(ss, 1); ss += __shfl_xor(ss, 2); ss += __shfl_xor(ss, 4);
        const float rstd = rsqrtf(ss * (1.0f / 128.0f) + 1e-6f);
        const u32x4 g0 = *(const u32x4*)(GA + (size_t)row * 1024 + col), g1 = *(const u32x4*)(GA + (size_t)row * 1024 + col + 8);
        u32x4 o0, o1;
#pragma unroll
        for (int e = 0; e < 4; ++e) {
            const int j = e >> 1, k = (e & 1) * 2;
            o0[e] = pk2(v[j][k] * rstd * gn[j][k] * bflo(g0[e]), v[j][k + 1] * rstd * gn[j][k + 1] * bfhi(g0[e]));
            o1[e] = pk2(v[2 + j][k] * rstd * gn[2 + j][k] * bflo(g1[e]), v[2 + j][k + 1] * rstd * gn[2 + j][k + 1] * bfhi(g1[e]));
        }
        *(u32x4*)(CAT + (size_t)row * D + col) = o0; *(u32x4*)(CAT + (size_t)row * D + col + 8) = o1;
    }
}


#define XB_TMO      128
#define XB_XCNT(j)  (256  + 64 * (j))
#define XB_XSUB(j)  (1280 + 64 * (j))
#define XB_XGEN(j)  (2304 + 64 * (j))
#define XB_TOP      3328
#define XB_TOPGEN   3392
#define XCD_BAR_WORDS 3456
#define XB_SPIN_CAP (1u << 18)
__device__ __forceinline__ unsigned xb_ld(unsigned* p)              { return __hip_atomic_load(p, __ATOMIC_RELAXED, __HIP_MEMORY_SCOPE_AGENT); }
__device__ __forceinline__ unsigned xb_add(unsigned* p, unsigned v) { return __hip_atomic_fetch_add(p, v, __ATOMIC_RELAXED, __HIP_MEMORY_SCOPE_AGENT); }
__device__ __forceinline__ unsigned xb_xcc_id() { return (unsigned)__builtin_amdgcn_s_getreg((3 << 11) | 20) & 0xFu; }
#define XB_SPIN(cond, bar) do { unsigned _sp = 0; while (cond) { __builtin_amdgcn_s_sleep(1); \
    if ((++_sp & 255u) == 0u) { if (xb_ld(&(bar)[XB_TMO])) break; if (_sp > XB_SPIN_CAP) { atomicAdd(&(bar)[XB_TMO], 1u); break; } } } } while (0)
struct XcdBarrier { unsigned* bar; unsigned x; volatile LAS unsigned* st; };
__device__ __forceinline__ XcdBarrier xcd_barrier_post(unsigned* bar, volatile LAS unsigned* st) {
    XcdBarrier b; b.bar = bar; b.x = xb_xcc_id(); b.st = st;
    if (threadIdx.x == 0) (void)xb_add(&bar[XB_XCNT(b.x)], 1u);
    return b;
}
__device__ __forceinline__ void xcd_barrier_complete(unsigned* bar, unsigned x, unsigned& nloc, unsigned& nx) {
    const unsigned G = gridDim.x * gridDim.y * gridDim.z;
    unsigned sum, cnt, mine, sp = 0u;
    for (;;) {
        sum = 0u; cnt = 0u; mine = 0u;
#pragma unroll
        for (unsigned j = 0; j < 16; ++j) { const unsigned c = xb_ld(&bar[XB_XCNT(j)]); sum += c; cnt += (c > 0u) ? 1u : 0u; mine = (j == x) ? c : mine; }
        if (sum == G) break;
        __builtin_amdgcn_s_sleep(1);
        if ((++sp & 255u) == 0u) { if (xb_ld(&bar[XB_TMO])) break; if (sp > XB_SPIN_CAP) { atomicAdd(&bar[XB_TMO], 1u); break; } }
    }
    nloc = mine > 0u ? mine : 1u; nx = cnt > 0u ? cnt : 1u;
}
__device__ __forceinline__ void xcd_barrier(const XcdBarrier& b) {
    asm volatile("s_waitcnt vmcnt(0)" ::: "memory");
    __syncthreads();
    if (threadIdx.x == 0) {
        unsigned* bar = b.bar;
        __builtin_amdgcn_s_waitcnt(0);
        unsigned nloc = b.st[0], nx = b.st[1];
        if (nloc == 0u) { xcd_barrier_complete(bar, b.x, nloc, nx); b.st[0] = nloc; b.st[1] = nx; }
        const unsigned old = xb_add(&bar[XB_XSUB(b.x)], 1u);
        const unsigned gen = old / nloc;
        if (old + 1u == (gen + 1u) * nloc) {
            __builtin_amdgcn_fence(__ATOMIC_RELEASE, "agent");
            asm volatile("s_waitcnt vmcnt(0)" ::: "memory");
            const unsigned og = xb_add(&bar[XB_TOP], 1u);
            const unsigned tg = og / nx;
            if (og + 1u == (tg + 1u) * nx) xb_add(&bar[XB_TOPGEN], 1u);
            else XB_SPIN(xb_ld(&bar[XB_TOPGEN]) == tg, bar);
            __builtin_amdgcn_fence(__ATOMIC_ACQUIRE, "agent");
            xb_add(&bar[XB_XGEN(b.x)], 1u);
            asm volatile("s_waitcnt vmcnt(0)" ::: "memory");
        } else {
            XB_SPIN(xb_ld(&bar[XB_XGEN(b.x)]) == gen, bar);
            __builtin_amdgcn_fence(__ATOMIC_ACQUIRE, "agent");
            asm volatile("s_waitcnt vmcnt(0)" ::: "memory");
        }
    }
    __syncthreads();
}

#ifndef PG8_SP2
#ifndef PG8_SP2
#define PG8_SP2 true
#endif
#endif
__global__ void __launch_bounds__(NT, 2) mk_fwd(Args a_) {
    KA a = kargs();
    extern __shared__ __attribute__((aligned(16))) unsigned char lds_raw[];
    LAS unsigned char* lds = (LAS unsigned char*)lds_raw;
    cg::grid_group grid = cg::this_grid();
    const int G = gridDim.x, bx = blockIdx.x;
    const int vcu = (G % 8 == 0) ? (bx % 8) * (G / 8) + bx / 8 : bx;
#define ws (a->ws)
    const int lo = a->ph_lo, hi = a->ph_hi;
    if (threadIdx.x < 16) ((LAS unsigned*)(lds + LDS_MISC))[threadIdx.x] = 0u;
    __syncthreads();
    (void)xcd_barrier_post((unsigned*)(ws + WS_CTL), (volatile LAS unsigned*)(lds + LDS_MISC));
    if (lo == -12345) grid.sync();
#define X (a->out)
#define MOD0 ((const float*)(ws + WS_MOD))
#define MOD1 (MOD0 + 9 * 12288)
#define Hb ((bf16_t*)(ws + WS_H))
#define CAT ((bf16_t*)(ws + WS_CAT))
#define ACT ((bf16_t*)(ws + WS_ACT))
#define PQT ((bf16_t*)(ws + WS_PQT))
#ifndef PHMASK
#define PHMASK 0x1FFFF
#endif
#define IN(k) (((PHMASK >> (k)) & 1) && lo <= (k) && (k) < hi)
#ifndef REPMASK
#define REPMASK 0
#endif
#ifndef REPN
#define REPN 2
#endif
#define REPS(k) for (int rep_ = 0; rep_ < (((REPMASK >> (k)) & 1) ? REPN : 1); ++rep_)
#define SEAM(k) do { if (IN(k) && IN((k) + 1)) { XcdBarrier b_; b_.bar = (unsigned*)(ws + WS_CTL); b_.x = xb_xcc_id(); b_.st = (volatile LAS unsigned*)(lds + LDS_MISC); xcd_barrier(b_); } a = kargs(); } while (0)

    if (IN(0)) REPS(0) phase_prologue(a, lds, vcu, G);
    SEAM(0);
    if (IN(1)) REPS(1) phase_norm_mod(a->in[0], a->in[1], a->in[7], MOD0, MOD0 + D, Hb, vcu, G);
    SEAM(1);
    if (IN(2)) {
        const int GG = G == 256 ? 224 : G;
        if (bx < GG) {
            SchedDense S{48, INW / 256, GG, bx, (const char*)Hb, (const char*)(ws + WS_WIN), (size_t)256 * D * 2, (size_t)256 * D * 2, ((REPMASK >> 2) & 1) ? REPN : 1, D / 64};
            EpiInProj E{(bf16_t*)(ws + WS_Q), (bf16_t*)(ws + WS_V), (bf16_t*)(ws + WS_GA), (bf16_t*)(ws + WS_U), (bf16_t*)(ws + WS_VV), (float*)(ws + WS_LF), a->in[9]};
            pg8::gemm_phase<EpiInProj, SchedDense, PG8_SP2, 0>(lds, D, D, (size_t)128 * D * 2, (size_t)128 * D * 2, S, E);
        } else {
            const int hw = (bx - GG) * 8 + __builtin_amdgcn_readfirstlane(threadIdx.x >> 6);
            convert_set(a, lds, 1, hw, (G - GG) * 8);
            convert_set(a, lds, 2, hw, (G - GG) * 8, 0, 4096);
            dft_tables(ws, (bx - GG) * NT + threadIdx.x, (G - GG) * NT);
        }
    }
    SEAM(2);
    if (IN(3)) REPS(3) phase_mixers(a, lds, vcu, G);
    SEAM(3);
    if (IN(4)) REPS(4) phase_finalize_a(a, vcu, G);
    SEAM(4);
    if (IN(5)) {
        SchedSplit2 S{G, bx, (const char*)CAT, (const char*)(ws + WS_WOUT0), (size_t)256 * D * 2, (size_t)256 * D * 2, D / 64};
        EpiResid E{a->in[0], a->in[1], X, MOD0 + 2 * D};
        pg8::gemm_phase<EpiResid, SchedSplit2, PG8_SP2, 0, true>(lds, D, D, (size_t)128 * D * 2, (size_t)128 * D * 2, S, E, (float*)(ws + WS_OF), (unsigned*)(ws + WS_CTL) + 4096 + 0 * 128);
    }
    SEAM(5);
    if (IN(6)) REPS(6) phase_norm_mod(X, X + (size_t)TCTX * D, a->in[15], MOD0 + 3 * D, MOD0 + 4 * D, Hb, vcu, G);
    SEAM(6);
    if (IN(7)) {
        const int GG = G == 256 ? 240 : G;
        if (bx < GG) {
            SchedDense S{48, DFF / 128, GG, bx, (const char*)Hb, (const char*)(ws + WS_WUP0), (size_t)256 * D * 2, (size_t)256 * D * 2, ((REPMASK >> 7) & 1) ? REPN : 1, D / 64};
            EpiConv E{ACT, a->in[17], a->in[18], (LAS float*)(lds + LDS_XCH)};
            pg8::gemm_phase<EpiConv, SchedDense, PG8_SP2, 1>(lds, D, D, (size_t)4 * D * 2, (size_t)128 * D * 2, S, E);
        } else convert_set(a, lds, 2, (bx - GG) * 8 + __builtin_amdgcn_readfirstlane(threadIdx.x >> 6), (G - GG) * 8, 4096);
    }
    SEAM(7);
    if (IN(8)) {
#ifdef PROBE_G4
        {
            SchedSplit2 S{G, bx, (const char*)ACT, (const char*)(ws + WS_WDN0), (size_t)256 * DFF * 2, (size_t)256 * DFF * 2, DFF / 64};
            EpiResid E{X, X + (size_t)TCTX * D, (float*)(ws + WS_V), MOD0 + 5 * D};
            pg8::gemm_phase<EpiResid, SchedSplit2, PG8_SP2, 0, true>(lds, DFF, DFF, (size_t)128 * DFF * 2, (size_t)128 * DFF * 2, S, E, (float*)(ws + WS_OF), (unsigned*)(ws + WS_CTL) + 4096 + 5 * 128);
            __syncthreads();
        }
#endif
        SchedSplit2 S{G, bx, (const char*)ACT, (const char*)(ws + WS_WDN0), (size_t)256 * DFF * 2, (size_t)256 * DFF * 2, DFF / 64};
        EpiResid E{X, X + (size_t)TCTX * D, X, MOD0 + 5 * D};
        pg8::gemm_phase<EpiResid, SchedSplit2, PG8_SP2, 0, true>(lds, DFF, DFF, (size_t)128 * DFF * 2, (size_t)128 * DFF * 2, S, E, (float*)(ws + WS_OF), (unsigned*)(ws + WS_CTL) + 4096 + 1 * 128);
    }
    SEAM(8);
    if (IN(9)) REPS(9) phase_norm_mod(X, X + (size_t)TCTX * D, a->in[22], MOD1, MOD1 + D, Hb, vcu, G);
    SEAM(9);
    if (IN(10)) REPS(10) {
        SchedF1 S{G, bx, (const char*)(ws + WS_DFTC), (const char*)Hb, 8};
        EpiF1 E{PQT};
        pg8::gemm_phase<EpiF1, SchedF1, PG8_SP2, 0>(lds, 512, D, (size_t)128 * 512 * 2, (size_t)128 * D * 2, S, E);
    }
    SEAM(10);
    if (IN(11)) REPS(11) {
        { SchedF2 S{G, bx, 1, (const char*)(ws + WS_DFT1024), (const char*)PQT, 32}; EpiBf16 E{CAT, D};
          pg8::gemm_phase<EpiBf16, SchedF2, PG8_SP2, 0>(lds, 2048, 2 * T, (size_t)128 * 2048 * 2, (size_t)128 * 2 * T * 2, S, E); }
        { SchedF2 S{G, bx, 0, (const char*)(ws + WS_DFT256), (const char*)PQT, 8}; EpiBf16 E{CAT, D};
          pg8::gemm_phase<EpiBf16, SchedF2, PG8_SP2, 0>(lds, 512, 2 * T, (size_t)128 * 512 * 2, (size_t)128 * 2 * T * 2, S, E); }
    }
    SEAM(11);
    if (IN(12)) {
        SchedSplit2 S{G, bx, (const char*)CAT, (const char*)(ws + WS_WOUT1), (size_t)256 * D * 2, (size_t)256 * D * 2, D / 64};
        EpiResid E{X, X + (size_t)TCTX * D, X, MOD1 + 2 * D};
        pg8::gemm_phase<EpiResid, SchedSplit2, PG8_SP2, 0, true>(lds, D, D, (size_t)128 * D * 2, (size_t)128 * D * 2, S, E, (float*)(ws + WS_OF), (unsigned*)(ws + WS_CTL) + 4096 + 2 * 128);
    }
    SEAM(12);
    if (IN(13)) REPS(13) phase_norm_mod(X, X + (size_t)TCTX * D, a->in[24], MOD1 + 3 * D, MOD1 + 4 * D, Hb, vcu, G);
    SEAM(13);
    if (IN(14)) {
        SchedDense S{48, DFF / 128, G, bx, (const char*)Hb, (const char*)(ws + WS_WUP1), (size_t)256 * D * 2, (size_t)256 * D * 2, ((REPMASK >> 14) & 1) ? REPN : 1, D / 64};
        EpiConv E{ACT, a->in[26], a->in[27], (LAS float*)(lds + LDS_XCH)};
        pg8::gemm_phase<EpiConv, SchedDense, PG8_SP2, 1>(lds, D, D, (size_t)4 * D * 2, (size_t)128 * D * 2, S, E);
    }
    SEAM(14);
    if (IN(15)) {
        SchedSplit2 S{G, bx, (const char*)ACT, (const char*)(ws + WS_WDN1), (size_t)256 * DFF * 2, (size_t)256 * DFF * 2, DFF / 64};
        EpiResid E{X, X + (size_t)TCTX * D, X, MOD1 + 5 * D};
        pg8::gemm_phase<EpiResid, SchedSplit2, PG8_SP2, 0, true>(lds, DFF, DFF, (size_t)128 * DFF * 2, (size_t)128 * DFF * 2, S, E, (float*)(ws + WS_OF), (unsigned*)(ws + WS_CTL) + 4096 + 3 * 128);
    }
    SEAM(15);
    if (IN(16)) REPS(16) phase_final_norm(X, a->in[29], vcu, G);
#undef IN
#undef SEAM
#undef ws
#undef X
#undef MOD0
#undef MOD1
#undef Hb
#undef CAT
#undef ACT
#undef PQT
}

extern "C" void kernel_launch(void* const* d_in, const int* in_sizes, int n_in, void* d_out, int out_size, void* d_ws, size_t ws_size, hipStream_t stream) {
    static int grid = 0;
    if (grid == 0) {
        if (n_in != 30 || ws_size < WS_END) { fprintf(stderr, "kernel_launch: need 30 inputs and %zu bytes of workspace (got %d, %zu)\n", (size_t)WS_END, n_in, ws_size); grid = -1; return; }
        int dev = 0, cus = 0, per_cu = 0;
        if (hipGetDevice(&dev) != hipSuccess || hipDeviceGetAttribute(&cus, hipDeviceAttributeMultiprocessorCount, dev) != hipSuccess) { grid = -1; return; }
        if (hipFuncSetAttribute((const void*)mk_fwd, hipFuncAttributeMaxDynamicSharedMemorySize, LDS_BYTES) != hipSuccess) { fprintf(stderr, "kernel_launch: hipFuncSetAttribute failed\n"); grid = -1; return; }
        if (hipOccupancyMaxActiveBlocksPerMultiprocessor(&per_cu, (const void*)mk_fwd, NT, LDS_BYTES) != hipSuccess || per_cu < 1) { fprintf(stderr, "kernel_launch: occupancy query says %d blocks per CU\n", per_cu); grid = -1; return; }
        grid = cus;
    }
    if (grid < 0) return;
    if (hipMemsetAsync((char*)d_ws + WS_CTL, 0, 65536, stream) != hipSuccess) { fprintf(stderr, "kernel_launch: hipMemsetAsync failed\n"); return; }
    Args a{};
    for (int i = 0; i < 30; ++i) a.in[i] = (const float*)d_in[i];
    a.out = (float*)d_out; a.ws = (unsigned char*)d_ws;
#if MK_FUSED
    a.ph_lo = 0; a.ph_hi = NPH;
    void* args[] = {&a};
    hipError_t e = hipLaunchCooperativeKernel((const void*)mk_fwd, dim3(grid), dim3(NT), args, LDS_BYTES, stream);
    if (e != hipSuccess) fprintf(stderr, "cooperative launch failed: %s (grid %d)\n", hipGetErrorString(e), grid);
#else
    for (int p = 0; p < NPH; ++p) {
        a.ph_lo = p; a.ph_hi = p + 1;
        void* args[] = {&a};
        hipError_t e = hipLaunchCooperativeKernel((const void*)mk_fwd, dim3(grid), dim3(NT), args, LDS_BYTES, stream);
        if (e != hipSuccess) { fprintf(stderr, "launch %d failed: %s (grid %d)\n", p, hipGetErrorString(e), grid); break; }
    }
#endif
}
```

```cpp
#include <hip/hip_runtime.h>
#include <hip/hip_cooperative_groups.h>
#include <cstdio>
#include <cstdint>
namespace cg = cooperative_groups;

#ifndef MK_FUSED
#define MK_FUSED 1
#endif

#define LAS __attribute__((address_space(3)))
typedef unsigned short bf16_t;
typedef short bf16x8 __attribute__((ext_vector_type(8)));
typedef float f32x4 __attribute__((ext_vector_type(4)));
typedef float f32x2 __attribute__((ext_vector_type(2)));
typedef unsigned u32x4 __attribute__((ext_vector_type(4)));
typedef unsigned u32x2 __attribute__((ext_vector_type(2)));

constexpr int D = 2048, T = 12288, TCTX = 4096;
constexpr int DFF = 5632, DFF2 = 11264, INW = 7168, AW = 1024;
constexpr int NPH = 17;
constexpr int NT = 512;

constexpr size_t WS_CTL = 0;
constexpr size_t WS_MOD = 65536;
constexpr size_t WS_WIN = WS_MOD + (size_t)2 * 9 * 12288 * 4;
constexpr size_t WS_WOUT0 = WS_WIN + (size_t)INW * D * 2;
constexpr size_t WS_WUP0 = WS_WOUT0 + (size_t)D * D * 2;
constexpr size_t WS_WDN0 = WS_WUP0 + (size_t)DFF2 * D * 2;
constexpr size_t WS_WOUT1 = WS_WDN0 + (size_t)D * DFF * 2;
constexpr size_t WS_WUP1 = WS_WOUT1 + (size_t)D * D * 2;
constexpr size_t WS_WDN1 = WS_WUP1 + (size_t)DFF2 * D * 2;
constexpr size_t WS_DFTC = WS_WDN1 + (size_t)D * DFF * 2;
constexpr size_t WS_DFT256 = WS_DFTC + (size_t)1024 * 512 * 2;
constexpr size_t WS_DFT1024 = WS_DFT256 + (size_t)256 * 512 * 2;
constexpr size_t WS_H = WS_DFT1024 + (size_t)1024 * 2048 * 2;
constexpr size_t WS_CAT = WS_H + (size_t)T * D * 2;
constexpr size_t WS_R1 = WS_CAT + (size_t)T * D * 2;
constexpr size_t WS_Q = WS_R1;
constexpr size_t WS_V = WS_Q + (size_t)T * AW * 2;
constexpr size_t WS_GA = WS_V + (size_t)T * AW * 2;
constexpr size_t WS_U = WS_GA + (size_t)T * AW * 2;
constexpr size_t WS_VV = WS_U + (size_t)T * AW * 2;
constexpr size_t WS_LF = WS_VV + (size_t)T * AW * 2;
constexpr size_t WS_OF = WS_LF + (size_t)T * 2048 * 4;
constexpr size_t WS_OB = WS_OF + (size_t)T * AW * 4;
constexpr size_t WS_R1_END = WS_OB + (size_t)T * AW * 4;
constexpr size_t WS_ACT = WS_R1;
constexpr size_t WS_PQT = WS_R1;
constexpr size_t WS_END = WS_R1_END;
static_assert(WS_ACT + (size_t)T * DFF * 2 <= WS_R1_END && WS_PQT + (size_t)2048 * 2 * T * 2 <= WS_R1_END, "aliases fit");

constexpr int LDS_BYTES = 147456;
constexpr int LDS_XCH = 131072;
constexpr int LDS_MISC = 131072 + 8192;

__device__ __forceinline__ unsigned f2bf(float f) { unsigned u = __builtin_bit_cast(unsigned, f); return (u + 0x7fffu + ((u >> 16) & 1u)) >> 16; }
__device__ __forceinline__ unsigned pk2(float lo, float hi) { unsigned r; asm("v_cvt_pk_bf16_f32 %0, %1, %2" : "=v"(r) : "v"(lo), "v"(hi)); return r; }
__device__ __forceinline__ float bflo(unsigned w) { return __builtin_bit_cast(float, w << 16); }
__device__ __forceinline__ float bfhi(unsigned w) { return __builtin_bit_cast(float, w & 0xffff0000u); }
__device__ __forceinline__ float bf2f(bf16_t b) { return __builtin_bit_cast(float, (unsigned)b << 16); }
__device__ __forceinline__ float wave_sum(float v) {
#pragma unroll
    for (int o = 1; o < 64; o <<= 1) v += __shfl_xor(v, o);
    return v;
}
__device__ __forceinline__ float fast_sigmoid(float x) { return __builtin_amdgcn_rcpf(1.0f + __expf(-x)); }
__device__ __forceinline__ float silu_f(float x) { return x * fast_sigmoid(x); }
__device__ __forceinline__ float gelu_tanh_f(float x) { const float u = 1.5957691216057308f * (x + 0.044715f * x * x * x); return x * fast_sigmoid(u); }
__device__ __forceinline__ int row_bi(int pm) { return pm < 16 ? 0 : 1 + ((pm - 16) >> 2); }
#define LDS_WAIT() asm volatile("s_waitcnt lgkmcnt(0)" ::: "memory")

namespace pg8 {
constexpr int BM = 256, BK = 64, HALF = 128, HTB = HALF * BK * 2, NXCD = 8, WGM = 8;
__device__ __forceinline__ int lds_byte(int r, int c) { const int st = (r >> 4) * 2 + (c >> 5), rr = r & 15, cc = c & 31, ob = rr * 64 + cc * 2; return st * 1024 + (ob ^ (((ob >> 9) & 1) << 5)); }
__device__ __forceinline__ void stage_rc(int b, int& R, int& C) { const int st = b / 1024, sb = b % 1024, swz = sb ^ (((sb >> 9) & 1) << 5); R = (st >> 1) * 16 + swz / 64; C = (st & 1) * 32 + (swz % 64) / 2; }
__device__ __forceinline__ int perm32(int rho) { const int n = rho >> 4, i = rho & 15; return 8 * (i >> 2) + 4 * n + (i & 3); }
__device__ __forceinline__ int permA_conv(int R) { return 8 * (16 * (R >> 6) + (R & 15)) + ((R >> 4) & 3); }

struct Unit { const char* A; const char* B; int e0, e1, e2, nt, sp; };

__device__ __forceinline__ void tile_order(int L, int nM, int nN, int& pm, int& pn) {
    const int nwg = nM * nN; int wgid = L;
    { const int q = nwg / NXCD, r = nwg % NXCD, xcd = wgid % NXCD, off = wgid / NXCD; wgid = (xcd < r ? xcd * (q + 1) : r * (q + 1) + (xcd - r) * q) + off; }
    const int nig = WGM * nN, gid = wgid / nig, fm = gid * WGM, gsz = (nM - fm) < WGM ? (nM - fm) : WGM;
    pm = fm + ((wgid % nig) % gsz); pn = (wgid % nig) / gsz;
}

template <class Epi, class Sched, bool SP2, int PERMA, bool SPLIT = false>
__device__ __forceinline__ void gemm_phase(LAS unsigned char* lds, const int lda, const int ldb, const size_t hstepA, const size_t hstepB, const Sched& S, const Epi& E, float* slabs = nullptr, unsigned* scnt = nullptr) {
    const int tid = threadIdx.x, wid = __builtin_amdgcn_readfirstlane(tid >> 6), lane = tid & 63, wr = wid >> 2, wc = wid & 3, fr = lane & 15, fq = lane >> 4;
    unsigned voffA[2], voffB[2];
#pragma unroll
    for (int i = 0; i < 2; ++i) { int R, C; stage_rc(tid * 16 + i * 8192, R, C); const int Ra = PERMA ? permA_conv(R) : R; const int Rb = (R & ~31) + perm32(R & 31);
        voffA[i] = (unsigned)(Ra * lda + C) * 2u; voffB[i] = (unsigned)(Rb * ldb + C) * 2u; }
    const size_t kstep = (size_t)(BK * 2);
    const unsigned ldsw = (unsigned)wid * 1024u;
    const int aoff = lds_byte(wr * 64 + fr, fq * 8), boff = lds_byte(wc * 32 + fr, fq * 8);
#define PG8_SA(b, h) (((b) * 2 + (h)) * HTB)
#define PG8_SB(b, h) ((4 + (b) * 2 + (h)) * HTB)
#define PG8_STAGE(bufoff, gbase, voff) do { _Pragma("unroll") for (int _i = 0; _i < 2; ++_i) \
        __builtin_amdgcn_global_load_lds((const unsigned*)((const char*)(gbase) + (voff)[_i]), (LAS unsigned*)(lds + (bufoff) + ldsw + _i * 8192), 16, 0, 0); } while (0)
#define PG8_LDA(dst, b, h) do { _Pragma("unroll") for (int m = 0; m < 4; ++m) _Pragma("unroll") for (int k = 0; k < 2; ++k) dst[m][k] = *(const LAS bf16x8*)(lds + PG8_SA(b, h) + aoff + m * 2048 + k * 1024); } while (0)
#define PG8_LDB(dst, b, h) do { _Pragma("unroll") for (int n = 0; n < 2; ++n) _Pragma("unroll") for (int k = 0; k < 2; ++k) dst[n][k] = *(const LAS bf16x8*)(lds + PG8_SB(b, h) + boff + n * 2048 + k * 1024); } while (0)
#define PG8_MMA(ai, bj, At, Bt) do { __builtin_amdgcn_s_setprio(1); _Pragma("unroll") for (int m = 0; m < 4; ++m) _Pragma("unroll") for (int n = 0; n < 2; ++n) _Pragma("unroll") for (int k = 0; k < 2; ++k) \
        acc[ai][bj][m][n] = __builtin_amdgcn_mfma_f32_16x16x32_bf16(Bt[n][k], At[m][k], acc[ai][bj][m][n], 0, 0, 0); __builtin_amdgcn_s_setprio(0); } while (0)
#define PG8_WAIT_V(n) asm volatile("s_waitcnt vmcnt(" #n ")" ::: "memory")
#define PG8_WAIT_L(n) asm volatile("s_waitcnt lgkmcnt(" #n ")" ::: "memory")
#define PG8_BAR __builtin_amdgcn_s_barrier()
#define PG8_SCHED __builtin_amdgcn_sched_barrier(0)
    Unit cur, nxt; int ui = 0;
    if (!S.next(0, cur)) return;
    f32x4 acc[2][2][4][2];
#pragma unroll
    for (int a = 0; a < 2; ++a)
#pragma unroll
        for (int b = 0; b < 2; ++b)
#pragma unroll
            for (int m = 0; m < 4; ++m)
#pragma unroll
                for (int n = 0; n < 2; ++n) acc[a][b][m][n] = (f32x4){0.f, 0.f, 0.f, 0.f};
    bf16x8 At[4][2], B0[2][2], B1[2][2];
    const char* cA = cur.A; const char* cB = cur.B;
    if constexpr (SP2) {
        PG8_STAGE(PG8_SB(0, 0), cB, voffB); PG8_STAGE(PG8_SB(0, 1), cB + hstepB, voffB); PG8_STAGE(PG8_SA(0, 0), cA, voffA); PG8_STAGE(PG8_SA(0, 1), cA + hstepA, voffA);
        if (wr == 1) PG8_BAR;
        PG8_WAIT_V(2); PG8_BAR;
        PG8_STAGE(PG8_SB(1, 0), cB + kstep, voffB); PG8_STAGE(PG8_SA(1, 0), cA + kstep, voffA); PG8_STAGE(PG8_SB(1, 1), cB + hstepB + kstep, voffB);
        PG8_WAIT_V(6); PG8_BAR;
    } else {
        PG8_STAGE(PG8_SB(0, 0), cB, voffB); PG8_STAGE(PG8_SA(0, 0), cA, voffA); PG8_STAGE(PG8_SB(0, 1), cB + hstepB, voffB); PG8_STAGE(PG8_SA(0, 1), cA + hstepA, voffA);
        if (wr == 1) PG8_BAR;
        PG8_WAIT_V(4); PG8_BAR;
        PG8_STAGE(PG8_SB(1, 0), cB + kstep, voffB); PG8_STAGE(PG8_SA(1, 0), cA + kstep, voffA); PG8_STAGE(PG8_SB(1, 1), cB + hstepB + kstep, voffB);
        PG8_WAIT_V(6); PG8_BAR;
    }
    for (;;) {
        const bool has_next = S.next(ui + 1, nxt);
        const char* nA = has_next ? nxt.A : cA; const char* nB = has_next ? nxt.B : cB;
        const int nt = SPLIT ? cur.nt : S.nt;
        for (int t = 0; t < nt; t += 2) {
            const bool last = (t == nt - 2);
            const char* a1 = cA + (size_t)(t + 1) * kstep;
            const char* a2 = last ? nA : cA + (size_t)(t + 2) * kstep; const char* b2 = last ? nB : cB + (size_t)(t + 2) * kstep;
            const char* a3 = a2 + kstep; const char* b3 = b2 + kstep;
            if constexpr (SP2) {
            PG8_LDB(B0, 0, 0); PG8_LDB(B1, 0, 1); PG8_SCHED; PG8_LDA(At, 0, 0); PG8_STAGE(PG8_SA(1, 1), a1 + hstepA, voffA);
            PG8_WAIT_V(8); PG8_WAIT_L(0); PG8_BAR; PG8_MMA(0, 0, At, B0); PG8_MMA(0, 1, At, B1); PG8_BAR; PG8_SCHED;
            PG8_LDA(At, 0, 1); PG8_STAGE(PG8_SB(0, 0), b2, voffB); PG8_STAGE(PG8_SB(0, 1), b2 + hstepB, voffB); PG8_STAGE(PG8_SA(0, 0), a2, voffA);
            PG8_WAIT_V(8); PG8_WAIT_L(0); PG8_BAR; PG8_MMA(1, 0, At, B0); PG8_MMA(1, 1, At, B1); PG8_BAR; PG8_SCHED;
            PG8_LDB(B0, 1, 0); PG8_LDB(B1, 1, 1); PG8_SCHED; PG8_LDA(At, 1, 0); PG8_STAGE(PG8_SA(0, 1), a2 + hstepA, voffA);
            PG8_WAIT_V(8); PG8_WAIT_L(0); PG8_BAR; PG8_MMA(0, 0, At, B0); PG8_MMA(0, 1, At, B1); PG8_BAR; PG8_SCHED;
            PG8_LDA(At, 1, 1); PG8_STAGE(PG8_SB(1, 0), b3, voffB); PG8_STAGE(PG8_SB(1, 1), b3 + hstepB, voffB); PG8_STAGE(PG8_SA(1, 0), a3, voffA);
            PG8_WAIT_V(8); PG8_WAIT_L(0); PG8_BAR; PG8_MMA(1, 0, At, B0); PG8_MMA(1, 1, At, B1); PG8_BAR; PG8_SCHED;
            } else {
            PG8_LDB(B0, 0, 0); PG8_SCHED; PG8_LDA(At, 0, 0); PG8_STAGE(PG8_SA(1, 1), a1 + hstepA, voffA);
            PG8_WAIT_L(8); PG8_BAR; PG8_WAIT_L(0); PG8_MMA(0, 0, At, B0); PG8_BAR; PG8_SCHED;
            PG8_LDB(B1, 0, 1); PG8_STAGE(PG8_SB(0, 0), b2, voffB);
            PG8_BAR; PG8_WAIT_L(0); PG8_MMA(0, 1, At, B1); PG8_BAR;
            PG8_LDA(At, 0, 1); PG8_STAGE(PG8_SA(0, 0), a2, voffA);
            PG8_BAR; PG8_WAIT_L(0); PG8_MMA(1, 0, At, B0); PG8_BAR; PG8_SCHED;
            PG8_STAGE(PG8_SB(0, 1), b2 + hstepB, voffB);
            PG8_WAIT_V(6); PG8_BAR; PG8_MMA(1, 1, At, B1); PG8_BAR;
            PG8_LDB(B0, 1, 0); PG8_SCHED; PG8_LDA(At, 1, 0); PG8_STAGE(PG8_SA(0, 1), a2 + hstepA, voffA);
            PG8_WAIT_L(8); PG8_BAR; PG8_WAIT_L(0); PG8_MMA(0, 0, At, B0); PG8_BAR; PG8_SCHED;
            PG8_LDB(B1, 1, 1); PG8_STAGE(PG8_SB(1, 0), b3, voffB);
            PG8_BAR; PG8_WAIT_L(0); PG8_MMA(0, 1, At, B1); PG8_BAR;
            PG8_LDA(At, 1, 1); PG8_STAGE(PG8_SA(1, 0), a3, voffA);
            PG8_BAR; PG8_WAIT_L(0); PG8_MMA(1, 0, At, B0); PG8_BAR; PG8_SCHED;
            PG8_STAGE(PG8_SB(1, 1), b3 + hstepB, voffB);
            PG8_WAIT_V(6); PG8_BAR; PG8_MMA(1, 1, At, B1); PG8_BAR;
            }
        }
        if (wr == 0) PG8_BAR;
        bool do_epi = true;
        if constexpr (SPLIT) if (cur.sp) {
            const int pair = (cur.sp - 1) >> 1, kpart = (cur.sp - 1) & 1;
            {
                const __amdgpu_buffer_rsrc_t rs = __builtin_amdgcn_make_buffer_rsrc((void*)slabs, (short)0, 256 * 32 * 512 * 16, 0x00020000);
                const unsigned v0 = (unsigned)(((pair * 2 + kpart) * 32 * 512 + tid) * 16);
#pragma unroll
                for (int r = 0; r < 32; ++r) __builtin_amdgcn_raw_buffer_store_b128(__builtin_bit_cast(u32x4, acc[r >> 4][(r >> 3) & 1][(r >> 1) & 3][r & 1]), rs, v0 + (unsigned)r * 8192u, 0, 16);
            }
            asm volatile("s_waitcnt vmcnt(0)" ::: "memory");
            PG8_BAR;
            LAS unsigned* flag = (LAS unsigned*)(lds + 131072 + 8192 + 64);
            if (tid == 0) {
                const unsigned old = __hip_atomic_fetch_add(scnt + pair, 1u, __ATOMIC_RELAXED, __HIP_MEMORY_SCOPE_AGENT);
                if (old == 1u) { __builtin_amdgcn_fence(__ATOMIC_ACQUIRE, "agent"); asm volatile("s_waitcnt vmcnt(0)" ::: "memory"); }
                *flag = old;
            }
            asm volatile("s_waitcnt lgkmcnt(0)" ::: "memory");
            PG8_BAR;
            asm volatile("" ::: "memory");
            do_epi = (*(volatile LAS unsigned*)flag == 1u);
            if (do_epi) {
                const float* s0 = slabs + ((size_t)(pair * 2) * 32 * 512 + tid) * 4; const float* s1 = s0 + (size_t)32 * 512 * 4;
#pragma unroll
                for (int r = 0; r < 32; ++r) acc[r >> 4][(r >> 3) & 1][(r >> 1) & 3][r & 1] = *(const f32x4*)(s0 + (size_t)r * 2048);
#pragma unroll
                for (int rb = 0; rb < 32; rb += 16) {
                    f32x4 t[16];
#pragma unroll
                    for (int r = 0; r < 16; ++r) t[r] = *(const f32x4*)(s1 + (size_t)(rb + r) * 2048);
                    asm volatile("" ::: "memory");
#pragma unroll
                    for (int r = 0; r < 16; ++r) acc[(rb + r) >> 4][((rb + r) >> 3) & 1][((rb + r) >> 1) & 3][(rb + r) & 1] += t[r];
                }
            }
        }
        if (do_epi) E(acc, cur, wr, wc, fr, fq);
        if (!has_next) break;
#pragma unroll
        for (int a = 0; a < 2; ++a)
#pragma unroll
            for (int b = 0; b < 2; ++b)
#pragma unroll
                for (int m = 0; m < 4; ++m)
#pragma unroll
                    for (int n = 0; n < 2; ++n) acc[a][b][m][n] = (f32x4){0.f, 0.f, 0.f, 0.f};
        cur = nxt; cA = nA; cB = nB; ++ui;
        if (wr == 1) PG8_BAR;
    }
    PG8_WAIT_V(0);
    PG8_BAR;
#undef PG8_SA
#undef PG8_SB
#undef PG8_STAGE
#undef PG8_LDA
#undef PG8_LDB
#undef PG8_MMA
#undef PG8_WAIT_V
#undef PG8_WAIT_L
#undef PG8_BAR
#undef PG8_SCHED
}
}
using pg8::Unit;
typedef f32x4 Acc[2][2][4][2];

struct SchedDense {
    int nM, nN, G, c; const char* A; const char* B; size_t astep, bstep; int reps, nt;
    __device__ __forceinline__ bool next(int i, Unit& u) const {
        long L = (long)i * G + c; if (L >= (long)reps * nM * nN) return false; L %= (long)nM * nN;
        int pm, pn; pg8::tile_order((int)L, nM, nN, pm, pn);
        u.A = A + (size_t)pm * astep; u.B = B + (size_t)pn * bstep; u.e0 = pm; u.e1 = pn; u.e2 = 0; u.nt = nt; u.sp = 0; return true;
    }
};
struct SchedSplit2 {
    int G, c; const char* A; const char* B; size_t astep, bstep; int nt;
    __device__ __forceinline__ bool next(int i, Unit& u) const {
        int L = c, kpart = 0, sp = 0, n = nt; size_t koff = 0;
        if (G != 256) { L = i * G + c; if (L >= 384) return false; }
        else if (i > 1) return false;
        else if (i == 1) { const int x = c & 7, t = c >> 3, j = t >> 1; kpart = t & 1; L = 256 + 8 * j + x; sp = 1 + 2 * (8 * j + x) + kpart; n = nt / 2; koff = (size_t)kpart * n * 128; }
        int pm, pn; pg8::tile_order(L, 48, 8, pm, pn);
        u.A = A + (size_t)pm * astep + koff; u.B = B + (size_t)pn * bstep + koff; u.e0 = pm; u.e1 = pn; u.e2 = 0; u.nt = n; u.sp = sp; return true;
    }
};
struct SchedF1 {
    int G, c; const char* A; const char* B; int nt;
    __device__ __forceinline__ bool next(int i, Unit& u) const {
        const long L = (long)i * G + c; if (L >= 16 * 48) return false;
        int pmm, pn; pg8::tile_order((int)L, 16, 48, pmm, pn);
        const int g = pmm >> 2, pmd = pmm & 3;
        u.A = A + (size_t)pmd * 256 * 512 * 2; u.B = B + ((size_t)pn * 256 * D + (size_t)g * 512) * 2; u.e0 = pmd; u.e1 = pn; u.e2 = g; u.nt = 8; u.sp = 0; return true;
    }
};
struct SchedF2 {
    int G, c, smp; const char* A; const char* B; int nt;
    __device__ __forceinline__ bool next(int i, Unit& u) const {
        const long L = (long)i * G + c;
        if (smp) { if (L >= 256) return false; const int l = (int)L, pn2 = l & 1, pm = (l >> 1) & 3, g = (l >> 3) & 3, s = l >> 5;
            u.A = A + (size_t)pm * 256 * 2048 * 2; u.B = B + (((size_t)(g * 512 + pn2 * 256)) * (2 * T) + 2 * (size_t)(TCTX + 1024 * s)) * 2;
            u.e0 = (TCTX + 1024 * s + 256 * pm) >> 8; u.e1 = g * 2 + pn2; u.e2 = 0; u.nt = 32; u.sp = 0; return true; }
        if (L >= 128) return false; const int l = (int)L, pn2 = l & 1, g = (l >> 1) & 3, s = l >> 3;
        u.A = A; u.B = B + (((size_t)(g * 512 + pn2 * 256)) * (2 * T) + 2 * (size_t)(256 * s)) * 2;
        u.e0 = s; u.e1 = g * 2 + pn2; u.e2 = 0; u.nt = 8; u.sp = 0; return true;
    }
};

struct EpiInProj {
    bf16_t *Q, *V, *GA, *U, *VV; float* LF; const float* lbraw;
    __device__ __forceinline__ void operator()(Acc& acc, const Unit& u, int wr, int wc, int fr, int fq) const {
        const int pm = u.e0, pn = u.e1, seg = pn >> 2;
        const int row0 = pm * 256 + wr * 64 + fr, cs0 = (pn & 3) * 256 + wc * 32 + 8 * fq;
#pragma unroll
        for (int bj = 0; bj < 2; ++bj) {
            const int col = cs0 + bj * 128;
            if (seg == 1 || seg == 2) {
                const float* l0 = lbraw + (seg - 1) * 2048 + col;
                float lb[8];
#pragma unroll
                for (int j = 0; j < 8; ++j) lb[j] = fast_sigmoid(l0[j] - l0[1024 + j]);
#pragma unroll
                for (int ai = 0; ai < 2; ++ai)
#pragma unroll
                    for (int m = 0; m < 4; ++m) {
                        const int row = row0 + ai * 128 + m * 16;
                        f32x4 o0, o1;
#pragma unroll
                        for (int e = 0; e < 4; ++e) { o0[e] = __logf(lb[e] + (1.f - lb[e]) * fast_sigmoid(acc[ai][bj][m][0][e])); o1[e] = __logf(lb[4 + e] + (1.f - lb[4 + e]) * fast_sigmoid(acc[ai][bj][m][1][e])); }
                        float* p = LF + (size_t)row * 2048 + (seg - 1) * 1024 + col;
                        *(f32x4*)p = o0; *(f32x4*)(p + 4) = o1;
                    }
            } else {
                bf16_t* base = seg == 0 ? Q : seg == 3 ? V : seg == 4 ? GA : seg == 5 ? U : VV;
#pragma unroll
                for (int ai = 0; ai < 2; ++ai)
#pragma unroll
                    for (int m = 0; m < 4; ++m) {
                        const int row = row0 + ai * 128 + m * 16;
                        f32x4 v0 = acc[ai][bj][m][0], v1 = acc[ai][bj][m][1];
                        if (seg == 0) {
#pragma unroll
                            for (int e = 0; e < 4; ++e) { v0[e] = silu_f(v0[e]) * 0.08838834764831845f; v1[e] = silu_f(v1[e]) * 0.08838834764831845f; }
                        } else if (seg == 4) {
#pragma unroll
                            for (int e = 0; e < 4; ++e) { v0[e] = silu_f(v0[e]); v1[e] = silu_f(v1[e]); }
                        } else if (seg >= 5) {
#pragma unroll
                            for (int e = 0; e < 4; ++e) { v0[e] = gelu_tanh_f(v0[e]); v1[e] = gelu_tanh_f(v1[e]); }
                        }
                        u32x4 w; w.x = pk2(v0[0], v0[1]); w.y = pk2(v0[2], v0[3]); w.z = pk2(v1[0], v1[1]); w.w = pk2(v1[2], v1[3]);
                        *(u32x4*)(base + (size_t)row * 1024 + col) = w;
                    }
            }
        }
    }
};
struct EpiResid {
    const float* xin0; const float* xin1; float* xout; const float* gate;
    __device__ __forceinline__ void operator()(Acc& acc, const Unit& u, int wr, int wc, int fr, int fq) const {
        const int pm = u.e0, pn = u.e1;
        const int row0 = pm * 256 + wr * 64 + fr, col0 = pn * 256 + wc * 32 + 8 * fq;
        const float* g = gate + (size_t)row_bi(pm) * 12288 + col0;
        const float* xin = pm < 16 ? xin0 : xin1 - (size_t)TCTX * D;
        f32x4 gv[2][2];
#pragma unroll
        for (int bj = 0; bj < 2; ++bj) { gv[bj][0] = *(const f32x4*)(g + bj * 128); gv[bj][1] = *(const f32x4*)(g + bj * 128 + 4); }
#pragma unroll
        for (int ai = 0; ai < 2; ++ai) {
            f32x4 xv[4][2][2];
#pragma unroll
            for (int m = 0; m < 4; ++m)
#pragma unroll
                for (int bj = 0; bj < 2; ++bj) { const float* p = xin + (size_t)(row0 + ai * 128 + m * 16) * D + col0 + bj * 128; xv[m][bj][0] = *(const f32x4*)p; xv[m][bj][1] = *(const f32x4*)(p + 4); }
            asm volatile("" ::: "memory");
#pragma unroll
            for (int m = 0; m < 4; ++m)
#pragma unroll
                for (int bj = 0; bj < 2; ++bj) { float* p = xout + (size_t)(row0 + ai * 128 + m * 16) * D + col0 + bj * 128;
                    *(f32x4*)p = xv[m][bj][0] + gv[bj][0] * acc[ai][bj][m][0]; *(f32x4*)(p + 4) = xv[m][bj][1] + gv[bj][1] * acc[ai][bj][m][1]; }
            asm volatile("" ::: "memory");
        }
    }
};
__device__ __forceinline__ float dpp_shr1(float src, float old) { return __builtin_bit_cast(float, __builtin_amdgcn_update_dpp(__builtin_bit_cast(int, old), __builtin_bit_cast(int, src), 0x111, 0xf, 0xf, false)); }
__device__ __forceinline__ float dpp_shl1(float src, float old) { return __builtin_bit_cast(float, __builtin_amdgcn_update_dpp(__builtin_bit_cast(int, old), __builtin_bit_cast(int, src), 0x101, 0xf, 0xf, false)); }
struct EpiConv {
    bf16_t* ACT; const float* cw; const float* cb; LAS float* xch;
    __device__ __forceinline__ void operator()(Acc& acc, const Unit& u, int wr, int wc, int fr, int fq) const {
        const int pm = u.e0, pn = u.e1; const bool ctx = pm < 16;
        LAS float* mine = xch + (wr * 4 + wc) * 64; const LAS float* other = xch + ((wr ^ 1) * 4 + wc) * 64;
        if (wr == 0) { if (fr == 15) {
#pragma unroll
            for (int bj = 0; bj < 2; ++bj)
#pragma unroll
                for (int n = 0; n < 2; ++n) *(LAS f32x4*)(mine + ((bj * 2 + n) * 4 + fq) * 4) = acc[1][bj][3][n]; } }
        else { if (fr == 0) {
#pragma unroll
            for (int bj = 0; bj < 2; ++bj)
#pragma unroll
                for (int n = 0; n < 2; ++n) *(LAS f32x4*)(mine + ((bj * 2 + n) * 4 + fq) * 4) = acc[0][bj][0][n]; } }
        LDS_WAIT(); __builtin_amdgcn_s_barrier(); asm volatile("" ::: "memory");
        const bool zl = !ctx && fr == 8, zr = !ctx && fr == 7;
        const int wcol0 = 128 * pn + 32 * wc + 8 * fq;
#pragma unroll
        for (int bj = 0; bj < 2; ++bj)
#pragma unroll
            for (int n = 0; n < 2; ++n) {
                const float* wp = cw + bj * DFF + wcol0 + 4 * n; const float* bp = cb + bj * DFF + wcol0 + 4 * n;
                f32x4 hv = *(const LAS f32x4*)(other + ((bj * 2 + n) * 4 + fq) * 4); if (!ctx) hv = (f32x4){0.f, 0.f, 0.f, 0.f};
#pragma unroll
                for (int e = 0; e < 4; ++e) {
                    const float w0 = wp[e], w1 = wp[DFF2 + e], w2 = wp[2 * DFF2 + e], bb = bp[e];
                    float x[8];
#pragma unroll
                    for (int j = 0; j < 8; ++j) x[j] = acc[j >> 2][bj][j & 3][n][e];
                    float left = dpp_shr1(x[7], wr == 1 ? hv[e] : 0.f);
                    float right = dpp_shl1(x[0], wr == 0 ? hv[e] : 0.f);
                    if (zl) left = 0.f; if (zr) right = 0.f;
#pragma unroll
                    for (int j = 0; j < 8; ++j) {
                        const float xm = j == 0 ? left : x[j - 1], xp = j == 7 ? right : x[j + 1];
                        acc[j >> 2][bj][j & 3][n][e] = w0 * xm + w1 * x[j] + w2 * xp + bb;
                    }
                }
                asm volatile("" ::: "memory");
            }
#pragma unroll
        for (int ai = 0; ai < 2; ++ai)
#pragma unroll
            for (int m = 0; m < 4; ++m) {
                const int tok = pm * 256 + 8 * (16 * wr + fr) + 4 * ai + m;
                f32x4 o0, o1;
#pragma unroll
                for (int e = 0; e < 4; ++e) { o0[e] = silu_f(acc[ai][0][m][0][e]) * acc[ai][1][m][0][e]; o1[e] = silu_f(acc[ai][0][m][1][e]) * acc[ai][1][m][1][e]; }
                u32x4 w; w.x = pk2(o0[0], o0[1]); w.y = pk2(o0[2], o0[3]); w.z = pk2(o1[0], o1[1]); w.w = pk2(o1[2], o1[3]);
                *(u32x4*)(ACT + (size_t)tok * DFF + wcol0) = w;
                asm volatile("" ::: "memory");
            }
    }
};
struct EpiF1 {
    bf16_t* PQT;
    __device__ __forceinline__ void operator()(Acc& acc, const Unit& u, int wr, int wc, int fr, int fq) const {
        const int pmd = u.e0, pn = u.e1, g = u.e2, which = pmd >> 1;
        int sb2, N, n0;
        if (pn < 16) { sb2 = 2 * 256 * pn; N = 256; n0 = 0; } else { const int s = (pn - 16) >> 2; sb2 = 2 * (TCTX + 1024 * s); N = 1024; n0 = ((pn - 16) & 3) * 256; }
        const int c0 = g * 512 + (pmd & 1) * 256 + wr * 64 + fr;
        bf16_t* base = PQT + (size_t)sb2 + which * N + n0 + wc * 32 + 8 * fq;
#pragma unroll
        for (int ai = 0; ai < 2; ++ai)
#pragma unroll
            for (int m = 0; m < 4; ++m) {
                bf16_t* rowp = base + (size_t)(c0 + ai * 128 + m * 16) * (2 * T);
#pragma unroll
                for (int bj = 0; bj < 2; ++bj) { const f32x4 v0 = acc[ai][bj][m][0], v1 = acc[ai][bj][m][1];
                    u32x4 w; w.x = pk2(v0[0], v0[1]); w.y = pk2(v0[2], v0[3]); w.z = pk2(v1[0], v1[1]); w.w = pk2(v1[2], v1[3]);
                    *(u32x4*)(rowp + bj * 128) = w; }
            }
    }
};
struct EpiBf16 {
    bf16_t* O; int ldo;
    __device__ __forceinline__ void operator()(Acc& acc, const Unit& u, int wr, int wc, int fr, int fq) const {
        const int row0 = u.e0 * 256 + wr * 64 + fr, col0 = u.e1 * 256 + wc * 32 + 8 * fq;
#pragma unroll
        for (int ai = 0; ai < 2; ++ai)
#pragma unroll
            for (int m = 0; m < 4; ++m) {
                bf16_t* rowp = O + (size_t)(row0 + ai * 128 + m * 16) * ldo + col0;
#pragma unroll
                for (int bj = 0; bj < 2; ++bj) { const f32x4 v0 = acc[ai][bj][m][0], v1 = acc[ai][bj][m][1];
                    u32x4 w; w.x = pk2(v0[0], v0[1]); w.y = pk2(v0[2], v0[3]); w.z = pk2(v1[0], v1[1]); w.w = pk2(v1[2], v1[3]);
                    *(u32x4*)(rowp + bj * 128) = w; }
            }
    }
};

struct Args { const float* in[30]; float* out; unsigned char* ws; int ph_lo, ph_hi; };
typedef const __attribute__((address_space(4))) Args* KA;
__device__ __forceinline__ KA kargs() { auto kp = __builtin_amdgcn_kernarg_segment_ptr(); asm volatile("" : "+s"(kp)); return (KA)kp; }

struct CvtSrc { const float* W; bf16_t* WT; int K, N, up, item; };
__device__ __forceinline__ void cvt_load(const CvtSrc& c, int lane, f32x4 (&r)[16]) {
    const int nblk = c.N / 64, kb = c.item / nblk, nb = c.item % nblk, k0 = 64 * kb, n0 = 64 * nb;
    const int cc = lane & 15, q = lane >> 4;
#pragma unroll
    for (int i = 0; i < 16; ++i) { const int kk = 8 * (i >> 1) + 2 * q + (i & 1); r[i] = *(const f32x4*)(c.W + (size_t)(k0 + kk) * c.N + n0 + 4 * cc); }
}
__device__ __forceinline__ void cvt_store(const CvtSrc& c, int lane, const f32x4 (&r)[16], LAS unsigned* scr) {
    const int nblk = c.N / 64, kb = c.item / nblk, nb = c.item % nblk, k0 = 64 * kb, n0 = 64 * nb;
    const int cc = lane & 15, q = lane >> 4;
#pragma unroll
    for (int ip = 0; ip < 8; ++ip)
#pragma unroll
        for (int e = 0; e < 4; ++e) scr[(4 * cc + e) * 33 + 4 * ip + q] = pk2(r[2 * ip][e], r[2 * ip + 1][e]);
    LDS_WAIT(); asm volatile("" ::: "memory");
    const int c8 = lane & 7;
#pragma unroll
    for (int j = 0; j < 8; ++j) { const int n = (lane >> 3) + 8 * j; const LAS unsigned* sp = scr + n * 33 + 4 * c8;
        u32x4 o; o.x = sp[0]; o.y = sp[1]; o.z = sp[2]; o.w = sp[3];
        int nn = n0 + n;
        if (c.up) { const int bjj = nn >= DFF ? 1 : 0, cgc = nn - bjj * DFF; nn = (cgc >> 7) * 256 + bjj * 128 + (cgc & 127); }
        *(u32x4*)(c.WT + (size_t)nn * c.K + k0 + 8 * c8) = o; }
    LDS_WAIT(); asm volatile("" ::: "memory");
}
__device__ __forceinline__ bool cvt_pick(KA a, int set, int it, CvtSrc& c) {
    unsigned char* ws = a->ws;
    constexpr int I_IN = 32 * (INW / 64), I_O = 32 * (D / 64), I_UP = 32 * (DFF2 / 64), I_DN = (DFF / 64) * (D / 64);
    if (set == 0) { if (it >= I_IN) return false; c.W = a->in[8]; c.WT = (bf16_t*)(ws + WS_WIN); c.K = D; c.N = INW; c.up = 0; c.item = it; return true; }
    if (it >= I_O + I_UP + I_DN) return false;
    int r = it;
    if (r < I_O) { c.W = a->in[set == 1 ? 14 : 23]; c.WT = (bf16_t*)(ws + (set == 1 ? WS_WOUT0 : WS_WOUT1)); c.K = D; c.N = D; c.up = 0; c.item = r; return true; } r -= I_O;
    if (r < I_UP) { c.W = a->in[set == 1 ? 16 : 25]; c.WT = (bf16_t*)(ws + (set == 1 ? WS_WUP0 : WS_WUP1)); c.K = D; c.N = DFF2; c.up = 1; c.item = r; return true; } r -= I_UP;
    c.W = a->in[set == 1 ? 19 : 28]; c.WT = (bf16_t*)(ws + (set == 1 ? WS_WDN0 : WS_WDN1)); c.K = DFF; c.N = D; c.up = 0; c.item = r; return true;
}
__device__ __forceinline__ void convert_set(KA a, LAS unsigned char* lds, int set, int gw, int NGW, int i0 = 0, int i1 = 1 << 30) {
    const int lane = threadIdx.x & 63, wave = __builtin_amdgcn_readfirstlane(threadIdx.x >> 6);
    LAS unsigned* scr = (LAS unsigned*)(lds + wave * 8448);
    CvtSrc cur, nxt; f32x4 r0[16], r1[16];
    int it = i0 + gw;
    if (it >= i1 || !cvt_pick(a, set, it, cur)) return;
    cvt_load(cur, lane, r0);
    for (;;) {
        it += NGW; const bool h1 = it < i1 && cvt_pick(a, set, it, nxt);
        if (h1) cvt_load(nxt, lane, r1);
        cvt_store(cur, lane, r0, scr);
        if (!h1) break;
        it += NGW; const bool h2 = it < i1 && cvt_pick(a, set, it, cur);
        if (h2) cvt_load(cur, lane, r0);
        cvt_store(nxt, lane, r1, scr);
        if (!h2) break;
    }
}
__device__ __forceinline__ void dft_tables(unsigned char* ws, int gt, int GT) {
    bf16_t* DC = (bf16_t*)(ws + WS_DFTC); bf16_t* D256 = (bf16_t*)(ws + WS_DFT256); bf16_t* D1024 = (bf16_t*)(ws + WS_DFT1024);
    for (int i = gt; i < 1024 * 512; i += GT) { const int r = i >> 9, k = i & 511, c = r & 511; const float ang = 2.0f * (float)((c * k) & 511) * (1.0f / 512.0f);
        const float v = (r < 512 ? cospif(ang) : sinpif(ang)) * 0.04419417382415922f; DC[i] = (bf16_t)f2bf(v); }
    for (int i = gt; i < 256 * 512; i += GT) { const int p = i >> 9, k = i & 511, n = k & 255; const float ang = 2.0f * (float)((p * n) & 255) * (1.0f / 256.0f);
        const float v = (k < 256 ? cospif(ang) : -sinpif(ang)) * 0.0625f; D256[i] = (bf16_t)f2bf(v); }
    for (int i = gt; i < 1024 * 2048; i += GT) { const int p = i >> 11, k = i & 2047, n = k & 1023; const float ang = 2.0f * (float)((p * n) & 1023) * (1.0f / 1024.0f);
        const float v = (k < 1024 ? cospif(ang) : -sinpif(ang)) * 0.03125f; D1024[i] = (bf16_t)f2bf(v); }
}
__device__ __forceinline__ void phase_prologue(KA a, LAS unsigned char* lds, int vcu, int G) {
    const int tid = threadIdx.x, lane = tid & 63, wave = __builtin_amdgcn_readfirstlane(tid >> 6);
    unsigned char* ws = a->ws;
    __syncthreads();
    if (vcu < 192) {
        const int l = vcu / 96, n0 = (vcu % 96) * 128;
        const float* Wm = a->in[l ? 20 : 5]; const float* bm = a->in[l ? 21 : 6];
        LAS float* S = (LAS float*)lds;
        {
            const float* cc = a->in[4]; const float* cs = a->in[3];
            float cv[4][9];
#pragma unroll
            for (int j = 0; j < 4; ++j) { const int k = tid + NT * j; cv[j][0] = cc[k];
#pragma unroll
                for (int bi = 1; bi < 9; ++bi) cv[j][bi] = cs[(bi - 1) * 2048 + k]; }
#pragma unroll
            for (int j = 0; j < 4; ++j) { const int k = tid + NT * j;
#pragma unroll
                for (int bi = 0; bi < 9; ++bi) S[k * 12 + bi] = silu_f(cv[j][bi]); }
        }
        __syncthreads();
        const int l4 = tid & 31, rg = tid >> 5;
        f32x4 accm[9];
#pragma unroll
        for (int bi = 0; bi < 9; ++bi) accm[bi] = (f32x4){0.f, 0.f, 0.f, 0.f};
#pragma unroll 8
        for (int kk = 0; kk < 128; ++kk) {
            const int k = rg + 16 * kk;
            const f32x4 w = *(const f32x4*)(Wm + (size_t)k * 12288 + n0 + 4 * l4);
            const f32x4 s0 = *(const LAS f32x4*)(S + k * 12), s1 = *(const LAS f32x4*)(S + k * 12 + 4); const float s8 = S[k * 12 + 8];
            accm[0] += s0[0] * w; accm[1] += s0[1] * w; accm[2] += s0[2] * w; accm[3] += s0[3] * w;
            accm[4] += s1[0] * w; accm[5] += s1[1] * w; accm[6] += s1[2] * w; accm[7] += s1[3] * w; accm[8] += s8 * w;
        }
        __syncthreads();
        LAS float* red = (LAS float*)lds;
#pragma unroll
        for (int bi = 0; bi < 9; ++bi) *(LAS f32x4*)(red + (rg * 9 + bi) * 128 + 4 * l4) = accm[bi];
        __syncthreads();
        float* MOD = (float*)(ws + WS_MOD) + (size_t)l * 9 * 12288;
        for (int o = tid; o < 9 * 128; o += NT) { const int bi = o >> 7, n = o & 127; float s = bm[n0 + n];
#pragma unroll
            for (int r = 0; r < 16; ++r) s += red[(r * 9 + bi) * 128 + n];
            MOD[(size_t)bi * 12288 + n0 + n] = s; }
        __syncthreads();
    }
    __syncthreads();
    if (G == 256) { if (vcu >= 192) convert_set(a, lds, 0, (vcu - 192) * 8 + wave, 64 * 8); }
    else convert_set(a, lds, 0, vcu * 8 + wave, G * 8);
    if (G != 256) { convert_set(a, lds, 1, vcu * 8 + wave, G * 8); convert_set(a, lds, 2, vcu * 8 + wave, G * 8); dft_tables(ws, vcu * NT + tid, G * NT); }
}

__device__ __forceinline__ void phase_norm_mod(const float* x0, const float* x1, const float* nw, const float* sh, const float* sc, bf16_t* H, int vcu, int G) {
    const int lane = threadIdx.x & 63, wave = __builtin_amdgcn_readfirstlane(threadIdx.x >> 6);
    const int gw = vcu * 8 + wave, NGW = G * 8;
    const int chunk = (T + NGW - 1) / NGW, r0 = gw * chunk, r1 = (r0 + chunk < T) ? r0 + chunk : T;
    if (r0 >= r1) return;
    f32x4 wv[8], av[8], vn[8]; int bi_cur = -1;
#define NRM_LOAD(r) do { const int r_ = (r); const float* xr = r_ < TCTX ? x0 + (size_t)r_ * D : x1 + (size_t)(r_ - TCTX) * D; \
        _Pragma("unroll") for (int j = 0; j < 8; ++j) vn[j] = *(const f32x4*)(xr + 4 * lane + 256 * j); } while (0)
    NRM_LOAD(r0);
    for (int row = r0; row < r1; ++row) {
        f32x4 v[8];
#pragma unroll
        for (int j = 0; j < 8; ++j) v[j] = vn[j];
        NRM_LOAD(row + 1 < r1 ? row + 1 : row);
        const int bi = row < TCTX ? 0 : 1 + ((row - TCTX) >> 10);
        if (bi != bi_cur) { bi_cur = bi; const float* shp = sh + (size_t)bi * 12288; const float* scp = sc + (size_t)bi * 12288;
#pragma unroll
            for (int j = 0; j < 8; ++j) { const int c = 4 * lane + 256 * j; wv[j] = *(const f32x4*)(nw + c) * (*(const f32x4*)(scp + c) + 1.0f); av[j] = *(const f32x4*)(shp + c); } }
        float s = 0.f;
#pragma unroll
        for (int j = 0; j < 8; ++j) s += (v[j][0] * v[j][0] + v[j][1] * v[j][1]) + (v[j][2] * v[j][2] + v[j][3] * v[j][3]);
        const float rstd = rsqrtf(wave_sum(s) * (1.0f / D) + 1e-6f);
#pragma unroll
        for (int j = 0; j < 8; ++j) { const int c = 4 * lane + 256 * j;
            const f32x4 o = v[j] * rstd * wv[j] + av[j];
            u32x2 p; p.x = pk2(o[0], o[1]); p.y = pk2(o[2], o[3]);
            *(u32x2*)(H + (size_t)row * D + c) = p; }
    }
#undef NRM_LOAD
}
__device__ __forceinline__ void phase_final_norm(float* X, const float* nw, int vcu, int G) {
    const int lane = threadIdx.x & 63, wave = __builtin_amdgcn_readfirstlane(threadIdx.x >> 6);
    const int gw = vcu * 8 + wave, NGW = G * 8;
    const int chunk = (T + NGW - 1) / NGW, r0 = gw * chunk, r1 = (r0 + chunk < T) ? r0 + chunk : T;
    if (r0 >= r1) return;
    f32x4 wv[8], vn[8];
#pragma unroll
    for (int j = 0; j < 8; ++j) wv[j] = *(const f32x4*)(nw + 4 * lane + 256 * j);
#define NRM_LOAD(r) do { const float* xr = X + (size_t)(r) * D; _Pragma("unroll") for (int j = 0; j < 8; ++j) vn[j] = *(const f32x4*)(xr + 4 * lane + 256 * j); } while (0)
    NRM_LOAD(r0);
    for (int row = r0; row < r1; ++row) {
        f32x4 v[8];
#pragma unroll
        for (int j = 0; j < 8; ++j) v[j] = vn[j];
        NRM_LOAD(row + 1 < r1 ? row + 1 : row);
        float s = 0.f;
#pragma unroll
        for (int j = 0; j < 8; ++j) s += (v[j][0] * v[j][0] + v[j][1] * v[j][1]) + (v[j][2] * v[j][2] + v[j][3] * v[j][3]);
        const float rstd = rsqrtf(wave_sum(s) * (1.0f / D) + 1e-6f);
        float* xr = X + (size_t)row * D;
#pragma unroll
        for (int j = 0; j < 8; ++j) *(f32x4*)(xr + 4 * lane + 256 * j) = v[j] * rstd * wv[j];
    }
#undef NRM_LOAD
}

constexpr int P128 = 136, P64 = 72;
constexpr int SC_QS = 0, SC_KS = SC_QS + 64 * P128 * 2, SC_QI = SC_KS + 64 * P128 * 2, SC_KO = SC_QI + 64 * P128 * 2, SC_VT = SC_KO + 128 * P64 * 2,
              SC_SC = SC_VT + 128 * P64 * 2, SC_ST = SC_SC + 64 * P64 * 2, SC_TOT = SC_ST + 128 * P128 * 2, SC_DEC = SC_TOT + 4 * 128 * 4, SC_END = SC_DEC + 128 * 4;
static_assert(SC_END <= LDS_BYTES, "scan LDS");
__device__ __forceinline__ void scan_item(KA a, LAS unsigned char* lds, int seqbase, int N, int b_state, int h, int dir, bool ctx, int b_out) {
    int tid = threadIdx.x; asm volatile("" : "+v"(tid));
    const int lane = tid & 63, w = __builtin_amdgcn_readfirstlane(tid >> 6), fr = lane & 15, fq = lane >> 4;
    unsigned char* ws = a->ws;
    const bf16_t* Qg = (const bf16_t*)(ws + WS_Q) + h * 128; const bf16_t* Vg = (const bf16_t*)(ws + WS_V) + h * 128;
    const float* LFg = (const float*)(ws + WS_LF) + dir * 1024 + h * 128;
    float* Og = (float*)(ws + (dir ? WS_OB : WS_OF)) + h * 128;
    LAS bf16_t* QS = (LAS bf16_t*)(lds + SC_QS); LAS bf16_t* KS = (LAS bf16_t*)(lds + SC_KS); LAS bf16_t* QI = (LAS bf16_t*)(lds + SC_QI);
    LAS bf16_t* KO = (LAS bf16_t*)(lds + SC_KO); LAS bf16_t* VT = (LAS bf16_t*)(lds + SC_VT); LAS bf16_t* SCm = (LAS bf16_t*)(lds + SC_SC);
    LAS bf16_t* ST = (LAS bf16_t*)(lds + SC_ST); LAS float* TOT = (LAS float*)(lds + SC_TOT); LAS float* DEC = (LAS float*)(lds + SC_DEC);
    const int ch = tid & 127, seg = tid >> 7;
    f32x4 accS[8];
    if (ctx) {
#pragma unroll
        for (int kt = 0; kt < 8; ++kt) accS[kt] = (f32x4){0.f, 0.f, 0.f, 0.f};
    } else {
        const float* s0 = a->in[2] + ((size_t)(b_state * 2 + dir) * 8 + h) * 16384;
#pragma unroll
        for (int kt = 0; kt < 8; ++kt)
#pragma unroll
            for (int e = 0; e < 4; ++e) accS[kt][e] = s0[(16 * kt + 4 * fq + e) * 128 + 16 * w + fr];
    }
    __syncthreads();
#pragma unroll
    for (int kt = 0; kt < 8; ++kt) { u32x2 p; p.x = pk2(accS[kt][0], accS[kt][1]); p.y = pk2(accS[kt][2], accS[kt][3]); *(LAS u32x2*)(ST + (16 * w + fr) * P128 + 16 * kt + 4 * fq) = p; }
    const int nc = N >> 6;
    float lfN[16]; unsigned short qN[16], vN[16];
#define SCAN_LOAD(cc) do { _Pragma("unroll") for (int ii = 0; ii < 16; ++ii) { \
            const int i = 64 * (cc) + 16 * seg + ii; const int tok = seqbase + (dir ? N - 1 - i : i); \
            lfN[ii] = LFg[(unsigned)tok * 2048u + (unsigned)ch]; qN[ii] = Qg[(unsigned)tok * 1024u + (unsigned)ch]; vN[ii] = Vg[(unsigned)tok * 1024u + (unsigned)ch]; } } while (0)
    SCAN_LOAD(0);
    for (int c = 0; c < nc; ++c) {
        float lf[16], qv[16]; unsigned short vv16[16];
#pragma unroll
        for (int ii = 0; ii < 16; ++ii) { lf[ii] = lfN[ii]; qv[ii] = bf2f(qN[ii]); vv16[ii] = vN[ii]; }
        { const int cn = c + 1 < nc ? c + 1 : c; SCAN_LOAD(cn); }
        float run = 0.f;
#pragma unroll
        for (int ii = 0; ii < 16; ++ii) run += lf[ii];
        TOT[seg * 128 + ch] = run;
        __syncthreads();
        const float t0 = TOT[ch], t1 = TOT[128 + ch], t2 = TOT[256 + ch], t3 = TOT[384 + ch];
        const float offs = seg == 0 ? 0.f : seg == 1 ? t0 : seg == 2 ? t0 + t1 : t0 + t1 + t2;
        const float ref = t0 + t1, blast = (t0 + t1) + (t2 + t3);
        if (seg == 0) DEC[ch] = __expf(blast);
        const float eref = __expf(ref), ebr = __expf(blast - ref);
        float brun = offs;
        unsigned kow[8], vtw[8];
#pragma unroll
        for (int ii = 0; ii < 16; ii += 2) {
            float ko2[2];
#pragma unroll
            for (int d = 0; d < 2; ++d) {
                const int i2 = ii + d, i = 16 * seg + i2; brun += lf[i2]; const float b = brun; const float kf = 1.0f - __expf(lf[i2]);
                const float e1 = __expf(b - ref), e2 = __builtin_amdgcn_rcpf(e1);
                const float qs = qv[i2] * e1, ks = kf * e2;
                QS[i * P128 + ch] = (bf16_t)pk2(qs, qs);
                KS[i * P128 + ch] = (bf16_t)pk2(ks, ks);
                QI[i * P128 + ch] = (bf16_t)pk2(qs * eref, qs * eref);
                ko2[d] = ks * ebr;
            }
            kow[ii >> 1] = pk2(ko2[0], ko2[1]); vtw[ii >> 1] = (unsigned)vv16[ii] | ((unsigned)vv16[ii + 1] << 16);
        }
        *(LAS u32x4*)(KO + ch * P64 + 16 * seg) = (u32x4){kow[0], kow[1], kow[2], kow[3]}; *(LAS u32x4*)(KO + ch * P64 + 16 * seg + 8) = (u32x4){kow[4], kow[5], kow[6], kow[7]};
        *(LAS u32x4*)(VT + ch * P64 + 16 * seg) = (u32x4){vtw[0], vtw[1], vtw[2], vtw[3]}; *(LAS u32x4*)(VT + ch * P64 + 16 * seg + 8) = (u32x4){vtw[4], vtw[5], vtw[6], vtw[7]};
        __syncthreads();
        {
            const int it = w >> 1;
#pragma unroll
            for (int jj = 0; jj < 2; ++jj) {
                const int jt = 2 * (w & 1) + jj;
                f32x4 d = (f32x4){0.f, 0.f, 0.f, 0.f};
                if (jt <= it) {
#pragma unroll
                    for (int ks = 0; ks < 4; ++ks) {
                        const bf16x8 af = *(const LAS bf16x8*)(KS + (16 * jt + fr) * P128 + 32 * ks + 8 * fq);
                        const bf16x8 bf = *(const LAS bf16x8*)(QS + (16 * it + fr) * P128 + 32 * ks + 8 * fq);
                        d = __builtin_amdgcn_mfma_f32_16x16x32_bf16(af, bf, d, 0, 0, 0);
                    }
                }
                const int i = 16 * it + fr, j0 = 16 * jt + 4 * fq;
#pragma unroll
                for (int e = 0; e < 4; ++e) if (j0 + e > i) d[e] = 0.f;
                u32x2 p; p.x = pk2(d[0], d[1]); p.y = pk2(d[2], d[3]);
                *(LAS u32x2*)(SCm + i * P64 + j0) = p;
            }
        }
        __syncthreads();
        f32x4 oacc[4];
#pragma unroll
        for (int it = 0; it < 4; ++it) oacc[it] = (f32x4){0.f, 0.f, 0.f, 0.f};
        {
            bf16x8 stf[4], vtf[2];
#pragma unroll
            for (int ks = 0; ks < 4; ++ks) stf[ks] = *(const LAS bf16x8*)(ST + (16 * w + fr) * P128 + 32 * ks + 8 * fq);
#pragma unroll
            for (int ks = 0; ks < 2; ++ks) vtf[ks] = *(const LAS bf16x8*)(VT + (16 * w + fr) * P64 + 32 * ks + 8 * fq);
#pragma unroll
            for (int it = 0; it < 4; ++it) {
#pragma unroll
                for (int ks = 0; ks < 4; ++ks) { const bf16x8 qf = *(const LAS bf16x8*)(QI + (16 * it + fr) * P128 + 32 * ks + 8 * fq); oacc[it] = __builtin_amdgcn_mfma_f32_16x16x32_bf16(stf[ks], qf, oacc[it], 0, 0, 0); }
#pragma unroll
                for (int ks = 0; ks < 2; ++ks) { const bf16x8 sf = *(const LAS bf16x8*)(SCm + (16 * it + fr) * P64 + 32 * ks + 8 * fq); oacc[it] = __builtin_amdgcn_mfma_f32_16x16x32_bf16(vtf[ks], sf, oacc[it], 0, 0, 0); }
            }
#pragma unroll
            for (int kt = 0; kt < 8; ++kt) {
                const f32x4 dc = *(const LAS f32x4*)(DEC + 16 * kt + 4 * fq);
                accS[kt] = accS[kt] * dc;
#pragma unroll
                for (int ks = 0; ks < 2; ++ks) { const bf16x8 kf = *(const LAS bf16x8*)(KO + (16 * kt + fr) * P64 + 32 * ks + 8 * fq); accS[kt] = __builtin_amdgcn_mfma_f32_16x16x32_bf16(kf, vtf[ks], accS[kt], 0, 0, 0); }
            }
        }
#pragma unroll
        for (int it = 0; it < 4; ++it) { const int i = 64 * c + 16 * it + fr; const int tok = seqbase + (dir ? N - 1 - i : i); *(f32x4*)(Og + (size_t)tok * 1024 + 16 * w + 4 * fq) = oacc[it]; }
#pragma unroll
        for (int kt = 0; kt < 8; ++kt) { u32x2 p; p.x = pk2(accS[kt][0], accS[kt][1]); p.y = pk2(accS[kt][2], accS[kt][3]); *(LAS u32x2*)(ST + (16 * w + fr) * P128 + 16 * kt + 4 * fq) = p; }
    }
    if (ctx) {
        float* so = a->out + (size_t)T * D + ((size_t)(b_out * 2 + dir) * 8 + h) * 16384;
#pragma unroll
        for (int kt = 0; kt < 8; ++kt)
#pragma unroll
            for (int e = 0; e < 4; ++e) so[(16 * kt + 4 * fq + e) * 128 + 16 * w + fr] = accS[kt][e];
    }
}

constexpr int MB_WS = 0, MB_BV = 128 * P128 * 2, MB_END = MB_BV + 256 * P128 * 2;
static_assert(MB_END <= LDS_BYTES, "mixer-B LDS");
__device__ __forceinline__ void mixb_item(KA a, LAS unsigned char* lds, int cbk, int g) {
    int tid = threadIdx.x; asm volatile("" : "+v"(tid));
    const int lane = tid & 63, w = __builtin_amdgcn_readfirstlane(tid >> 6), fr = lane & 15, fq = lane >> 4;
    unsigned char* ws = a->ws;
    LAS bf16_t* WSl = (LAS bf16_t*)(lds + MB_WS); LAS bf16_t* BV = (LAS bf16_t*)(lds + MB_BV);
    const bf16_t* VVg = (const bf16_t*)(ws + WS_VV) + (size_t)cbk * 128 * 1024 + g * 256;
    const bf16_t* Ug = (const bf16_t*)(ws + WS_U) + (size_t)cbk * 128 * 1024 + g * 256;
    bf16_t* CAT = (bf16_t*)(ws + WS_CAT) + (size_t)cbk * 128 * D + 1024 + g * 256;
    const float* wsg = a->in[12] + (size_t)g * 16384; const float* vn = a->in[11] + g * 256; const float* bsg = a->in[13] + g * 128;
    __syncthreads();
#pragma unroll
    for (int j = 0; j < 8; ++j) { const int idx = (tid + j * NT) * 4, p = idx >> 7, q = idx & 127; const f32x4 v = *(const f32x4*)(wsg + idx);
        u32x2 o; o.x = pk2(v[0], v[1]); o.y = pk2(v[2], v[3]); *(LAS u32x2*)(WSl + p * P128 + q) = o; }
    {
        const int q = tid >> 2, qt = tid & 3;
        u32x4 raw[8]; float ss = 0.f;
#pragma unroll
        for (int j = 0; j < 8; ++j) { raw[j] = *(const u32x4*)(VVg + (size_t)q * 1024 + qt * 64 + 8 * j);
#pragma unroll
            for (int e = 0; e < 4; ++e) { const float lo = bflo(raw[j][e]), hi = bfhi(raw[j][e]); ss += lo * lo + hi * hi; } }
        ss += __shfl_xor(ss, 1); ss += __shfl_xor(ss, 2);
        const float rstd = rsqrtf(ss * (1.0f / 256.0f) + 1e-6f);
#pragma unroll
        for (int j = 0; j < 8; ++j)
#pragma unroll
            for (int e = 0; e < 4; ++e) { const int c = qt * 64 + 8 * j + 2 * e;
                BV[c * P128 + q] = (bf16_t)f2bf(bflo(raw[j][e]) * rstd * vn[c]); BV[(c + 1) * P128 + q] = (bf16_t)f2bf(bfhi(raw[j][e]) * rstd * vn[c + 1]); }
    }
    __syncthreads();
    const int wr2 = w >> 2, wc2 = w & 3;
    f32x4 acc[4][4];
#pragma unroll
    for (int mt = 0; mt < 4; ++mt)
#pragma unroll
        for (int nt = 0; nt < 4; ++nt) acc[mt][nt] = (f32x4){0.f, 0.f, 0.f, 0.f};
#pragma unroll
    for (int ks = 0; ks < 4; ++ks) {
        bf16x8 wf[4], vf[4];
#pragma unroll
        for (int mt = 0; mt < 4; ++mt) wf[mt] = *(const LAS bf16x8*)(WSl + (64 * wr2 + 16 * mt + fr) * P128 + 32 * ks + 8 * fq);
#pragma unroll
        for (int nt = 0; nt < 4; ++nt) vf[nt] = *(const LAS bf16x8*)(BV + (64 * wc2 + 16 * nt + fr) * P128 + 32 * ks + 8 * fq);
#pragma unroll
        for (int mt = 0; mt < 4; ++mt)
#pragma unroll
            for (int nt = 0; nt < 4; ++nt) acc[mt][nt] = __builtin_amdgcn_mfma_f32_16x16x32_bf16(vf[nt], wf[mt], acc[mt][nt], 0, 0, 0);
    }
#pragma unroll
    for (int mt = 0; mt < 4; ++mt) {
        const int p = 64 * wr2 + 16 * mt + fr; const float bsv = bsg[p];
#pragma unroll
        for (int nt = 0; nt < 4; ++nt) { const int c = 64 * wc2 + 16 * nt + 4 * fq;
            const u32x2 uu = *(const u32x2*)(Ug + (size_t)p * 1024 + c);
            u32x2 o; o.x = pk2(bflo(uu.x) * (acc[mt][nt][0] + bsv), bfhi(uu.x) * (acc[mt][nt][1] + bsv)); o.y = pk2(bflo(uu.y) * (acc[mt][nt][2] + bsv), bfhi(uu.y) * (acc[mt][nt][3] + bsv));
            *(u32x2*)(CAT + (size_t)p * D + c) = o; }
    }
}
__device__ __forceinline__ void mixer_work(KA a, LAS unsigned char* lds, int it) {
    if (it < 128) { const int s = it >> 4, h = (it >> 1) & 7, dir = it & 1; scan_item(a, lds, TCTX + 1024 * s, 1024, s, h, dir, false, 0); }
    else if (it < 384) { const int j = it - 128, s = j >> 4, h = (j >> 1) & 7, dir = j & 1; scan_item(a, lds, 256 * s, 256, 0, h, dir, true, s); }
    else { const int j = it - 384; mixb_item(a, lds, j >> 2, j & 3); }
}
__device__ __forceinline__ void phase_mixers(KA a, LAS unsigned char* lds, int vcu, int G) {
    if (G == 256) {
        const int j = vcu - 128, n = vcu < 128 ? 1 : 5;
        for (int q = 0; q < n; ++q) { const int it = vcu < 128 ? vcu : (q < 2 ? 128 + 2 * j + q : 384 + 3 * j + (q - 2)); mixer_work(a, lds, it); }
    } else { for (int it = vcu; it < 768; it += G) mixer_work(a, lds, it); }
}
__device__ __forceinline__ void phase_finalize_a(KA a, int vcu, int G) {
    const int lane = threadIdx.x & 63, wave = __builtin_amdgcn_readfirstlane(threadIdx.x >> 6);
    const int gw = vcu * 8 + wave, NGW = G * 8;
    const int chunk = (T + NGW - 1) / NGW, r0 = gw * chunk, r1 = (r0 + chunk < T) ? r0 + chunk : T;
    if (r0 >= r1) return;
    unsigned char* ws = a->ws;
    const float* OF = (const float*)(ws + WS_OF); const float* OB = (const float*)(ws + WS_OB); const bf16_t* GA = (const bf16_t*)(ws + WS_GA); bf16_t* CAT = (bf16_t*)(ws + WS_CAT);
    const int col = (lane >> 3) * 128 + (lane & 7) * 16, vc = (lane & 7) * 16;
    f32x4 gn[4];
#pragma unroll
    for (int j = 0; j < 4; ++j) gn[j] = *(const f32x4*)(a->in[10] + vc + 4 * j);
    f32x4 fn[4], bn[4]; u32x4 g0n, g1n;
#define FIN_LOAD(r) do { const size_t o_ = (size_t)(r) * 1024 + col; _Pragma("unroll") for (int j = 0; j < 4; ++j) { fn[j] = *(const f32x4*)(OF + o_ + 4 * j); bn[j] = *(const f32x4*)(OB + o_ + 4 * j); } \
        g0n = *(const u32x4*)(GA + o_); g1n = *(const u32x4*)(GA + o_ + 8); } while (0)
    FIN_LOAD(r0);
    for (int row = r0; row < r1; ++row) {
        f32x4 v[4]; const u32x4 g0 = g0n, g1 = g1n; float ss = 0.f;
#pragma unroll
        for (int j = 0; j < 4; ++j) { v[j] = fn[j] + bn[j]; ss += (v[j][0] * v[j][0] + v[j][1] * v[j][1]) + (v[j][2] * v[j][2] + v[j][3] * v[j][3]); }
        FIN_LOAD(row + 1 < r1 ? row + 1 : row);
        ss += __shfl_xor(ss, 1); ss += __shfl_xor(ss, 2); ss += __shfl_xor(ss, 4);
        const float rstd = rsqrtf(ss * (1.0f / 128.0f) + 1e-6f);
        u32x4 o0, o1;
#pragma unroll
        for (int e = 0; e < 4; ++e) {
            const int j = e >> 1, k = (e & 1) * 2;
            o0[e] = pk2(v[j][k] * rstd * gn[j][k] * bflo(g0[e]), v[j][k + 1] * rstd * gn[j][k + 1] * bfhi(g0[e]));
            o1[e] = pk2(v[2 + j][k] * rstd * gn[2 + j][k] * bflo(g1[e]), v[2 + j][k + 1] * rstd * gn[2 + j][k + 1] * bfhi(g1[e]));
        }
        *(u32x4*)(CAT + (size_t)row * D + col) = o0; *(u32x4*)(CAT + (size_t)row * D + col + 8) = o1;
    }
#undef FIN_LOAD
}

#define XB_TMO      128
#define XB_XCNT(j)  (256  + 64 * (j))
#define XB_XSUB(j)  (1280 + 64 * (j))
#define XB_XGEN(j)  (2304 + 64 * (j))
#define XB_TOP      3328
#define XB_TOPGEN   3392
#define XCD_BAR_WORDS 3456
#define XB_SPIN_CAP (1u << 18)
__device__ __forceinline__ unsigned xb_ld(unsigned* p)              { return __hip_atomic_load(p, __ATOMIC_RELAXED, __HIP_MEMORY_SCOPE_AGENT); }
__device__ __forceinline__ unsigned xb_add(unsigned* p, unsigned v) { return __hip_atomic_fetch_add(p, v, __ATOMIC_RELAXED, __HIP_MEMORY_SCOPE_AGENT); }
__device__ __forceinline__ unsigned xb_xcc_id() { return (unsigned)__builtin_amdgcn_s_getreg((3 << 11) | 20) & 0xFu; }
#define XB_SPIN(cond, bar) do { unsigned _sp = 0; while (cond) { __builtin_amdgcn_s_sleep(1); \
    if ((++_sp & 255u) == 0u) { if (xb_ld(&(bar)[XB_TMO])) break; if (_sp > XB_SPIN_CAP) { atomicAdd(&(bar)[XB_TMO], 1u); break; } } } } while (0)
struct XcdBarrier { unsigned* bar; unsigned x; volatile LAS unsigned* st; };
__device__ __forceinline__ XcdBarrier xcd_barrier_post(unsigned* bar, volatile LAS unsigned* st) {
    XcdBarrier b; b.bar = bar; b.x = xb_xcc_id(); b.st = st;
    if (threadIdx.x == 0) (void)xb_add(&bar[XB_XCNT(b.x)], 1u);
    return b;
}
__device__ __forceinline__ void xcd_barrier_complete(unsigned* bar, unsigned x, unsigned& nloc, unsigned& nx) {
    const unsigned G = gridDim.x * gridDim.y * gridDim.z;
    unsigned sum, cnt, mine, sp = 0u;
    for (;;) {
        sum = 0u; cnt = 0u; mine = 0u;
#pragma unroll
        for (unsigned j = 0; j < 16; ++j) { const unsigned c = xb_ld(&bar[XB_XCNT(j)]); sum += c; cnt += (c > 0u) ? 1u : 0u; mine = (j == x) ? c : mine; }
        if (sum == G) break;
        __builtin_amdgcn_s_sleep(1);
        if ((++sp & 255u) == 0u) { if (xb_ld(&bar[XB_TMO])) break; if (sp > XB_SPIN_CAP) { atomicAdd(&bar[XB_TMO], 1u); break; } }
    }
    nloc = mine > 0u ? mine : 1u; nx = cnt > 0u ? cnt : 1u;
}
__device__ __forceinline__ void xcd_barrier(const XcdBarrier& b) {
    asm volatile("s_waitcnt vmcnt(0)" ::: "memory");
    __syncthreads();
    if (threadIdx.x == 0) {
        unsigned* bar = b.bar;
        __builtin_amdgcn_s_waitcnt(0);
        unsigned nloc = b.st[0], nx = b.st[1];
        if (nloc == 0u) { xcd_barrier_complete(bar, b.x, nloc, nx); b.st[0] = nloc; b.st[1] = nx; }
        const unsigned old = xb_add(&bar[XB_XSUB(b.x)], 1u);
        const unsigned gen = old / nloc;
        if (old + 1u == (gen + 1u) * nloc) {
            __builtin_amdgcn_fence(__ATOMIC_RELEASE, "agent");
            asm volatile("s_waitcnt vmcnt(0)" ::: "memory");
            const unsigned og = xb_add(&bar[XB_TOP], 1u);
            const unsigned tg = og / nx;
            if (og + 1u == (tg + 1u) * nx) xb_add(&bar[XB_TOPGEN], 1u);
            else XB_SPIN(xb_ld(&bar[XB_TOPGEN]) == tg, bar);
            __builtin_amdgcn_fence(__ATOMIC_ACQUIRE, "agent");
            xb_add(&bar[XB_XGEN(b.x)], 1u);
            asm volatile("s_waitcnt vmcnt(0)" ::: "memory");
        } else {
            XB_SPIN(xb_ld(&bar[XB_XGEN(b.x)]) == gen, bar);
            __builtin_amdgcn_fence(__ATOMIC_ACQUIRE, "agent");
            asm volatile("s_waitcnt vmcnt(0)" ::: "memory");
        }
    }
    __syncthreads();
}

#ifndef PG8_SP2
#ifndef PG8_SP2
#define PG8_SP2 true
#endif
#endif
__global__ void __launch_bounds__(NT, 2) mk_fwd(Args a_) {
    KA a = kargs();
    extern __shared__ __attribute__((aligned(16))) unsigned char lds_raw[];
    LAS unsigned char* lds = (LAS unsigned char*)lds_raw;
    cg::grid_group grid = cg::this_grid();
    const int G = gridDim.x, bx = blockIdx.x;
    const int vcu = (G % 8 == 0) ? (bx % 8) * (G / 8) + bx / 8 : bx;
#define ws (a->ws)
    const int lo = a->ph_lo, hi = a->ph_hi;
    if (threadIdx.x < 16) ((LAS unsigned*)(lds + LDS_MISC))[threadIdx.x] = 0u;
    __syncthreads();
    (void)xcd_barrier_post((unsigned*)(ws + WS_CTL), (volatile LAS unsigned*)(lds + LDS_MISC));
    if (lo == -12345) grid.sync();
#define X (a->out)
#define MOD0 ((const float*)(ws + WS_MOD))
#define MOD1 (MOD0 + 9 * 12288)
#define Hb ((bf16_t*)(ws + WS_H))
#define CAT ((bf16_t*)(ws + WS_CAT))
#define ACT ((bf16_t*)(ws + WS_ACT))
#define PQT ((bf16_t*)(ws + WS_PQT))
#ifndef PHMASK
#define PHMASK 0x1FFFF
#endif
#define IN(k) (((PHMASK >> (k)) & 1) && lo <= (k) && (k) < hi)
#ifndef REPMASK
#define REPMASK 0
#endif
#ifndef REPN
#define REPN 2
#endif
#define REPS(k) for (int rep_ = 0; rep_ < (((REPMASK >> (k)) & 1) ? REPN : 1); ++rep_)
#ifdef PROBE_T
#define PROBE_STAMP(i) do { if (blockIdx.x == 0 && threadIdx.x == 0) ((unsigned long long*)(ws + WS_CTL + 32768))[i] = __builtin_amdgcn_s_memrealtime(); } while (0)
#else
#define PROBE_STAMP(i) do {} while (0)
#endif
#define SEAM(k) do { if (IN(k) && IN((k) + 1)) { XcdBarrier b_; b_.bar = (unsigned*)(ws + WS_CTL); b_.x = xb_xcc_id(); b_.st = (volatile LAS unsigned*)(lds + LDS_MISC); xcd_barrier(b_); PROBE_STAMP((k) + 1); } a = kargs(); } while (0)

    PROBE_STAMP(0);
    if (IN(0)) REPS(0) phase_prologue(a, lds, vcu, G);
    SEAM(0);
    if (IN(1)) REPS(1) phase_norm_mod(a->in[0], a->in[1], a->in[7], MOD0, MOD0 + D, Hb, vcu, G);
    SEAM(1);
    if (IN(2)) {
        const int GG = G == 256 ? 224 : G;
        if (bx < GG) {
            SchedDense S{48, INW / 256, GG, bx, (const char*)Hb, (const char*)(ws + WS_WIN), (size_t)256 * D * 2, (size_t)256 * D * 2, ((REPMASK >> 2) & 1) ? REPN : 1, D / 64};
            EpiInProj E{(bf16_t*)(ws + WS_Q), (bf16_t*)(ws + WS_V), (bf16_t*)(ws + WS_GA), (bf16_t*)(ws + WS_U), (bf16_t*)(ws + WS_VV), (float*)(ws + WS_LF), a->in[9]};
            pg8::gemm_phase<EpiInProj, SchedDense, PG8_SP2, 0>(lds, D, D, (size_t)128 * D * 2, (size_t)128 * D * 2, S, E);
        } else {
            const int hw = (bx - GG) * 8 + __builtin_amdgcn_readfirstlane(threadIdx.x >> 6);
            convert_set(a, lds, 1, hw, (G - GG) * 8);
            convert_set(a, lds, 2, hw, (G - GG) * 8, 0, 4096);
            dft_tables(ws, (bx - GG) * NT + threadIdx.x, (G - GG) * NT);
        }
    }
    SEAM(2);
    if (IN(3)) REPS(3) phase_mixers(a, lds, vcu, G);
    SEAM(3);
    if (IN(4)) REPS(4) phase_finalize_a(a, vcu, G);
    SEAM(4);
    if (IN(5)) {
        SchedSplit2 S{G, bx, (const char*)CAT, (const char*)(ws + WS_WOUT0), (size_t)256 * D * 2, (size_t)256 * D * 2, D / 64};
        EpiResid E{a->in[0], a->in[1], X, MOD0 + 2 * D};
        pg8::gemm_phase<EpiResid, SchedSplit2, PG8_SP2, 0, true>(lds, D, D, (size_t)128 * D * 2, (size_t)128 * D * 2, S, E, (float*)(ws + WS_OF), (unsigned*)(ws + WS_CTL) + 4096 + 0 * 128);
    }
    SEAM(5);
    if (IN(6)) REPS(6) phase_norm_mod(X, X + (size_t)TCTX * D, a->in[15], MOD0 + 3 * D, MOD0 + 4 * D, Hb, vcu, G);
    SEAM(6);
    if (IN(7)) {
        const int GG = G == 256 ? 240 : G;
        if (bx < GG) {
            SchedDense S{48, DFF / 128, GG, bx, (const char*)Hb, (const char*)(ws + WS_WUP0), (size_t)256 * D * 2, (size_t)256 * D * 2, ((REPMASK >> 7) & 1) ? REPN : 1, D / 64};
            EpiConv E{ACT, a->in[17], a->in[18], (LAS float*)(lds + LDS_XCH)};
            pg8::gemm_phase<EpiConv, SchedDense, PG8_SP2, 1>(lds, D, D, (size_t)4 * D * 2, (size_t)128 * D * 2, S, E);
        } else convert_set(a, lds, 2, (bx - GG) * 8 + __builtin_amdgcn_readfirstlane(threadIdx.x >> 6), (G - GG) * 8, 4096);
    }
    SEAM(7);
    if (IN(8)) {
        SchedSplit2 S{G, bx, (const char*)ACT, (const char*)(ws + WS_WDN0), (size_t)256 * DFF * 2, (size_t)256 * DFF * 2, DFF / 64};
        EpiResid E{X, X + (size_t)TCTX * D, X, MOD0 + 5 * D};
        pg8::gemm_phase<EpiResid, SchedSplit2, PG8_SP2, 0, true>(lds, DFF, DFF, (size_t)128 * DFF * 2, (size_t)128 * DFF * 2, S, E, (float*)(ws + WS_OF), (unsigned*)(ws + WS_CTL) + 4096 + 1 * 128);
    }
    SEAM(8);
    if (IN(9)) REPS(9) phase_norm_mod(X, X + (size_t)TCTX * D, a->in[22], MOD1, MOD1 + D, Hb, vcu, G);
    SEAM(9);
    if (IN(10)) REPS(10) {
        SchedF1 S{G, bx, (const char*)(ws + WS_DFTC), (const char*)Hb, 8};
        EpiF1 E{PQT};
        pg8::gemm_phase<EpiF1, SchedF1, PG8_SP2, 0>(lds, 512, D, (size_t)128 * 512 * 2, (size_t)128 * D * 2, S, E);
    }
    SEAM(10);
    if (IN(11)) REPS(11) {
        { SchedF2 S{G, bx, 1, (const char*)(ws + WS_DFT1024), (const char*)PQT, 32}; EpiBf16 E{CAT, D};
          pg8::gemm_phase<EpiBf16, SchedF2, PG8_SP2, 0>(lds, 2048, 2 * T, (size_t)128 * 2048 * 2, (size_t)128 * 2 * T * 2, S, E); }
        { SchedF2 S{G, bx, 0, (const char*)(ws + WS_DFT256), (const char*)PQT, 8}; EpiBf16 E{CAT, D};
          pg8::gemm_phase<EpiBf16, SchedF2, PG8_SP2, 0>(lds, 512, 2 * T, (size_t)128 * 512 * 2, (size_t)128 * 2 * T * 2, S, E); }
    }
    SEAM(11);
    if (IN(12)) {
        SchedSplit2 S{G, bx, (const char*)CAT, (const char*)(ws + WS_WOUT1), (size_t)256 * D * 2, (size_t)256 * D * 2, D / 64};
        EpiResid E{X, X + (size_t)TCTX * D, X, MOD1 + 2 * D};
        pg8::gemm_phase<EpiResid, SchedSplit2, PG8_SP2, 0, true>(lds, D, D, (size_t)128 * D * 2, (size_t)128 * D * 2, S, E, (float*)(ws + WS_OF), (unsigned*)(ws + WS_CTL) + 4096 + 2 * 128);
    }
    SEAM(12);
    if (IN(13)) REPS(13) phase_norm_mod(X, X + (size_t)TCTX * D, a->in[24], MOD1 + 3 * D, MOD1 + 4 * D, Hb, vcu, G);
    SEAM(13);
    if (IN(14)) {
        SchedDense S{48, DFF / 128, G, bx, (const char*)Hb, (const char*)(ws + WS_WUP1), (size_t)256 * D * 2, (size_t)256 * D * 2, ((REPMASK >> 14) & 1) ? REPN : 1, D / 64};
        EpiConv E{ACT, a->in[26], a->in[27], (LAS float*)(lds + LDS_XCH)};
        pg8::gemm_phase<EpiConv, SchedDense, PG8_SP2, 1>(lds, D, D, (size_t)4 * D * 2, (size_t)128 * D * 2, S, E);
    }
    SEAM(14);
    if (IN(15)) {
        SchedSplit2 S{G, bx, (const char*)ACT, (const char*)(ws + WS_WDN1), (size_t)256 * DFF * 2, (size_t)256 * DFF * 2, DFF / 64};
        EpiResid E{X, X + (size_t)TCTX * D, X, MOD1 + 5 * D};
        pg8::gemm_phase<EpiResid, SchedSplit2, PG8_SP2, 0, true>(lds, DFF, DFF, (size_t)128 * DFF * 2, (size_t)128 * DFF * 2, S, E, (float*)(ws + WS_OF), (unsigned*)(ws + WS_CTL) + 4096 + 3 * 128);
    }
    SEAM(15);
    if (IN(16)) REPS(16) phase_final_norm(X, a->in[29], vcu, G);
#ifdef PROBE_T
    if (bx == 0 && threadIdx.x == 0) { PROBE_STAMP(18);
      const unsigned long long* tsb = (const unsigned long long*)(ws + WS_CTL + 32768);
      const unsigned long long dt = tsb[PROBE_B] - tsb[PROBE_A]; const unsigned long long t0 = __builtin_amdgcn_s_memrealtime();
      while (__builtin_amdgcn_s_memrealtime() - t0 < 8ull * dt) __builtin_amdgcn_s_sleep(32); }
#endif
#undef IN
#undef SEAM
#undef ws
#undef X
#undef MOD0
#undef MOD1
#undef Hb
#undef CAT
#undef ACT
#undef PQT
}

extern "C" void kernel_launch(void* const* d_in, const int* in_sizes, int n_in, void* d_out, int out_size, void* d_ws, size_t ws_size, hipStream_t stream) {
    static int grid = 0;
    if (grid == 0) {
        if (n_in != 30 || ws_size < WS_END) { fprintf(stderr, "kernel_launch: need 30 inputs and %zu bytes of workspace (got %d, %zu)\n", (size_t)WS_END, n_in, ws_size); grid = -1; return; }
        int dev = 0, cus = 0, per_cu = 0;
        if (hipGetDevice(&dev) != hipSuccess || hipDeviceGetAttribute(&cus, hipDeviceAttributeMultiprocessorCount, dev) != hipSuccess) { grid = -1; return; }
        if (hipFuncSetAttribute((const void*)mk_fwd, hipFuncAttributeMaxDynamicSharedMemorySize, LDS_BYTES) != hipSuccess) { fprintf(stderr, "kernel_launch: hipFuncSetAttribute failed\n"); grid = -1; return; }
        if (hipOccupancyMaxActiveBlocksPerMultiprocessor(&per_cu, (const void*)mk_fwd, NT, LDS_BYTES) != hipSuccess || per_cu < 1) { fprintf(stderr, "kernel_launch: occupancy query says %d blocks per CU\n", per_cu); grid = -1; return; }
        grid = cus;
    }
    if (grid < 0) return;
    if (hipMemsetAsync((char*)d_ws + WS_CTL, 0, 65536, stream) != hipSuccess) { fprintf(stderr, "kernel_launch: hipMemsetAsync failed\n"); return; }
    Args a{};
    for (int i = 0; i < 30; ++i) a.in[i] = (const float*)d_in[i];
    a.out = (float*)d_out; a.ws = (unsigned char*)d_ws;
#if MK_FUSED
    a.ph_lo = 0; a.ph_hi = NPH;
    void* args[] = {&a};
    hipError_t e = hipLaunchCooperativeKernel((const void*)mk_fwd, dim3(grid), dim3(NT), args, LDS_BYTES, stream);
    if (e != hipSuccess) fprintf(stderr, "cooperative launch failed: %s (grid %d)\n", hipGetErrorString(e), grid);
#else
    for (int p = 0; p < NPH; ++p) {
        a.ph_lo = p; a.ph_hi = p + 1;
        void* args[] = {&a};
        hipError_t e = hipLaunchCooperativeKernel((const void*)mk_fwd, dim3(grid), dim3(NT), args, LDS_BYTES, stream);
        if (e != hipSuccess) { fprintf(stderr, "launch %d failed: %s (grid %d)\n", p, hipGetErrorString(e), grid); break; }
    }
#endif
}
```

```cpp
#include <hip/hip_runtime.h>
#include <hip/hip_cooperative_groups.h>
#include <cstdio>
#include <cstdint>
namespace cg = cooperative_groups;

#ifndef MK_FUSED
#define MK_FUSED 1
#endif

#define LAS __attribute__((address_space(3)))
typedef unsigned short bf16_t;
typedef short bf16x8 __attribute__((ext_vector_type(8)));
typedef float f32x4 __attribute__((ext_vector_type(4)));
typedef float f32x2 __attribute__((ext_vector_type(2)));
typedef unsigned u32x4 __attribute__((ext_vector_type(4)));
typedef unsigned u32x2 __attribute__((ext_vector_type(2)));

constexpr int D = 2048, T = 12288, TCTX = 4096;
constexpr int DFF = 5632, DFF2 = 11264, INW = 7168, AW = 1024;
constexpr int NPH = 17;
constexpr int NT = 512;

constexpr size_t WS_CTL = 0;
constexpr size_t WS_MOD = 65536;
constexpr size_t WS_WIN = WS_MOD + (size_t)2 * 9 * 12288 * 4;
constexpr size_t WS_WOUT0 = WS_WIN + (size_t)INW * D * 2;
constexpr size_t WS_WUP0 = WS_WOUT0 + (size_t)D * D * 2;
constexpr size_t WS_WDN0 = WS_WUP0 + (size_t)DFF2 * D * 2;
constexpr size_t WS_WOUT1 = WS_WDN0 + (size_t)D * DFF * 2;
constexpr size_t WS_WUP1 = WS_WOUT1 + (size_t)D * D * 2;
constexpr size_t WS_WDN1 = WS_WUP1 + (size_t)DFF2 * D * 2;
constexpr size_t WS_DFTC = WS_WDN1 + (size_t)D * DFF * 2;
constexpr size_t WS_DFT256 = WS_DFTC + (size_t)1024 * 512 * 2;
constexpr size_t WS_DFT1024 = WS_DFT256 + (size_t)256 * 512 * 2;
constexpr size_t WS_H = WS_DFT1024 + (size_t)1024 * 2048 * 2;
constexpr size_t WS_CAT = WS_H + (size_t)T * D * 2;
constexpr size_t WS_R1 = WS_CAT + (size_t)T * D * 2;
constexpr size_t WS_Q = WS_R1;
constexpr size_t WS_V = WS_Q + (size_t)T * AW * 2;
constexpr size_t WS_GA = WS_V + (size_t)T * AW * 2;
constexpr size_t WS_U = WS_GA + (size_t)T * AW * 2;
constexpr size_t WS_VV = WS_U + (size_t)T * AW * 2;
constexpr size_t WS_LF = WS_VV + (size_t)T * AW * 2;
constexpr size_t WS_OF = WS_LF + (size_t)T * 2048 * 4;
constexpr size_t WS_OB = WS_OF + (size_t)T * AW * 4;
constexpr size_t WS_R1_END = WS_OB + (size_t)T * AW * 4;
constexpr size_t WS_ACT = WS_R1;
constexpr size_t WS_PQT = WS_R1;
constexpr size_t WS_END = WS_R1_END;
static_assert(WS_ACT + (size_t)T * DFF * 2 <= WS_R1_END && WS_PQT + (size_t)2048 * 2 * T * 2 <= WS_R1_END, "aliases fit");

constexpr int LDS_BYTES = 147456;
constexpr int LDS_XCH = 131072;
constexpr int LDS_MISC = 131072 + 8192;

__device__ __forceinline__ unsigned f2bf(float f) { unsigned u = __builtin_bit_cast(unsigned, f); return (u + 0x7fffu + ((u >> 16) & 1u)) >> 16; }
__device__ __forceinline__ unsigned pk2(float lo, float hi) { unsigned r; asm("v_cvt_pk_bf16_f32 %0, %1, %2" : "=v"(r) : "v"(lo), "v"(hi)); return r; }
__device__ __forceinline__ float bflo(unsigned w) { return __builtin_bit_cast(float, w << 16); }
__device__ __forceinline__ float bfhi(unsigned w) { return __builtin_bit_cast(float, w & 0xffff0000u); }
__device__ __forceinline__ float bf2f(bf16_t b) { return __builtin_bit_cast(float, (unsigned)b << 16); }
__device__ __forceinline__ float wave_sum(float v) {
#pragma unroll
    for (int o = 1; o < 64; o <<= 1) v += __shfl_xor(v, o);
    return v;
}
__device__ __forceinline__ float fast_sigmoid(float x) { return __builtin_amdgcn_rcpf(1.0f + __expf(-x)); }
__device__ __forceinline__ float silu_f(float x) { return x * fast_sigmoid(x); }
__device__ __forceinline__ float gelu_tanh_f(float x) { const float u = 1.5957691216057308f * (x + 0.044715f * x * x * x); return x * fast_sigmoid(u); }
__device__ __forceinline__ int row_bi(int pm) { return pm < 16 ? 0 : 1 + ((pm - 16) >> 2); }
#define LDS_WAIT() asm volatile("s_waitcnt lgkmcnt(0)" ::: "memory")

namespace pg8 {
constexpr int BM = 256, BK = 64, HALF = 128, HTB = HALF * BK * 2, NXCD = 8, WGM = 8;
__device__ __forceinline__ int lds_byte(int r, int c) { const int st = (r >> 4) * 2 + (c >> 5), rr = r & 15, cc = c & 31, ob = rr * 64 + cc * 2; return st * 1024 + (ob ^ (((ob >> 9) & 1) << 5)); }
__device__ __forceinline__ void stage_rc(int b, int& R, int& C) { const int st = b / 1024, sb = b % 1024, swz = sb ^ (((sb >> 9) & 1) << 5); R = (st >> 1) * 16 + swz / 64; C = (st & 1) * 32 + (swz % 64) / 2; }
__device__ __forceinline__ int perm32(int rho) { const int n = rho >> 4, i = rho & 15; return 8 * (i >> 2) + 4 * n + (i & 3); }
__device__ __forceinline__ int permA_conv(int R) { return 8 * (16 * (R >> 6) + (R & 15)) + ((R >> 4) & 3); }

struct Unit { const char* A; const char* B; int e0, e1, e2, nt, sp; };

__device__ __forceinline__ void tile_order(int L, int nM, int nN, int& pm, int& pn) {
    const int nwg = nM * nN; int wgid = L;
    { const int q = nwg / NXCD, r = nwg % NXCD, xcd = wgid % NXCD, off = wgid / NXCD; wgid = (xcd < r ? xcd * (q + 1) : r * (q + 1) + (xcd - r) * q) + off; }
    const int nig = WGM * nN, gid = wgid / nig, fm = gid * WGM, gsz = (nM - fm) < WGM ? (nM - fm) : WGM;
    pm = fm + ((wgid % nig) % gsz); pn = (wgid % nig) / gsz;
}

template <class Epi, class Sched, bool SP2, int PERMA, bool SPLIT = false>
__device__ __forceinline__ void gemm_phase(LAS unsigned char* lds, const int lda, const int ldb, const size_t hstepA, const size_t hstepB, const Sched& S, const Epi& E, float* slabs = nullptr, unsigned* scnt = nullptr) {
    const int tid = threadIdx.x, wid = __builtin_amdgcn_readfirstlane(tid >> 6), lane = tid & 63, wr = wid >> 2, wc = wid & 3, fr = lane & 15, fq = lane >> 4;
    unsigned voffA[2], voffB[2];
#pragma unroll
    for (int i = 0; i < 2; ++i) { int R, C; stage_rc(tid * 16 + i * 8192, R, C); const int Ra = PERMA ? permA_conv(R) : R; const int Rb = (R & ~31) + perm32(R & 31);
        voffA[i] = (unsigned)(Ra * lda + C) * 2u; voffB[i] = (unsigned)(Rb * ldb + C) * 2u; }
    const size_t kstep = (size_t)(BK * 2);
    const unsigned ldsw = (unsigned)wid * 1024u;
    const int aoff = lds_byte(wr * 64 + fr, fq * 8), boff = lds_byte(wc * 32 + fr, fq * 8);
#define PG8_SA(b, h) (((b) * 2 + (h)) * HTB)
#define PG8_SB(b, h) ((4 + (b) * 2 + (h)) * HTB)
#define PG8_STAGE(bufoff, gbase, voff) do { _Pragma("unroll") for (int _i = 0; _i < 2; ++_i) \
        __builtin_amdgcn_global_load_lds((const unsigned*)((const char*)(gbase) + (voff)[_i]), (LAS unsigned*)(lds + (bufoff) + ldsw + _i * 8192), 16, 0, 0); } while (0)
#define PG8_LDA(dst, b, h) do { _Pragma("unroll") for (int m = 0; m < 4; ++m) _Pragma("unroll") for (int k = 0; k < 2; ++k) dst[m][k] = *(const LAS bf16x8*)(lds + PG8_SA(b, h) + aoff + m * 2048 + k * 1024); } while (0)
#define PG8_LDB(dst, b, h) do { _Pragma("unroll") for (int n = 0; n < 2; ++n) _Pragma("unroll") for (int k = 0; k < 2; ++k) dst[n][k] = *(const LAS bf16x8*)(lds + PG8_SB(b, h) + boff + n * 2048 + k * 1024); } while (0)
#define PG8_MMA(ai, bj, At, Bt) do { __builtin_amdgcn_s_setprio(1); _Pragma("unroll") for (int m = 0; m < 4; ++m) _Pragma("unroll") for (int n = 0; n < 2; ++n) _Pragma("unroll") for (int k = 0; k < 2; ++k) \
        acc[ai][bj][m][n] = __builtin_amdgcn_mfma_f32_16x16x32_bf16(Bt[n][k], At[m][k], acc[ai][bj][m][n], 0, 0, 0); __builtin_amdgcn_s_setprio(0); } while (0)
#define PG8_WAIT_V(n) asm volatile("s_waitcnt vmcnt(" #n ")" ::: "memory")
#define PG8_WAIT_L(n) asm volatile("s_waitcnt lgkmcnt(" #n ")" ::: "memory")
#define PG8_BAR __builtin_amdgcn_s_barrier()
#define PG8_SCHED __builtin_amdgcn_sched_barrier(0)
    Unit cur, nxt; int ui = 0;
    if (!S.next(0, cur)) return;
    f32x4 acc[2][2][4][2];
#pragma unroll
    for (int a = 0; a < 2; ++a)
#pragma unroll
        for (int b = 0; b < 2; ++b)
#pragma unroll
            for (int m = 0; m < 4; ++m)
#pragma unroll
                for (int n = 0; n < 2; ++n) acc[a][b][m][n] = (f32x4){0.f, 0.f, 0.f, 0.f};
    bf16x8 At[4][2], B0[2][2], B1[2][2];
    const char* cA = cur.A; const char* cB = cur.B;
    if constexpr (SP2) {
        PG8_STAGE(PG8_SB(0, 0), cB, voffB); PG8_STAGE(PG8_SB(0, 1), cB + hstepB, voffB); PG8_STAGE(PG8_SA(0, 0), cA, voffA); PG8_STAGE(PG8_SA(0, 1), cA + hstepA, voffA);
        if (wr == 1) PG8_BAR;
        PG8_WAIT_V(2); PG8_BAR;
        PG8_STAGE(PG8_SB(1, 0), cB + kstep, voffB); PG8_STAGE(PG8_SA(1, 0), cA + kstep, voffA); PG8_STAGE(PG8_SB(1, 1), cB + hstepB + kstep, voffB);
        PG8_WAIT_V(6); PG8_BAR;
    } else {
        PG8_STAGE(PG8_SB(0, 0), cB, voffB); PG8_STAGE(PG8_SA(0, 0), cA, voffA); PG8_STAGE(PG8_SB(0, 1), cB + hstepB, voffB); PG8_STAGE(PG8_SA(0, 1), cA + hstepA, voffA);
        if (wr == 1) PG8_BAR;
        PG8_WAIT_V(4); PG8_BAR;
        PG8_STAGE(PG8_SB(1, 0), cB + kstep, voffB); PG8_STAGE(PG8_SA(1, 0), cA + kstep, voffA); PG8_STAGE(PG8_SB(1, 1), cB + hstepB + kstep, voffB);
        PG8_WAIT_V(6); PG8_BAR;
    }
    for (;;) {
        const bool has_next = S.next(ui + 1, nxt);
        const char* nA = has_next ? nxt.A : cA; const char* nB = has_next ? nxt.B : cB;
        const int nt = SPLIT ? cur.nt : S.nt;
        for (int t = 0; t < nt; t += 2) {
            const bool last = (t == nt - 2);
            const char* a1 = cA + (size_t)(t + 1) * kstep;
            const char* a2 = last ? nA : cA + (size_t)(t + 2) * kstep; const char* b2 = last ? nB : cB + (size_t)(t + 2) * kstep;
            const char* a3 = a2 + kstep; const char* b3 = b2 + kstep;
            if constexpr (SP2) {
            PG8_LDB(B0, 0, 0); PG8_LDB(B1, 0, 1); PG8_SCHED; PG8_LDA(At, 0, 0); PG8_STAGE(PG8_SA(1, 1), a1 + hstepA, voffA);
            PG8_WAIT_V(8); PG8_WAIT_L(0); PG8_BAR; PG8_MMA(0, 0, At, B0); PG8_MMA(0, 1, At, B1); PG8_BAR; PG8_SCHED;
            PG8_LDA(At, 0, 1); PG8_STAGE(PG8_SB(0, 0), b2, voffB); PG8_STAGE(PG8_SB(0, 1), b2 + hstepB, voffB); PG8_STAGE(PG8_SA(0, 0), a2, voffA);
            PG8_WAIT_V(8); PG8_WAIT_L(0); PG8_BAR; PG8_MMA(1, 0, At, B0); PG8_MMA(1, 1, At, B1); PG8_BAR; PG8_SCHED;
            PG8_LDB(B0, 1, 0); PG8_LDB(B1, 1, 1); PG8_SCHED; PG8_LDA(At, 1, 0); PG8_STAGE(PG8_SA(0, 1), a2 + hstepA, voffA);
            PG8_WAIT_V(8); PG8_WAIT_L(0); PG8_BAR; PG8_MMA(0, 0, At, B0); PG8_MMA(0, 1, At, B1); PG8_BAR; PG8_SCHED;
            PG8_LDA(At, 1, 1); PG8_STAGE(PG8_SB(1, 0), b3, voffB); PG8_STAGE(PG8_SB(1, 1), b3 + hstepB, voffB); PG8_STAGE(PG8_SA(1, 0), a3, voffA);
            PG8_WAIT_V(8); PG8_WAIT_L(0); PG8_BAR; PG8_MMA(1, 0, At, B0); PG8_MMA(1, 1, At, B1); PG8_BAR; PG8_SCHED;
            } else {
            PG8_LDB(B0, 0, 0); PG8_SCHED; PG8_LDA(At, 0, 0); PG8_STAGE(PG8_SA(1, 1), a1 + hstepA, voffA);
            PG8_WAIT_L(8); PG8_BAR; PG8_WAIT_L(0); PG8_MMA(0, 0, At, B0); PG8_BAR; PG8_SCHED;
            PG8_LDB(B1, 0, 1); PG8_STAGE(PG8_SB(0, 0), b2, voffB);
            PG8_BAR; PG8_WAIT_L(0); PG8_MMA(0, 1, At, B1); PG8_BAR;
            PG8_LDA(At, 0, 1); PG8_STAGE(PG8_SA(0, 0), a2, voffA);
            PG8_BAR; PG8_WAIT_L(0); PG8_MMA(1, 0, At, B0); PG8_BAR; PG8_SCHED;
            PG8_STAGE(PG8_SB(0, 1), b2 + hstepB, voffB);
            PG8_WAIT_V(6); PG8_BAR; PG8_MMA(1, 1, At, B1); PG8_BAR;
            PG8_LDB(B0, 1, 0); PG8_SCHED; PG8_LDA(At, 1, 0); PG8_STAGE(PG8_SA(0, 1), a2 + hstepA, voffA);
            PG8_WAIT_L(8); PG8_BAR; PG8_WAIT_L(0); PG8_MMA(0, 0, At, B0); PG8_BAR; PG8_SCHED;
            PG8_LDB(B1, 1, 1); PG8_STAGE(PG8_SB(1, 0), b3, voffB);
            PG8_BAR; PG8_WAIT_L(0); PG8_MMA(0, 1, At, B1); PG8_BAR;
            PG8_LDA(At, 1, 1); PG8_STAGE(PG8_SA(1, 0), a3, voffA);
            PG8_BAR; PG8_WAIT_L(0); PG8_MMA(1, 0, At, B0); PG8_BAR; PG8_SCHED;
            PG8_STAGE(PG8_SB(1, 1), b3 + hstepB, voffB);
            PG8_WAIT_V(6); PG8_BAR; PG8_MMA(1, 1, At, B1); PG8_BAR;
            }
        }
        if (wr == 0) PG8_BAR;
        bool do_epi = true;
        if constexpr (SPLIT) if (cur.sp) {
            const int pair = (cur.sp - 1) >> 1, kpart = (cur.sp - 1) & 1;
            {
                const __amdgpu_buffer_rsrc_t rs = __builtin_amdgcn_make_buffer_rsrc((void*)slabs, (short)0, 256 * 32 * 512 * 16, 0x00020000);
                const unsigned v0 = (unsigned)(((pair * 2 + kpart) * 32 * 512 + tid) * 16);
#pragma unroll
                for (int r = 0; r < 32; ++r) __builtin_amdgcn_raw_buffer_store_b128(__builtin_bit_cast(u32x4, acc[r >> 4][(r >> 3) & 1][(r >> 1) & 3][r & 1]), rs, v0 + (unsigned)r * 8192u, 0, 16);
            }
            asm volatile("s_waitcnt vmcnt(0)" ::: "memory");
            PG8_BAR;
            LAS unsigned* flag = (LAS unsigned*)(lds + 131072 + 8192 + 64);
            if (tid == 0) {
                const unsigned old = __hip_atomic_fetch_add(scnt + pair, 1u, __ATOMIC_RELAXED, __HIP_MEMORY_SCOPE_AGENT);
                if (old == 1u) { __builtin_amdgcn_fence(__ATOMIC_ACQUIRE, "agent"); asm volatile("s_waitcnt vmcnt(0)" ::: "memory"); }
                *flag = old;
            }
            asm volatile("s_waitcnt lgkmcnt(0)" ::: "memory");
            PG8_BAR;
            asm volatile("" ::: "memory");
            do_epi = (*(volatile LAS unsigned*)flag == 1u);
            if (do_epi) {
                const float* s0 = slabs + ((size_t)(pair * 2) * 32 * 512 + tid) * 4; const float* s1 = s0 + (size_t)32 * 512 * 4;
#pragma unroll
                for (int r = 0; r < 32; ++r) acc[r >> 4][(r >> 3) & 1][(r >> 1) & 3][r & 1] = *(const f32x4*)(s0 + (size_t)r * 2048);
#pragma unroll
                for (int rb = 0; rb < 32; rb += 16) {
                    f32x4 t[16];
#pragma unroll
                    for (int r = 0; r < 16; ++r) t[r] = *(const f32x4*)(s1 + (size_t)(rb + r) * 2048);
                    asm volatile("" ::: "memory");
#pragma unroll
                    for (int r = 0; r < 16; ++r) acc[(rb + r) >> 4][((rb + r) >> 3) & 1][((rb + r) >> 1) & 3][(rb + r) & 1] += t[r];
                }
            }
        }
        if (do_epi) E(acc, cur, wr, wc, fr, fq);
        if (!has_next) break;
#pragma unroll
        for (int a = 0; a < 2; ++a)
#pragma unroll
            for (int b = 0; b < 2; ++b)
#pragma unroll
                for (int m = 0; m < 4; ++m)
#pragma unroll
                    for (int n = 0; n < 2; ++n) acc[a][b][m][n] = (f32x4){0.f, 0.f, 0.f, 0.f};
        cur = nxt; cA = nA; cB = nB; ++ui;
        if (wr == 1) PG8_BAR;
    }
    PG8_WAIT_V(0);
    PG8_BAR;
#undef PG8_SA
#undef PG8_SB
#undef PG8_STAGE
#undef PG8_LDA
#undef PG8_LDB
#undef PG8_MMA
#undef PG8_WAIT_V
#undef PG8_WAIT_L
#undef PG8_BAR
#undef PG8_SCHED
}
}
using pg8::Unit;
typedef f32x4 Acc[2][2][4][2];

struct SchedDense {
    int nM, nN, G, c; const char* A; const char* B; size_t astep, bstep; int reps, nt;
    __device__ __forceinline__ bool next(int i, Unit& u) const {
        long L = (long)i * G + c; if (L >= (long)reps * nM * nN) return false; L %= (long)nM * nN;
        int pm, pn; pg8::tile_order((int)L, nM, nN, pm, pn);
        u.A = A + (size_t)pm * astep; u.B = B + (size_t)pn * bstep; u.e0 = pm; u.e1 = pn; u.e2 = 0; u.nt = nt; u.sp = 0; return true;
    }
};
struct SchedSplit2 {
    int G, c; const char* A; const char* B; size_t astep, bstep; int nt, dense;
    __device__ __forceinline__ bool next(int i, Unit& u) const {
        int L = c, kpart = 0, sp = 0, n = nt; size_t koff = 0;
        if (G != 256 || dense) { L = i * G + c; if (L >= 384) return false; }
        else if (i > 1) return false;
        else if (i == 1) { const int x = c & 7, t = c >> 3, j = t >> 1; kpart = t & 1; L = 256 + 8 * j + x; sp = 1 + 2 * (8 * j + x) + kpart; n = nt / 2; koff = (size_t)kpart * n * 128; }
        int pm, pn; pg8::tile_order(L, 48, 8, pm, pn);
        u.A = A + (size_t)pm * astep + koff; u.B = B + (size_t)pn * bstep + koff; u.e0 = pm; u.e1 = pn; u.e2 = 0; u.nt = n; u.sp = sp; return true;
    }
};
struct SchedF1 {
    int G, c; const char* A; const char* B; int nt;
    __device__ __forceinline__ bool next(int i, Unit& u) const {
        const long L = (long)i * G + c; if (L >= 16 * 48) return false;
        int pmm, pn; pg8::tile_order((int)L, 16, 48, pmm, pn);
        const int g = pmm >> 2, pmd = pmm & 3;
        u.A = A + (size_t)pmd * 256 * 512 * 2; u.B = B + ((size_t)pn * 256 * D + (size_t)g * 512) * 2; u.e0 = pmd; u.e1 = pn; u.e2 = g; u.nt = 8; u.sp = 0; return true;
    }
};
struct SchedF2 {
    int G, c, smp; const char* A; const char* B; int nt;
    __device__ __forceinline__ bool next(int i, Unit& u) const {
        const long L = (long)i * G + c;
        if (smp) { if (L >= 256) return false; const int l = (int)L, pn2 = l & 1, pm = (l >> 1) & 3, g = (l >> 3) & 3, s = l >> 5;
            u.A = A + (size_t)pm * 256 * 2048 * 2; u.B = B + (((size_t)(g * 512 + pn2 * 256)) * (2 * T) + 2 * (size_t)(TCTX + 1024 * s)) * 2;
            u.e0 = (TCTX + 1024 * s + 256 * pm) >> 8; u.e1 = g * 2 + pn2; u.e2 = 0; u.nt = 32; u.sp = 0; return true; }
        if (L >= 128) return false; const int l = (int)L, pn2 = l & 1, g = (l >> 1) & 3, s = l >> 3;
        u.A = A; u.B = B + (((size_t)(g * 512 + pn2 * 256)) * (2 * T) + 2 * (size_t)(256 * s)) * 2;
        u.e0 = s; u.e1 = g * 2 + pn2; u.e2 = 0; u.nt = 8; u.sp = 0; return true;
    }
};

struct EpiInProj {
    bf16_t *Q, *V, *GA, *U, *VV; float* LF; const float* lbraw;
    __device__ __forceinline__ void operator()(Acc& acc, const Unit& u, int wr, int wc, int fr, int fq) const {
        const int pm = u.e0, pn = u.e1, seg = pn >> 2;
        const int row0 = pm * 256 + wr * 64 + fr, cs0 = (pn & 3) * 256 + wc * 32 + 8 * fq;
#pragma unroll
        for (int bj = 0; bj < 2; ++bj) {
            const int col = cs0 + bj * 128;
            if (seg == 1 || seg == 2) {
                const float* l0 = lbraw + (seg - 1) * 2048 + col;
                float lb[8];
#pragma unroll
                for (int j = 0; j < 8; ++j) lb[j] = fast_sigmoid(l0[j] - l0[1024 + j]);
#pragma unroll
                for (int ai = 0; ai < 2; ++ai)
#pragma unroll
                    for (int m = 0; m < 4; ++m) {
                        const int row = row0 + ai * 128 + m * 16;
                        f32x4 o0, o1;
#pragma unroll
                        for (int e = 0; e < 4; ++e) { o0[e] = __logf(lb[e] + (1.f - lb[e]) * fast_sigmoid(acc[ai][bj][m][0][e])); o1[e] = __logf(lb[4 + e] + (1.f - lb[4 + e]) * fast_sigmoid(acc[ai][bj][m][1][e])); }
                        float* p = LF + (size_t)row * 2048 + (seg - 1) * 1024 + col;
                        *(f32x4*)p = o0; *(f32x4*)(p + 4) = o1;
                    }
            } else {
                bf16_t* base = seg == 0 ? Q : seg == 3 ? V : seg == 4 ? GA : seg == 5 ? U : VV;
#pragma unroll
                for (int ai = 0; ai < 2; ++ai)
#pragma unroll
                    for (int m = 0; m < 4; ++m) {
                        const int row = row0 + ai * 128 + m * 16;
                        f32x4 v0 = acc[ai][bj][m][0], v1 = acc[ai][bj][m][1];
                        if (seg == 0) {
#pragma unroll
                            for (int e = 0; e < 4; ++e) { v0[e] = silu_f(v0[e]) * 0.08838834764831845f; v1[e] = silu_f(v1[e]) * 0.08838834764831845f; }
                        } else if (seg == 4) {
#pragma unroll
                            for (int e = 0; e < 4; ++e) { v0[e] = silu_f(v0[e]); v1[e] = silu_f(v1[e]); }
                        } else if (seg >= 5) {
#pragma unroll
                            for (int e = 0; e < 4; ++e) { v0[e] = gelu_tanh_f(v0[e]); v1[e] = gelu_tanh_f(v1[e]); }
                        }
                        u32x4 w; w.x = pk2(v0[0], v0[1]); w.y = pk2(v0[2], v0[3]); w.z = pk2(v1[0], v1[1]); w.w = pk2(v1[2], v1[3]);
                        *(u32x4*)(base + (size_t)row * 1024 + col) = w;
                    }
            }
        }
    }
};
struct EpiResid {
    const float* xin0; const float* xin1; float* xout; const float* gate;
    __device__ __forceinline__ void operator()(Acc& acc, const Unit& u, int wr, int wc, int fr, int fq) const {
        const int pm = u.e0, pn = u.e1;
        const int row0 = pm * 256 + wr * 64 + fr, col0 = pn * 256 + wc * 32 + 8 * fq;
        const float* g = gate + (size_t)row_bi(pm) * 12288 + col0;
        const float* xin = pm < 16 ? xin0 : xin1 - (size_t)TCTX * D;
        f32x4 gv[2][2];
#pragma unroll
        for (int bj = 0; bj < 2; ++bj) { gv[bj][0] = *(const f32x4*)(g + bj * 128); gv[bj][1] = *(const f32x4*)(g + bj * 128 + 4); }
#pragma unroll
        for (int ai = 0; ai < 2; ++ai) {
            f32x4 xv[4][2][2];
#pragma unroll
            for (int m = 0; m < 4; ++m)
#pragma unroll
                for (int bj = 0; bj < 2; ++bj) { const float* p = xin + (size_t)(row0 + ai * 128 + m * 16) * D + col0 + bj * 128; xv[m][bj][0] = *(const f32x4*)p; xv[m][bj][1] = *(const f32x4*)(p + 4); }
            asm volatile("" ::: "memory");
#pragma unroll
            for (int m = 0; m < 4; ++m)
#pragma unroll
                for (int bj = 0; bj < 2; ++bj) { float* p = xout + (size_t)(row0 + ai * 128 + m * 16) * D + col0 + bj * 128;
                    *(f32x4*)p = xv[m][bj][0] + gv[bj][0] * acc[ai][bj][m][0]; *(f32x4*)(p + 4) = xv[m][bj][1] + gv[bj][1] * acc[ai][bj][m][1]; }
            asm volatile("" ::: "memory");
        }
    }
};
__device__ __forceinline__ float dpp_shr1(float src, float old) { return __builtin_bit_cast(float, __builtin_amdgcn_update_dpp(__builtin_bit_cast(int, old), __builtin_bit_cast(int, src), 0x111, 0xf, 0xf, false)); }
__device__ __forceinline__ float dpp_shl1(float src, float old) { return __builtin_bit_cast(float, __builtin_amdgcn_update_dpp(__builtin_bit_cast(int, old), __builtin_bit_cast(int, src), 0x101, 0xf, 0xf, false)); }
struct EpiConv {
    bf16_t* ACT; const float* cw; const float* cb; LAS float* xch;
    __device__ __forceinline__ void operator()(Acc& acc, const Unit& u, int wr, int wc, int fr, int fq) const {
        const int pm = u.e0, pn = u.e1; const bool ctx = pm < 16;
        LAS float* mine = xch + (wr * 4 + wc) * 64; const LAS float* other = xch + ((wr ^ 1) * 4 + wc) * 64;
        if (wr == 0) { if (fr == 15) {
#pragma unroll
            for (int bj = 0; bj < 2; ++bj)
#pragma unroll
                for (int n = 0; n < 2; ++n) *(LAS f32x4*)(mine + ((bj * 2 + n) * 4 + fq) * 4) = acc[1][bj][3][n]; } }
        else { if (fr == 0) {
#pragma unroll
            for (int bj = 0; bj < 2; ++bj)
#pragma unroll
                for (int n = 0; n < 2; ++n) *(LAS f32x4*)(mine + ((bj * 2 + n) * 4 + fq) * 4) = acc[0][bj][0][n]; } }
        LDS_WAIT(); __builtin_amdgcn_s_barrier(); asm volatile("" ::: "memory");
        const bool zl = !ctx && fr == 8, zr = !ctx && fr == 7;
        const int wcol0 = 128 * pn + 32 * wc + 8 * fq;
#pragma unroll
        for (int bj = 0; bj < 2; ++bj)
#pragma unroll
            for (int n = 0; n < 2; ++n) {
                const float* wp = cw + bj * DFF + wcol0 + 4 * n; const float* bp = cb + bj * DFF + wcol0 + 4 * n;
                f32x4 hv = *(const LAS f32x4*)(other + ((bj * 2 + n) * 4 + fq) * 4); if (!ctx) hv = (f32x4){0.f, 0.f, 0.f, 0.f};
#pragma unroll
                for (int e = 0; e < 4; ++e) {
                    const float w0 = wp[e], w1 = wp[DFF2 + e], w2 = wp[2 * DFF2 + e], bb = bp[e];
                    float x[8];
#pragma unroll
                    for (int j = 0; j < 8; ++j) x[j] = acc[j >> 2][bj][j & 3][n][e];
                    float left = dpp_shr1(x[7], wr == 1 ? hv[e] : 0.f);
                    float right = dpp_shl1(x[0], wr == 0 ? hv[e] : 0.f);
                    if (zl) left = 0.f; if (zr) right = 0.f;
#pragma unroll
                    for (int j = 0; j < 8; ++j) {
                        const float xm = j == 0 ? left : x[j - 1], xp = j == 7 ? right : x[j + 1];
                        acc[j >> 2][bj][j & 3][n][e] = w0 * xm + w1 * x[j] + w2 * xp + bb;
                    }
                }
                asm volatile("" ::: "memory");
            }
#pragma unroll
        for (int ai = 0; ai < 2; ++ai)
#pragma unroll
            for (int m = 0; m < 4; ++m) {
                const int tok = pm * 256 + 8 * (16 * wr + fr) + 4 * ai + m;
                f32x4 o0, o1;
#pragma unroll
                for (int e = 0; e < 4; ++e) { o0[e] = silu_f(acc[ai][0][m][0][e]) * acc[ai][1][m][0][e]; o1[e] = silu_f(acc[ai][0][m][1][e]) * acc[ai][1][m][1][e]; }
                u32x4 w; w.x = pk2(o0[0], o0[1]); w.y = pk2(o0[2], o0[3]); w.z = pk2(o1[0], o1[1]); w.w = pk2(o1[2], o1[3]);
                *(u32x4*)(ACT + (size_t)tok * DFF + wcol0) = w;
                asm volatile("" ::: "memory");
            }
    }
};
struct EpiF1 {
    bf16_t* PQT;
    __device__ __forceinline__ void operator()(Acc& acc, const Unit& u, int wr, int wc, int fr, int fq) const {
        const int pmd = u.e0, pn = u.e1, g = u.e2, which = pmd >> 1;
        int sb2, N, n0;
        if (pn < 16) { sb2 = 2 * 256 * pn; N = 256; n0 = 0; } else { const int s = (pn - 16) >> 2; sb2 = 2 * (TCTX + 1024 * s); N = 1024; n0 = ((pn - 16) & 3) * 256; }
        const int c0 = g * 512 + (pmd & 1) * 256 + wr * 64 + fr;
        bf16_t* base = PQT + (size_t)sb2 + which * N + n0 + wc * 32 + 8 * fq;
#pragma unroll
        for (int ai = 0; ai < 2; ++ai)
#pragma unroll
            for (int m = 0; m < 4; ++m) {
                bf16_t* rowp = base + (size_t)(c0 + ai * 128 + m * 16) * (2 * T);
#pragma unroll
                for (int bj = 0; bj < 2; ++bj) { const f32x4 v0 = acc[ai][bj][m][0], v1 = acc[ai][bj][m][1];
                    u32x4 w; w.x = pk2(v0[0], v0[1]); w.y = pk2(v0[2], v0[3]); w.z = pk2(v1[0], v1[1]); w.w = pk2(v1[2], v1[3]);
                    *(u32x4*)(rowp + bj * 128) = w; }
            }
    }
};
struct EpiBf16 {
    bf16_t* O; int ldo;
    __device__ __forceinline__ void operator()(Acc& acc, const Unit& u, int wr, int wc, int fr, int fq) const {
        const int row0 = u.e0 * 256 + wr * 64 + fr, col0 = u.e1 * 256 + wc * 32 + 8 * fq;
#pragma unroll
        for (int ai = 0; ai < 2; ++ai)
#pragma unroll
            for (int m = 0; m < 4; ++m) {
                bf16_t* rowp = O + (size_t)(row0 + ai * 128 + m * 16) * ldo + col0;
#pragma unroll
                for (int bj = 0; bj < 2; ++bj) { const f32x4 v0 = acc[ai][bj][m][0], v1 = acc[ai][bj][m][1];
                    u32x4 w; w.x = pk2(v0[0], v0[1]); w.y = pk2(v0[2], v0[3]); w.z = pk2(v1[0], v1[1]); w.w = pk2(v1[2], v1[3]);
                    *(u32x4*)(rowp + bj * 128) = w; }
            }
    }
};

struct Args { const float* in[30]; float* out; unsigned char* ws; int ph_lo, ph_hi; };
typedef const __attribute__((address_space(4))) Args* KA;
__device__ __forceinline__ KA kargs() { auto kp = __builtin_amdgcn_kernarg_segment_ptr(); asm volatile("" : "+s"(kp)); return (KA)kp; }

#ifdef PROBE_T
#define PSTAMPB(a, i, blk) do { if (blockIdx.x == (blk) && threadIdx.x == 0) ((unsigned long long*)((a)->ws + WS_CTL + 32768))[i] = __builtin_amdgcn_s_memrealtime(); } while (0)
#else
#define PSTAMPB(a, i, blk) do {} while (0)
#endif
struct CvtSrc { const float* W; bf16_t* WT; int K, N, up, item; };
__device__ __forceinline__ void cvt_load(const CvtSrc& c, int lane, f32x4 (&r)[16]) {
    const int nblk = c.N / 64, kb = c.item / nblk, nb = c.item % nblk, k0 = 64 * kb, n0 = 64 * nb;
    const int cc = lane & 15, q = lane >> 4;
#pragma unroll
    for (int i = 0; i < 16; ++i) { const int kk = 8 * (i >> 1) + 2 * q + (i & 1); r[i] = *(const f32x4*)(c.W + (size_t)(k0 + kk) * c.N + n0 + 4 * cc); }
}
__device__ __forceinline__ void cvt_store(const CvtSrc& c, int lane, const f32x4 (&r)[16], LAS unsigned* scr) {
    const int nblk = c.N / 64, kb = c.item / nblk, nb = c.item % nblk, k0 = 64 * kb, n0 = 64 * nb;
    const int cc = lane & 15, q = lane >> 4;
#pragma unroll
    for (int ip = 0; ip < 8; ++ip)
#pragma unroll
        for (int e = 0; e < 4; ++e) scr[(4 * cc + e) * 33 + 4 * ip + q] = pk2(r[2 * ip][e], r[2 * ip + 1][e]);
    LDS_WAIT(); asm volatile("" ::: "memory");
    const int c8 = lane & 7;
#pragma unroll
    for (int j = 0; j < 8; ++j) { const int n = (lane >> 3) + 8 * j; const LAS unsigned* sp = scr + n * 33 + 4 * c8;
        u32x4 o; o.x = sp[0]; o.y = sp[1]; o.z = sp[2]; o.w = sp[3];
        int nn = n0 + n;
        if (c.up) { const int bjj = nn >= DFF ? 1 : 0, cgc = nn - bjj * DFF; nn = (cgc >> 7) * 256 + bjj * 128 + (cgc & 127); }
        *(u32x4*)(c.WT + (size_t)nn * c.K + k0 + 8 * c8) = o; }
    LDS_WAIT(); asm volatile("" ::: "memory");
}
__device__ __forceinline__ bool cvt_pick(KA a, int set, int it, CvtSrc& c) {
    unsigned char* ws = a->ws;
    constexpr int I_IN = 32 * (INW / 64), I_O = 32 * (D / 64), I_UP = 32 * (DFF2 / 64), I_DN = (DFF / 64) * (D / 64);
    if (set == 0) { if (it >= I_IN) return false; c.W = a->in[8]; c.WT = (bf16_t*)(ws + WS_WIN); c.K = D; c.N = INW; c.up = 0; c.item = it; return true; }
    if (it >= I_O + I_UP + I_DN) return false;
    int r = it;
    if (r < I_O) { c.W = a->in[set == 1 ? 14 : 23]; c.WT = (bf16_t*)(ws + (set == 1 ? WS_WOUT0 : WS_WOUT1)); c.K = D; c.N = D; c.up = 0; c.item = r; return true; } r -= I_O;
    if (r < I_UP) { c.W = a->in[set == 1 ? 16 : 25]; c.WT = (bf16_t*)(ws + (set == 1 ? WS_WUP0 : WS_WUP1)); c.K = D; c.N = DFF2; c.up = 1; c.item = r; return true; } r -= I_UP;
    c.W = a->in[set == 1 ? 19 : 28]; c.WT = (bf16_t*)(ws + (set == 1 ? WS_WDN0 : WS_WDN1)); c.K = DFF; c.N = D; c.up = 0; c.item = r; return true;
}
__device__ __forceinline__ void convert_set(KA a, LAS unsigned char* lds, int set, int gw, int NGW, int i0 = 0, int i1 = 1 << 30) {
    const int lane = threadIdx.x & 63, wave = __builtin_amdgcn_readfirstlane(threadIdx.x >> 6);
    LAS unsigned* scr = (LAS unsigned*)(lds + wave * 8448);
    CvtSrc cur, nxt; f32x4 r0[16], r1[16];
    int it = i0 + gw;
    if (it >= i1 || !cvt_pick(a, set, it, cur)) return;
    cvt_load(cur, lane, r0);
    for (;;) {
        it += NGW; const bool h1 = it < i1 && cvt_pick(a, set, it, nxt);
        if (h1) cvt_load(nxt, lane, r1);
        cvt_store(cur, lane, r0, scr);
        if (!h1) break;
        it += NGW; const bool h2 = it < i1 && cvt_pick(a, set, it, cur);
        if (h2) cvt_load(cur, lane, r0);
        cvt_store(nxt, lane, r1, scr);
        if (!h2) break;
    }
}
__device__ __forceinline__ void dft_tables(unsigned char* ws, int gt, int GT) {
    bf16_t* DC = (bf16_t*)(ws + WS_DFTC); bf16_t* D256 = (bf16_t*)(ws + WS_DFT256); bf16_t* D1024 = (bf16_t*)(ws + WS_DFT1024);
    for (int i = gt; i < 1024 * 512; i += GT) { const int r = i >> 9, k = i & 511, c = r & 511; const float ang = 2.0f * (float)((c * k) & 511) * (1.0f / 512.0f);
        const float v = (r < 512 ? cospif(ang) : sinpif(ang)) * 0.04419417382415922f; DC[i] = (bf16_t)f2bf(v); }
    for (int i = gt; i < 256 * 512; i += GT) { const int p = i >> 9, k = i & 511, n = k & 255; const float ang = 2.0f * (float)((p * n) & 255) * (1.0f / 256.0f);
        const float v = (k < 256 ? cospif(ang) : -sinpif(ang)) * 0.0625f; D256[i] = (bf16_t)f2bf(v); }
    for (int i = gt; i < 1024 * 2048; i += GT) { const int p = i >> 11, k = i & 2047, n = k & 1023; const float ang = 2.0f * (float)((p * n) & 1023) * (1.0f / 1024.0f);
        const float v = (k < 1024 ? cospif(ang) : -sinpif(ang)) * 0.03125f; D1024[i] = (bf16_t)f2bf(v); }
}
__device__ __forceinline__ void phase_prologue(KA a, LAS unsigned char* lds, int vcu, int G) {
    const int tid = threadIdx.x, lane = tid & 63, wave = __builtin_amdgcn_readfirstlane(tid >> 6);
    unsigned char* ws = a->ws;
    __syncthreads();
    if (vcu < 192) {
        const int l = vcu / 96, n0 = (vcu % 96) * 128;
        const float* Wm = a->in[l ? 20 : 5]; const float* bm = a->in[l ? 21 : 6];
        LAS float* S = (LAS float*)lds;
        {
            const float* cc = a->in[4]; const float* cs = a->in[3];
            float cv[4][9];
#pragma unroll
            for (int j = 0; j < 4; ++j) { const int k = tid + NT * j; cv[j][0] = cc[k];
#pragma unroll
                for (int bi = 1; bi < 9; ++bi) cv[j][bi] = cs[(bi - 1) * 2048 + k]; }
#pragma unroll
            for (int j = 0; j < 4; ++j) { const int k = tid + NT * j;
#pragma unroll
                for (int bi = 0; bi < 9; ++bi) S[k * 12 + bi] = silu_f(cv[j][bi]); }
        }
        __syncthreads();
        const int l4 = tid & 31, rg = tid >> 5;
        f32x4 accm[9];
#pragma unroll
        for (int bi = 0; bi < 9; ++bi) accm[bi] = (f32x4){0.f, 0.f, 0.f, 0.f};
#pragma unroll 8
        for (int kk = 0; kk < 128; ++kk) {
            const int k = rg + 16 * kk;
            const f32x4 w = *(const f32x4*)(Wm + (size_t)k * 12288 + n0 + 4 * l4);
            const f32x4 s0 = *(const LAS f32x4*)(S + k * 12), s1 = *(const LAS f32x4*)(S + k * 12 + 4); const float s8 = S[k * 12 + 8];
            accm[0] += s0[0] * w; accm[1] += s0[1] * w; accm[2] += s0[2] * w; accm[3] += s0[3] * w;
            accm[4] += s1[0] * w; accm[5] += s1[1] * w; accm[6] += s1[2] * w; accm[7] += s1[3] * w; accm[8] += s8 * w;
        }
        __syncthreads();
        LAS float* red = (LAS float*)lds;
#pragma unroll
        for (int bi = 0; bi < 9; ++bi) *(LAS f32x4*)(red + (rg * 9 + bi) * 128 + 4 * l4) = accm[bi];
        __syncthreads();
        float* MOD = (float*)(ws + WS_MOD) + (size_t)l * 9 * 12288;
        for (int o = tid; o < 9 * 128; o += NT) { const int bi = o >> 7, n = o & 127; float s = bm[n0 + n];
#pragma unroll
            for (int r = 0; r < 16; ++r) s += red[(r * 9 + bi) * 128 + n];
            MOD[(size_t)bi * 12288 + n0 + n] = s; }
        __syncthreads();
    }
    __syncthreads();
    if (G == 256) { if (vcu >= 192) convert_set(a, lds, 0, (vcu - 192) * 8 + wave, 64 * 8); }
    else convert_set(a, lds, 0, vcu * 8 + wave, G * 8);
    if (G != 256) { convert_set(a, lds, 1, vcu * 8 + wave, G * 8); convert_set(a, lds, 2, vcu * 8 + wave, G * 8); dft_tables(ws, vcu * NT + tid, G * NT); }
}

__device__ __forceinline__ void phase_norm_mod(const float* x0, const float* x1, const float* nw, const float* sh, const float* sc, bf16_t* H, int vcu, int G) {
    const int lane = threadIdx.x & 63, wave = __builtin_amdgcn_readfirstlane(threadIdx.x >> 6);
    const int gw = vcu * 8 + wave, NGW = G * 8;
    const int chunk = (T + NGW - 1) / NGW, r0 = gw * chunk, r1 = (r0 + chunk < T) ? r0 + chunk : T;
    if (r0 >= r1) return;
    f32x4 wv[8], av[8], vn[8]; int bi_cur = -1;
#define NRM_LOAD(r) do { const int r_ = (r); const float* xr = r_ < TCTX ? x0 + (size_t)r_ * D : x1 + (size_t)(r_ - TCTX) * D; \
        _Pragma("unroll") for (int j = 0; j < 8; ++j) vn[j] = *(const f32x4*)(xr + 4 * lane + 256 * j); } while (0)
    NRM_LOAD(r0);
    for (int row = r0; row < r1; ++row) {
        f32x4 v[8];
#pragma unroll
        for (int j = 0; j < 8; ++j) v[j] = vn[j];
        NRM_LOAD(row + 1 < r1 ? row + 1 : row);
        const int bi = row < TCTX ? 0 : 1 + ((row - TCTX) >> 10);
        if (bi != bi_cur) { bi_cur = bi; const float* shp = sh + (size_t)bi * 12288; const float* scp = sc + (size_t)bi * 12288;
#pragma unroll
            for (int j = 0; j < 8; ++j) { const int c = 4 * lane + 256 * j; wv[j] = *(const f32x4*)(nw + c) * (*(const f32x4*)(scp + c) + 1.0f); av[j] = *(const f32x4*)(shp + c); } }
        float s = 0.f;
#pragma unroll
        for (int j = 0; j < 8; ++j) s += (v[j][0] * v[j][0] + v[j][1] * v[j][1]) + (v[j][2] * v[j][2] + v[j][3] * v[j][3]);
        const float rstd = rsqrtf(wave_sum(s) * (1.0f / D) + 1e-6f);
#pragma unroll
        for (int j = 0; j < 8; ++j) { const int c = 4 * lane + 256 * j;
            const f32x4 o = v[j] * rstd * wv[j] + av[j];
            u32x2 p; p.x = pk2(o[0], o[1]); p.y = pk2(o[2], o[3]);
            *(u32x2*)(H + (size_t)row * D + c) = p; }
    }
#undef NRM_LOAD
}
__device__ __forceinline__ void phase_final_norm(float* X, const float* nw, int vcu, int G) {
    const int lane = threadIdx.x & 63, wave = __builtin_amdgcn_readfirstlane(threadIdx.x >> 6);
    const int gw = vcu * 8 + wave, NGW = G * 8;
    const int chunk = (T + NGW - 1) / NGW, r0 = gw * chunk, r1 = (r0 + chunk < T) ? r0 + chunk : T;
    if (r0 >= r1) return;
    f32x4 wv[8], vn[8];
#pragma unroll
    for (int j = 0; j < 8; ++j) wv[j] = *(const f32x4*)(nw + 4 * lane + 256 * j);
#define NRM_LOAD(r) do { const float* xr = X + (size_t)(r) * D; _Pragma("unroll") for (int j = 0; j < 8; ++j) vn[j] = *(const f32x4*)(xr + 4 * lane + 256 * j); } while (0)
    NRM_LOAD(r0);
    for (int row = r0; row < r1; ++row) {
        f32x4 v[8];
#pragma unroll
        for (int j = 0; j < 8; ++j) v[j] = vn[j];
        NRM_LOAD(row + 1 < r1 ? row + 1 : row);
        float s = 0.f;
#pragma unroll
        for (int j = 0; j < 8; ++j) s += (v[j][0] * v[j][0] + v[j][1] * v[j][1]) + (v[j][2] * v[j][2] + v[j][3] * v[j][3]);
        const float rstd = rsqrtf(wave_sum(s) * (1.0f / D) + 1e-6f);
        float* xr = X + (size_t)row * D;
#pragma unroll
        for (int j = 0; j < 8; ++j) *(f32x4*)(xr + 4 * lane + 256 * j) = v[j] * rstd * wv[j];
    }
#undef NRM_LOAD
}

constexpr int P128 = 136, P64 = 72;
constexpr int SC_QS = 0, SC_KS = SC_QS + 64 * P128 * 2, SC_QI = SC_KS + 64 * P128 * 2, SC_KO = SC_QI + 64 * P128 * 2, SC_VT = SC_KO + 128 * P64 * 2,
              SC_SC = SC_VT + 128 * P64 * 2, SC_ST = SC_SC + 64 * P64 * 2, SC_TOT = SC_ST + 128 * P128 * 2, SC_DEC = SC_TOT + 4 * 128 * 4, SC_END = SC_DEC + 128 * 4;
static_assert(SC_END <= LDS_BYTES, "scan LDS");
__device__ __forceinline__ void scan_item(KA a, LAS unsigned char* lds, int seqbase, int N, int b_state, int h, int dir, bool ctx, int b_out) {
    int tid = threadIdx.x; asm volatile("" : "+v"(tid));
    const int lane = tid & 63, w = __builtin_amdgcn_readfirstlane(tid >> 6), fr = lane & 15, fq = lane >> 4;
    unsigned char* ws = a->ws;
    const bf16_t* Qg = (const bf16_t*)(ws + WS_Q) + h * 128; const bf16_t* Vg = (const bf16_t*)(ws + WS_V) + h * 128;
    const float* LFg = (const float*)(ws + WS_LF) + dir * 1024 + h * 128;
    float* Og = (float*)(ws + (dir ? WS_OB : WS_OF)) + h * 128;
    LAS bf16_t* QS = (LAS bf16_t*)(lds + SC_QS); LAS bf16_t* KS = (LAS bf16_t*)(lds + SC_KS); LAS bf16_t* QI = (LAS bf16_t*)(lds + SC_QI);
    LAS bf16_t* KO = (LAS bf16_t*)(lds + SC_KO); LAS bf16_t* VT = (LAS bf16_t*)(lds + SC_VT); LAS bf16_t* SCm = (LAS bf16_t*)(lds + SC_SC);
    LAS bf16_t* ST = (LAS bf16_t*)(lds + SC_ST); LAS float* TOT = (LAS float*)(lds + SC_TOT); LAS float* DEC = (LAS float*)(lds + SC_DEC);
    const int cp = tid & 63, seg = tid >> 6;
    f32x4 accS[8];
    if (ctx) {
#pragma unroll
        for (int kt = 0; kt < 8; ++kt) accS[kt] = (f32x4){0.f, 0.f, 0.f, 0.f};
    } else {
        const float* s0 = a->in[2] + ((size_t)(b_state * 2 + dir) * 8 + h) * 16384;
#pragma unroll
        for (int kt = 0; kt < 8; ++kt)
#pragma unroll
            for (int e = 0; e < 4; ++e) accS[kt][e] = s0[(16 * kt + 4 * fq + e) * 128 + 16 * w + fr];
    }
    __syncthreads();
#pragma unroll
    for (int kt = 0; kt < 8; ++kt) { u32x2 p; p.x = pk2(accS[kt][0], accS[kt][1]); p.y = pk2(accS[kt][2], accS[kt][3]); *(LAS u32x2*)(ST + (16 * w + fr) * P128 + 16 * kt + 4 * fq) = p; }
    const int nc = N >> 6;
    f32x2 lfN[8]; unsigned qN[8], vN[8];
#define SCAN_LOAD(cc) do { _Pragma("unroll") for (int ii = 0; ii < 8; ++ii) { \
            const int i = 64 * (cc) + 8 * seg + ii; const int tok = seqbase + (dir ? N - 1 - i : i); \
            lfN[ii] = *(const f32x2*)(LFg + ((unsigned)tok * 2048u + 2u * (unsigned)cp)); qN[ii] = *(const unsigned*)(Qg + ((unsigned)tok * 1024u + 2u * (unsigned)cp)); vN[ii] = *(const unsigned*)(Vg + ((unsigned)tok * 1024u + 2u * (unsigned)cp)); } } while (0)
    SCAN_LOAD(0);
    for (int c = 0; c < nc; ++c) {
        f32x2 lf[8]; unsigned qq[8], vq[8];
#pragma unroll
        for (int ii = 0; ii < 8; ++ii) { lf[ii] = lfN[ii]; qq[ii] = qN[ii]; vq[ii] = vN[ii]; }
        { const int cn = c + 1 < nc ? c + 1 : c; SCAN_LOAD(cn); }
        f32x2 run = (f32x2){0.f, 0.f};
#pragma unroll
        for (int ii = 0; ii < 8; ++ii) run += lf[ii];
        *(LAS f32x2*)(TOT + seg * 128 + 2 * cp) = run;
        __syncthreads();
        f32x2 offs = (f32x2){0.f, 0.f}, ref = (f32x2){0.f, 0.f}, blast = (f32x2){0.f, 0.f};
#pragma unroll
        for (int sg = 0; sg < 8; ++sg) { const f32x2 t = *(const LAS f32x2*)(TOT + sg * 128 + 2 * cp); if (sg < seg) offs += t; if (sg < 4) ref += t; blast += t; }
        if (seg == 0) *(LAS f32x2*)(DEC + 2 * cp) = (f32x2){__expf(blast[0]), __expf(blast[1])};
        const f32x2 eref = (f32x2){__expf(ref[0]), __expf(ref[1])}, ebr = (f32x2){__expf(blast[0] - ref[0]), __expf(blast[1] - ref[1])};
        f32x2 brun = offs;
        unsigned kow[2][4], vtw[2][4];
#pragma unroll
        for (int ii = 0; ii < 8; ii += 2) {
            float ko2[2][2];
#pragma unroll
            for (int d = 0; d < 2; ++d) {
                const int i2 = ii + d, i = 8 * seg + i2; brun += lf[i2];
                float qs[2], ks[2];
#pragma unroll
                for (int x = 0; x < 2; ++x) {
                    const float kf = 1.0f - __expf(lf[i2][x]);
                    const float e1 = __expf(brun[x] - ref[x]), e2 = __builtin_amdgcn_rcpf(e1);
                    qs[x] = (x ? bfhi(qq[i2]) : bflo(qq[i2])) * e1; ks[x] = kf * e2; ko2[x][d] = ks[x] * ebr[x];
                }
                *(LAS unsigned*)(QS + i * P128 + 2 * cp) = pk2(qs[0], qs[1]);
                *(LAS unsigned*)(KS + i * P128 + 2 * cp) = pk2(ks[0], ks[1]);
                *(LAS unsigned*)(QI + i * P128 + 2 * cp) = pk2(qs[0] * eref[0], qs[1] * eref[1]);
            }
            kow[0][ii >> 1] = pk2(ko2[0][0], ko2[0][1]); kow[1][ii >> 1] = pk2(ko2[1][0], ko2[1][1]);
            vtw[0][ii >> 1] = (vq[ii] & 0xffffu) | (vq[ii + 1] << 16); vtw[1][ii >> 1] = (vq[ii] >> 16) | (vq[ii + 1] & 0xffff0000u);
        }
#pragma unroll
        for (int x = 0; x < 2; ++x) {
            *(LAS u32x4*)(KO + (2 * cp + x) * P64 + 8 * seg) = (u32x4){kow[x][0], kow[x][1], kow[x][2], kow[x][3]};
            *(LAS u32x4*)(VT + (2 * cp + x) * P64 + 8 * seg) = (u32x4){vtw[x][0], vtw[x][1], vtw[x][2], vtw[x][3]};
        }
        __syncthreads();
        {
            const int it = w >> 1;
#pragma unroll
            for (int jj = 0; jj < 2; ++jj) {
                const int jt = 2 * (w & 1) + jj;
                f32x4 d = (f32x4){0.f, 0.f, 0.f, 0.f};
                if (jt <= it) {
#pragma unroll
                    for (int ks = 0; ks < 4; ++ks) {
                        const bf16x8 af = *(const LAS bf16x8*)(KS + (16 * jt + fr) * P128 + 32 * ks + 8 * fq);
                        const bf16x8 bf = *(const LAS bf16x8*)(QS + (16 * it + fr) * P128 + 32 * ks + 8 * fq);
                        d = __builtin_amdgcn_mfma_f32_16x16x32_bf16(af, bf, d, 0, 0, 0);
                    }
                }
                const int i = 16 * it + fr, j0 = 16 * jt + 4 * fq;
#pragma unroll
                for (int e = 0; e < 4; ++e) if (j0 + e > i) d[e] = 0.f;
                u32x2 p; p.x = pk2(d[0], d[1]); p.y = pk2(d[2], d[3]);
                *(LAS u32x2*)(SCm + i * P64 + j0) = p;
            }
        }
        __syncthreads();
        f32x4 oacc[4];
#pragma unroll
        for (int it = 0; it < 4; ++it) oacc[it] = (f32x4){0.f, 0.f, 0.f, 0.f};
        {
            bf16x8 stf[4], vtf[2];
#pragma unroll
            for (int ks = 0; ks < 4; ++ks) stf[ks] = *(const LAS bf16x8*)(ST + (16 * w + fr) * P128 + 32 * ks + 8 * fq);
#pragma unroll
            for (int ks = 0; ks < 2; ++ks) vtf[ks] = *(const LAS bf16x8*)(VT + (16 * w + fr) * P64 + 32 * ks + 8 * fq);
#pragma unroll
            for (int it = 0; it < 4; ++it) {
#pragma unroll
                for (int ks = 0; ks < 4; ++ks) { const bf16x8 qf = *(const LAS bf16x8*)(QI + (16 * it + fr) * P128 + 32 * ks + 8 * fq); oacc[it] = __builtin_amdgcn_mfma_f32_16x16x32_bf16(stf[ks], qf, oacc[it], 0, 0, 0); }
#pragma unroll
                for (int ks = 0; ks < 2; ++ks) { const bf16x8 sf = *(const LAS bf16x8*)(SCm + (16 * it + fr) * P64 + 32 * ks + 8 * fq); oacc[it] = __builtin_amdgcn_mfma_f32_16x16x32_bf16(vtf[ks], sf, oacc[it], 0, 0, 0); }
            }
#pragma unroll
            for (int kt = 0; kt < 8; ++kt) {
                const f32x4 dc = *(const LAS f32x4*)(DEC + 16 * kt + 4 * fq);
                accS[kt] = accS[kt] * dc;
#pragma unroll
                for (int ks = 0; ks < 2; ++ks) { const bf16x8 kf = *(const LAS bf16x8*)(KO + (16 * kt + fr) * P64 + 32 * ks + 8 * fq); accS[kt] = __builtin_amdgcn_mfma_f32_16x16x32_bf16(kf, vtf[ks], accS[kt], 0, 0, 0); }
            }
        }
#pragma unroll
        for (int it = 0; it < 4; ++it) { const int i = 64 * c + 16 * it + fr; const int tok = seqbase + (dir ? N - 1 - i : i); *(f32x4*)(Og + (size_t)tok * 1024 + 16 * w + 4 * fq) = oacc[it]; }
#pragma unroll
        for (int kt = 0; kt < 8; ++kt) { u32x2 p; p.x = pk2(accS[kt][0], accS[kt][1]); p.y = pk2(accS[kt][2], accS[kt][3]); *(LAS u32x2*)(ST + (16 * w + fr) * P128 + 16 * kt + 4 * fq) = p; }
    }
    if (ctx) {
        float* so = a->out + (size_t)T * D + ((size_t)(b_out * 2 + dir) * 8 + h) * 16384;
#pragma unroll
        for (int kt = 0; kt < 8; ++kt)
#pragma unroll
            for (int e = 0; e < 4; ++e) so[(16 * kt + 4 * fq + e) * 128 + 16 * w + fr] = accS[kt][e];
    }
}

constexpr int MB_WS = 0, MB_BV = 128 * P128 * 2, MB_END = MB_BV + 256 * P128 * 2;
static_assert(MB_END <= LDS_BYTES, "mixer-B LDS");
__device__ __forceinline__ void mixb_item(KA a, LAS unsigned char* lds, int cbk, int g, bool load_ws) {
    int tid = threadIdx.x; asm volatile("" : "+v"(tid));
    const int lane = tid & 63, w = __builtin_amdgcn_readfirstlane(tid >> 6), fr = lane & 15, fq = lane >> 4;
    unsigned char* ws = a->ws;
    LAS bf16_t* WSl = (LAS bf16_t*)(lds + MB_WS); LAS bf16_t* BV = (LAS bf16_t*)(lds + MB_BV);
    const bf16_t* VVg = (const bf16_t*)(ws + WS_VV) + (size_t)cbk * 128 * 1024 + g * 256;
    const bf16_t* Ug = (const bf16_t*)(ws + WS_U) + (size_t)cbk * 128 * 1024 + g * 256;
    bf16_t* CAT = (bf16_t*)(ws + WS_CAT) + (size_t)cbk * 128 * D + 1024 + g * 256;
    const float* wsg = a->in[12] + (size_t)g * 16384; const float* vn = a->in[11] + g * 256; const float* bsg = a->in[13] + g * 128;
    const int q = tid >> 2, qt = tid & 3;
    u32x4 raw[8];
#pragma unroll
    for (int j = 0; j < 8; ++j) raw[j] = *(const u32x4*)(VVg + (size_t)q * 1024 + qt * 64 + 8 * j);
    __syncthreads();
    if (load_ws) {
#pragma unroll
        for (int j = 0; j < 8; ++j) { const int idx = (tid + j * NT) * 4, p = idx >> 7, qq = idx & 127; const f32x4 v = *(const f32x4*)(wsg + idx);
            u32x2 o; o.x = pk2(v[0], v[1]); o.y = pk2(v[2], v[3]); *(LAS u32x2*)(WSl + p * P128 + qq) = o; }
    }
    {
        float ss = 0.f;
#pragma unroll
        for (int j = 0; j < 8; ++j)
#pragma unroll
            for (int e = 0; e < 4; ++e) { const float lo = bflo(raw[j][e]), hi = bfhi(raw[j][e]); ss += lo * lo + hi * hi; }
        ss += __shfl_xor(ss, 1); ss += __shfl_xor(ss, 2);
        const float rstd = rsqrtf(ss * (1.0f / 256.0f) + 1e-6f);
        const int qs = q ^ (16 * qt);
#pragma unroll
        for (int j = 0; j < 8; ++j)
#pragma unroll
            for (int e = 0; e < 4; ++e) { const int c = qt * 64 + 8 * j + 2 * e; const float lo = bflo(raw[j][e]) * rstd, hi = bfhi(raw[j][e]) * rstd;
                BV[c * P128 + qs] = (bf16_t)pk2(lo, lo); BV[(c + 1) * P128 + qs] = (bf16_t)pk2(hi, hi); }
    }
    const int wr2 = w >> 2, wc2 = w & 3;
    u32x2 uu[4][4];
#pragma unroll
    for (int mt = 0; mt < 4; ++mt)
#pragma unroll
        for (int nt = 0; nt < 4; ++nt) uu[mt][nt] = *(const u32x2*)(Ug + (size_t)(64 * wr2 + 16 * mt + fr) * 1024 + 64 * wc2 + 16 * nt + 4 * fq);
    __syncthreads();
    f32x4 acc[4][4];
#pragma unroll
    for (int mt = 0; mt < 4; ++mt)
#pragma unroll
        for (int nt = 0; nt < 4; ++nt) acc[mt][nt] = (f32x4){0.f, 0.f, 0.f, 0.f};
#pragma unroll
    for (int ks = 0; ks < 4; ++ks) {
        bf16x8 wf[4], vf[4];
#pragma unroll
        for (int mt = 0; mt < 4; ++mt) wf[mt] = *(const LAS bf16x8*)(WSl + (64 * wr2 + 16 * mt + fr) * P128 + 32 * ks + 8 * fq);
#pragma unroll
        for (int nt = 0; nt < 4; ++nt) vf[nt] = *(const LAS bf16x8*)(BV + (64 * wc2 + 16 * nt + fr) * P128 + ((32 * ks + 8 * fq) ^ (16 * wc2)));
#pragma unroll
        for (int mt = 0; mt < 4; ++mt)
#pragma unroll
            for (int nt = 0; nt < 4; ++nt) acc[mt][nt] = __builtin_amdgcn_mfma_f32_16x16x32_bf16(vf[nt], wf[mt], acc[mt][nt], 0, 0, 0);
    }
#pragma unroll
    for (int nt = 0; nt < 4; ++nt) {
        const int c = 64 * wc2 + 16 * nt + 4 * fq; const f32x4 vnv = *(const f32x4*)(vn + c);
#pragma unroll
        for (int mt = 0; mt < 4; ++mt) { const int p = 64 * wr2 + 16 * mt + fr; const float bsv = bsg[p];
            u32x2 o; o.x = pk2(bflo(uu[mt][nt].x) * (acc[mt][nt][0] * vnv[0] + bsv), bfhi(uu[mt][nt].x) * (acc[mt][nt][1] * vnv[1] + bsv));
            o.y = pk2(bflo(uu[mt][nt].y) * (acc[mt][nt][2] * vnv[2] + bsv), bfhi(uu[mt][nt].y) * (acc[mt][nt][3] * vnv[3] + bsv));
            *(u32x2*)(CAT + (size_t)p * D + c) = o; }
    }
}
__device__ __forceinline__ void mixer_work(KA a, LAS unsigned char* lds, int it, bool mixb_reload = true) {
    if (it < 128) { const int s = it >> 4, h = (it >> 1) & 7, dir = it & 1; scan_item(a, lds, TCTX + 1024 * s, 1024, s, h, dir, false, 0); }
    else if (it < 384) { const int j = it - 128, s = j >> 4, h = (j >> 1) & 7, dir = j & 1; scan_item(a, lds, 256 * s, 256, 0, h, dir, true, s); }
    else { const int j = it - 384, blk = j / 3, q = j % 3; mixb_item(a, lds, 3 * (blk & 31) + q, blk >> 5, mixb_reload || q == 0); }
}
__device__ __forceinline__ void phase_mixers(KA a, LAS unsigned char* lds, int vcu, int G) {
    PSTAMPB(a, 30, 0); PSTAMPB(a, 32, 4);
    if (G == 256) {
        const int j = vcu - 128, n = vcu < 128 ? 1 : 5;
        for (int q = 0; q < n; ++q) { const int it = vcu < 128 ? vcu : (q < 2 ? 128 + 2 * j + q : 384 + 3 * j + (q - 2)); mixer_work(a, lds, it, false); if (q == 1) PSTAMPB(a, 33, 4); }
    } else { for (int it = vcu; it < 768; it += G) mixer_work(a, lds, it); }
    __syncthreads();
    PSTAMPB(a, 31, 0); PSTAMPB(a, 34, 4);
}
__device__ __forceinline__ void phase_finalize_a(KA a, int vcu, int G) {
    const int lane = threadIdx.x & 63, wave = __builtin_amdgcn_readfirstlane(threadIdx.x >> 6);
    const int gw = vcu * 8 + wave, NGW = G * 8;
    const int chunk = (T + NGW - 1) / NGW, r0 = gw * chunk, r1 = (r0 + chunk < T) ? r0 + chunk : T;
    if (r0 >= r1) return;
    unsigned char* ws = a->ws;
    const float* OF = (const float*)(ws + WS_OF); const float* OB = (const float*)(ws + WS_OB); const bf16_t* GA = (const bf16_t*)(ws + WS_GA); bf16_t* CAT = (bf16_t*)(ws + WS_CAT);
    const int col = (lane >> 3) * 128 + (lane & 7) * 16, vc = (lane & 7) * 16;
    f32x4 gn[4];
#pragma unroll
    for (int j = 0; j < 4; ++j) gn[j] = *(const f32x4*)(a->in[10] + vc + 4 * j);
    f32x4 fn[4], bn[4]; u32x4 g0n, g1n;
#define FIN_LOAD(r) do { const size_t o_ = (size_t)(r) * 1024 + col; _Pragma("unroll") for (int j = 0; j < 4; ++j) { fn[j] = *(const f32x4*)(OF + o_ + 4 * j); bn[j] = *(const f32x4*)(OB + o_ + 4 * j); } \
        g0n = *(const u32x4*)(GA + o_); g1n = *(const u32x4*)(GA + o_ + 8); } while (0)
    FIN_LOAD(r0);
    for (int row = r0; row < r1; ++row) {
        f32x4 v[4]; const u32x4 g0 = g0n, g1 = g1n; float ss = 0.f;
#pragma unroll
        for (int j = 0; j < 4; ++j) { v[j] = fn[j] + bn[j]; ss += (v[j][0] * v[j][0] + v[j][1] * v[j][1]) + (v[j][2] * v[j][2] + v[j][3] * v[j][3]); }
        FIN_LOAD(row + 1 < r1 ? row + 1 : row);
        ss += __shfl_xor(ss, 1); ss += __shfl_xor(ss, 2); ss += __shfl_xor(ss, 4);
        const float rstd = rsqrtf(ss * (1.0f / 128.0f) + 1e-6f);
        u32x4 o0, o1;
#pragma unroll
        for (int e = 0; e < 4; ++e) {
            const int j = e >> 1, k = (e & 1) * 2;
            o0[e] = pk2(v[j][k] * rstd * gn[j][k] * bflo(g0[e]), v[j][k + 1] * rstd * gn[j][k + 1] * bfhi(g0[e]));
            o1[e] = pk2(v[2 + j][k] * rstd * gn[2 + j][k] * bflo(g1[e]), v[2 + j][k + 1] * rstd * gn[2 + j][k + 1] * bfhi(g1[e]));
        }
        *(u32x4*)(CAT + (size_t)row * D + col) = o0; *(u32x4*)(CAT + (size_t)row * D + col + 8) = o1;
    }
#undef FIN_LOAD
}

#define XB_TMO      128
#define XB_XCNT(j)  (256  + 64 * (j))
#define XB_XSUB(j)  (1280 + 64 * (j))
#define XB_XGEN(j)  (2304 + 64 * (j))
#define XB_TOP      3328
#define XB_TOPGEN   3392
#define XCD_BAR_WORDS 3456
#define XB_SPIN_CAP (1u << 18)
__device__ __forceinline__ unsigned xb_ld(unsigned* p)              { return __hip_atomic_load(p, __ATOMIC_RELAXED, __HIP_MEMORY_SCOPE_AGENT); }
__device__ __forceinline__ unsigned xb_add(unsigned* p, unsigned v) { return __hip_atomic_fetch_add(p, v, __ATOMIC_RELAXED, __HIP_MEMORY_SCOPE_AGENT); }
__device__ __forceinline__ unsigned xb_xcc_id() { return (unsigned)__builtin_amdgcn_s_getreg((3 << 11) | 20) & 0xFu; }
#define XB_SPIN(cond, bar) do { unsigned _sp = 0; while (cond) { __builtin_amdgcn_s_sleep(1); \
    if ((++_sp & 255u) == 0u) { if (xb_ld(&(bar)[XB_TMO])) break; if (_sp > XB_SPIN_CAP) { atomicAdd(&(bar)[XB_TMO], 1u); break; } } } } while (0)
struct XcdBarrier { unsigned* bar; unsigned x; volatile LAS unsigned* st; };
__device__ __forceinline__ XcdBarrier xcd_barrier_post(unsigned* bar, volatile LAS unsigned* st) {
    XcdBarrier b; b.bar = bar; b.x = xb_xcc_id(); b.st = st;
    if (threadIdx.x == 0) (void)xb_add(&bar[XB_XCNT(b.x)], 1u);
    return b;
}
__device__ __forceinline__ void xcd_barrier_complete(unsigned* bar, unsigned x, unsigned& nloc, unsigned& nx) {
    const unsigned G = gridDim.x * gridDim.y * gridDim.z;
    unsigned sum, cnt, mine, sp = 0u;
    for (;;) {
        sum = 0u; cnt = 0u; mine = 0u;
#pragma unroll
        for (unsigned j = 0; j < 16; ++j) { const unsigned c = xb_ld(&bar[XB_XCNT(j)]); sum += c; cnt += (c > 0u) ? 1u : 0u; mine = (j == x) ? c : mine; }
        if (sum == G) break;
        __builtin_amdgcn_s_sleep(1);
        if ((++sp & 255u) == 0u) { if (xb_ld(&bar[XB_TMO])) break; if (sp > XB_SPIN_CAP) { atomicAdd(&bar[XB_TMO], 1u); break; } }
    }
    nloc = mine > 0u ? mine : 1u; nx = cnt > 0u ? cnt : 1u;
}
__device__ __forceinline__ void xcd_barrier(const XcdBarrier& b) {
    asm volatile("s_waitcnt vmcnt(0)" ::: "memory");
    __syncthreads();
    if (threadIdx.x == 0) {
        unsigned* bar = b.bar;
        __builtin_amdgcn_s_waitcnt(0);
        unsigned nloc = b.st[0], nx = b.st[1];
        if (nloc == 0u) { xcd_barrier_complete(bar, b.x, nloc, nx); b.st[0] = nloc; b.st[1] = nx; }
        const unsigned old = xb_add(&bar[XB_XSUB(b.x)], 1u);
        const unsigned gen = old / nloc;
        if (old + 1u == (gen + 1u) * nloc) {
            __builtin_amdgcn_fence(__ATOMIC_RELEASE, "agent");
            asm volatile("s_waitcnt vmcnt(0)" ::: "memory");
            const unsigned og = xb_add(&bar[XB_TOP], 1u);
            const unsigned tg = og / nx;
            if (og + 1u == (tg + 1u) * nx) xb_add(&bar[XB_TOPGEN], 1u);
            else XB_SPIN(xb_ld(&bar[XB_TOPGEN]) == tg, bar);
            __builtin_amdgcn_fence(__ATOMIC_ACQUIRE, "agent");
            xb_add(&bar[XB_XGEN(b.x)], 1u);
            asm volatile("s_waitcnt vmcnt(0)" ::: "memory");
        } else {
            XB_SPIN(xb_ld(&bar[XB_XGEN(b.x)]) == gen, bar);
            __builtin_amdgcn_fence(__ATOMIC_ACQUIRE, "agent");
            asm volatile("s_waitcnt vmcnt(0)" ::: "memory");
        }
    }
    __syncthreads();
}

#ifndef DENSE_G2
#define DENSE_G2 1
#endif
#ifndef DENSE_G4
#define DENSE_G4 0
#endif
#ifndef PG8_SP2
#ifndef PG8_SP2
#define PG8_SP2 true
#endif
#endif
__global__ void __launch_bounds__(NT, 2) mk_fwd(Args a_) {
    KA a = kargs();
    extern __shared__ __attribute__((aligned(16))) unsigned char lds_raw[];
    LAS unsigned char* lds = (LAS unsigned char*)lds_raw;
    cg::grid_group grid = cg::this_grid();
    const int G = gridDim.x, bx = blockIdx.x;
    const int vcu = (G % 8 == 0) ? (bx % 8) * (G / 8) + bx / 8 : bx;
#define ws (a->ws)
    const int lo = a->ph_lo, hi = a->ph_hi;
    if (threadIdx.x < 16) ((LAS unsigned*)(lds + LDS_MISC))[threadIdx.x] = 0u;
    __syncthreads();
    (void)xcd_barrier_post((unsigned*)(ws + WS_CTL), (volatile LAS unsigned*)(lds + LDS_MISC));
    if (lo == -12345) grid.sync();
#define X (a->out)
#define MOD0 ((const float*)(ws + WS_MOD))
#define MOD1 (MOD0 + 9 * 12288)
#define Hb ((bf16_t*)(ws + WS_H))
#define CAT ((bf16_t*)(ws + WS_CAT))
#define ACT ((bf16_t*)(ws + WS_ACT))
#define PQT ((bf16_t*)(ws + WS_PQT))
#ifndef PHMASK
#define PHMASK 0x1FFFF
#endif
#define IN(k) (((PHMASK >> (k)) & 1) && lo <= (k) && (k) < hi)
#ifndef REPMASK
#define REPMASK 0
#endif
#ifndef REPN
#define REPN 2
#endif
#define REPS(k) for (int rep_ = 0; rep_ < (((REPMASK >> (k)) & 1) ? REPN : 1); ++rep_)
#ifdef PROBE_T
#define PROBE_STAMP(i) do { if (blockIdx.x == 0 && threadIdx.x == 0) ((unsigned long long*)(ws + WS_CTL + 32768))[i] = __builtin_amdgcn_s_memrealtime(); } while (0)
#else
#define PROBE_STAMP(i) do {} while (0)
#endif
#define SEAM(k) do { if (IN(k) && IN((k) + 1)) { XcdBarrier b_; b_.bar = (unsigned*)(ws + WS_CTL); b_.x = xb_xcc_id(); b_.st = (volatile LAS unsigned*)(lds + LDS_MISC); xcd_barrier(b_); PROBE_STAMP((k) + 1); } a = kargs(); } while (0)

    PROBE_STAMP(0);
    if (IN(0)) REPS(0) phase_prologue(a, lds, vcu, G);
    SEAM(0);
    if (IN(1)) REPS(1) phase_norm_mod(a->in[0], a->in[1], a->in[7], MOD0, MOD0 + D, Hb, vcu, G);
    SEAM(1);
    if (IN(2)) {
        const int GG = G == 256 ? 224 : G;
        if (bx < GG) {
            SchedDense S{48, INW / 256, GG, bx, (const char*)Hb, (const char*)(ws + WS_WIN), (size_t)256 * D * 2, (size_t)256 * D * 2, ((REPMASK >> 2) & 1) ? REPN : 1, D / 64};
            EpiInProj E{(bf16_t*)(ws + WS_Q), (bf16_t*)(ws + WS_V), (bf16_t*)(ws + WS_GA), (bf16_t*)(ws + WS_U), (bf16_t*)(ws + WS_VV), (float*)(ws + WS_LF), a->in[9]};
            pg8::gemm_phase<EpiInProj, SchedDense, PG8_SP2, 0>(lds, D, D, (size_t)128 * D * 2, (size_t)128 * D * 2, S, E);
        } else {
            const int hw = (bx - GG) * 8 + __builtin_amdgcn_readfirstlane(threadIdx.x >> 6);
            convert_set(a, lds, 1, hw, (G - GG) * 8);
            convert_set(a, lds, 2, hw, (G - GG) * 8, 0, 4096);
            dft_tables(ws, (bx - GG) * NT + threadIdx.x, (G - GG) * NT);
        }
    }
    SEAM(2);
    if (IN(3)) REPS(3) phase_mixers(a, lds, vcu, G);
    SEAM(3);
    if (IN(4)) REPS(4) phase_finalize_a(a, vcu, G);
    SEAM(4);
    if (IN(5)) {
        SchedSplit2 S{G, bx, (const char*)CAT, (const char*)(ws + WS_WOUT0), (size_t)256 * D * 2, (size_t)256 * D * 2, D / 64, DENSE_G2};
        EpiResid E{a->in[0], a->in[1], X, MOD0 + 2 * D};
        pg8::gemm_phase<EpiResid, SchedSplit2, PG8_SP2, 0, true>(lds, D, D, (size_t)128 * D * 2, (size_t)128 * D * 2, S, E, (float*)(ws + WS_OF), (unsigned*)(ws + WS_CTL) + 4096 + 0 * 128);
    }
    SEAM(5);
    if (IN(6)) REPS(6) phase_norm_mod(X, X + (size_t)TCTX * D, a->in[15], MOD0 + 3 * D, MOD0 + 4 * D, Hb, vcu, G);
    SEAM(6);
    if (IN(7)) {
        const int GG = G == 256 ? 240 : G;
        if (bx < GG) {
            SchedDense S{48, DFF / 128, GG, bx, (const char*)Hb, (const char*)(ws + WS_WUP0), (size_t)256 * D * 2, (size_t)256 * D * 2, ((REPMASK >> 7) & 1) ? REPN : 1, D / 64};
            EpiConv E{ACT, a->in[17], a->in[18], (LAS float*)(lds + LDS_XCH)};
            pg8::gemm_phase<EpiConv, SchedDense, PG8_SP2, 1>(lds, D, D, (size_t)4 * D * 2, (size_t)128 * D * 2, S, E);
        } else convert_set(a, lds, 2, (bx - GG) * 8 + __builtin_amdgcn_readfirstlane(threadIdx.x >> 6), (G - GG) * 8, 4096);
    }
    SEAM(7);
    if (IN(8)) {
        SchedSplit2 S{G, bx, (const char*)ACT, (const char*)(ws + WS_WDN0), (size_t)256 * DFF * 2, (size_t)256 * DFF * 2, DFF / 64, DENSE_G4};
        EpiResid E{X, X + (size_t)TCTX * D, X, MOD0 + 5 * D};
        pg8::gemm_phase<EpiResid, SchedSplit2, PG8_SP2, 0, true>(lds, DFF, DFF, (size_t)128 * DFF * 2, (size_t)128 * DFF * 2, S, E, (float*)(ws + WS_OF), (unsigned*)(ws + WS_CTL) + 4096 + 1 * 128);
    }
    SEAM(8);
    if (IN(9)) REPS(9) phase_norm_mod(X, X + (size_t)TCTX * D, a->in[22], MOD1, MOD1 + D, Hb, vcu, G);
    SEAM(9);
    if (IN(10)) REPS(10) {
        SchedF1 S{G, bx, (const char*)(ws + WS_DFTC), (const char*)Hb, 8};
        EpiF1 E{PQT};
        pg8::gemm_phase<EpiF1, SchedF1, PG8_SP2, 0>(lds, 512, D, (size_t)128 * 512 * 2, (size_t)128 * D * 2, S, E);
    }
    SEAM(10);
    if (IN(11)) REPS(11) {
        { SchedF2 S{G, bx, 1, (const char*)(ws + WS_DFT1024), (const char*)PQT, 32}; EpiBf16 E{CAT, D};
          pg8::gemm_phase<EpiBf16, SchedF2, PG8_SP2, 0>(lds, 2048, 2 * T, (size_t)128 * 2048 * 2, (size_t)128 * 2 * T * 2, S, E); }
        { SchedF2 S{G, bx, 0, (const char*)(ws + WS_DFT256), (const char*)PQT, 8}; EpiBf16 E{CAT, D};
          pg8::gemm_phase<EpiBf16, SchedF2, PG8_SP2, 0>(lds, 512, 2 * T, (size_t)128 * 512 * 2, (size_t)128 * 2 * T * 2, S, E); }
    }
    SEAM(11);
    if (IN(12)) {
        SchedSplit2 S{G, bx, (const char*)CAT, (const char*)(ws + WS_WOUT1), (size_t)256 * D * 2, (size_t)256 * D * 2, D / 64, DENSE_G2};
        EpiResid E{X, X + (size_t)TCTX * D, X, MOD1 + 2 * D};
        pg8::gemm_phase<EpiResid, SchedSplit2, PG8_SP2, 0, true>(lds, D, D, (size_t)128 * D * 2, (size_t)128 * D * 2, S, E, (float*)(ws + WS_OF), (unsigned*)(ws + WS_CTL) + 4096 + 2 * 128);
    }
    SEAM(12);
    if (IN(13)) REPS(13) phase_norm_mod(X, X + (size_t)TCTX * D, a->in[24], MOD1 + 3 * D, MOD1 + 4 * D, Hb, vcu, G);
    SEAM(13);
    if (IN(14)) {
        SchedDense S{48, DFF / 128, G, bx, (const char*)Hb, (const char*)(ws + WS_WUP1), (size_t)256 * D * 2, (size_t)256 * D * 2, ((REPMASK >> 14) & 1) ? REPN : 1, D / 64};
        EpiConv E{ACT, a->in[26], a->in[27], (LAS float*)(lds + LDS_XCH)};
        pg8::gemm_phase<EpiConv, SchedDense, PG8_SP2, 1>(lds, D, D, (size_t)4 * D * 2, (size_t)128 * D * 2, S, E);
    }
    SEAM(14);
    if (IN(15)) {
        SchedSplit2 S{G, bx, (const char*)ACT, (const char*)(ws + WS_WDN1), (size_t)256 * DFF * 2, (size_t)256 * DFF * 2, DFF / 64, DENSE_G4};
        EpiResid E{X, X + (size_t)TCTX * D, X, MOD1 + 5 * D};
        pg8::gemm_phase<EpiResid, SchedSplit2, PG8_SP2, 0, true>(lds, DFF, DFF, (size_t)128 * DFF * 2, (size_t)128 * DFF * 2, S, E, (float*)(ws + WS_OF), (unsigned*)(ws + WS_CTL) + 4096 + 3 * 128);
    }
    SEAM(15);
    if (IN(16)) REPS(16) phase_final_norm(X, a->in[29], vcu, G);
#ifdef PROBE_T
    if (bx == 0 && threadIdx.x == 0) { PROBE_STAMP(18);
      const unsigned long long* tsb = (const unsigned long long*)(ws + WS_CTL + 32768);
      const unsigned long long dt = tsb[PROBE_B] - tsb[PROBE_A]; const unsigned long long t0 = __builtin_amdgcn_s_memrealtime();
      while (__builtin_amdgcn_s_memrealtime() - t0 < 8ull * dt) __builtin_amdgcn_s_sleep(32); }
#endif
#undef IN
#undef SEAM
#undef ws
#undef X
#undef MOD0
#undef MOD1
#undef Hb
#undef CAT
#undef ACT
#undef PQT
}

extern "C" void kernel_launch(void* const* d_in, const int* in_sizes, int n_in, void* d_out, int out_size, void* d_ws, size_t ws_size, hipStream_t stream) {
    static int grid = 0;
    if (grid == 0) {
        if (n_in != 30 || ws_size < WS_END) { fprintf(stderr, "kernel_launch: need 30 inputs and %zu bytes of workspace (got %d, %zu)\n", (size_t)WS_END, n_in, ws_size); grid = -1; return; }
        int dev = 0, cus = 0, per_cu = 0;
        if (hipGetDevice(&dev) != hipSuccess || hipDeviceGetAttribute(&cus, hipDeviceAttributeMultiprocessorCount, dev) != hipSuccess) { grid = -1; return; }
        if (hipFuncSetAttribute((const void*)mk_fwd, hipFuncAttributeMaxDynamicSharedMemorySize, LDS_BYTES) != hipSuccess) { fprintf(stderr, "kernel_launch: hipFuncSetAttribute failed\n"); grid = -1; return; }
        if (hipOccupancyMaxActiveBlocksPerMultiprocessor(&per_cu, (const void*)mk_fwd, NT, LDS_BYTES) != hipSuccess || per_cu < 1) { fprintf(stderr, "kernel_launch: occupancy query says %d blocks per CU\n", per_cu); grid = -1; return; }
        grid = cus;
    }
    if (grid < 0) return;
    if (hipMemsetAsync((char*)d_ws + WS_CTL, 0, 65536, stream) != hipSuccess) { fprintf(stderr, "kernel_launch: hipMemsetAsync failed\n"); return; }
    Args a{};
    for (int i = 0; i < 30; ++i) a.in[i] = (const float*)d_in[i];
    a.out = (float*)d_out; a.ws = (unsigned char*)d_ws;
#if MK_FUSED
    a.ph_lo = 0; a.ph_hi = NPH;
    void* args[] = {&a};
    hipError_t e = hipLaunchCooperativeKernel((const void*)mk_fwd, dim3(grid), dim3(NT), args, LDS_BYTES, stream);
    if (e != hipSuccess) fprintf(stderr, "cooperative launch failed: %s (grid %d)\n", hipGetErrorString(e), grid);
#else
    for (int p = 0; p < NPH; ++p) {
        a.ph_lo = p; a.ph_hi = p + 1;
        void* args[] = {&a};
        hipError_t e = hipLaunchCooperativeKernel((const void*)mk_fwd, dim3(grid), dim3(NT), args, LDS_BYTES, stream);
        if (e != hipSuccess) { fprintf(stderr, "launch %d failed: %s (grid %d)\n", p, hipGetErrorString(e), grid); break; }
    }
#endif
}
```

```cpp
#define CODE_PAD "13"
#include <hip/hip_runtime.h>
#include <hip/hip_cooperative_groups.h>
#include <cstdio>
#include <cstdint>
namespace cg = cooperative_groups;

#ifndef MK_FUSED
#define MK_FUSED 1
#endif

#define LAS __attribute__((address_space(3)))
typedef unsigned short bf16_t;
typedef short bf16x8 __attribute__((ext_vector_type(8)));
typedef float f32x4 __attribute__((ext_vector_type(4)));
typedef float f32x2 __attribute__((ext_vector_type(2)));
typedef unsigned u32x4 __attribute__((ext_vector_type(4)));
typedef unsigned u32x2 __attribute__((ext_vector_type(2)));

constexpr int D = 2048, T = 12288, TCTX = 4096;
constexpr int DFF = 5632, DFF2 = 11264, INW = 7168, AW = 1024;
constexpr int NPH = 17;
constexpr int NT = 512;

constexpr size_t WS_CTL = 0;
constexpr size_t WS_MOD = 65536;
constexpr size_t WS_WIN = WS_MOD + (size_t)2 * 9 * 12288 * 4;
constexpr size_t WS_WOUT0 = WS_WIN + (size_t)INW * D * 2;
constexpr size_t WS_WUP0 = WS_WOUT0 + (size_t)D * D * 2;
constexpr size_t WS_WDN0 = WS_WUP0 + (size_t)DFF2 * D * 2;
constexpr size_t WS_WOUT1 = WS_WDN0 + (size_t)D * DFF * 2;
constexpr size_t WS_WUP1 = WS_WOUT1 + (size_t)D * D * 2;
constexpr size_t WS_WDN1 = WS_WUP1 + (size_t)DFF2 * D * 2;
constexpr size_t WS_DFTC = WS_WDN1 + (size_t)D * DFF * 2;
constexpr size_t WS_DFT256 = WS_DFTC + (size_t)1024 * 512 * 2;
constexpr size_t WS_DFT1024 = WS_DFT256 + (size_t)256 * 512 * 2;
constexpr size_t WS_H = WS_DFT1024 + (size_t)1024 * 2048 * 2;
constexpr size_t WS_CAT = WS_H + (size_t)T * D * 2;
constexpr size_t WS_R1 = WS_CAT + (size_t)T * D * 2;
constexpr size_t WS_Q = WS_R1;
constexpr size_t WS_V = WS_Q + (size_t)T * AW * 2;
constexpr size_t WS_GA = WS_V + (size_t)T * AW * 2;
constexpr size_t WS_U = WS_GA + (size_t)T * AW * 2;
constexpr size_t WS_VV = WS_U + (size_t)T * AW * 2;
constexpr size_t WS_LF = WS_VV + (size_t)T * AW * 2;
constexpr size_t WS_SLAB = WS_LF + (size_t)(16 << 20);
constexpr size_t WS_OF = WS_LF + (size_t)T * 2048 * 4;
constexpr size_t WS_OB = WS_OF + (size_t)T * AW * 2;
constexpr size_t WS_X = WS_OF + (size_t)T * AW * 4;
constexpr size_t WS_R1_END = WS_X + (size_t)T * D * 2;
constexpr size_t WS_ACT = WS_R1;
constexpr size_t WS_PQT = WS_R1;
constexpr int PQROW = 16 * 512 + 8 * 1024 + 1024;
constexpr int PQS0 = 16 * 512, PQSS = 1024;
constexpr size_t WS_END = WS_R1_END;
static_assert(WS_ACT + (size_t)T * DFF * 2 <= WS_SLAB && WS_PQT + (size_t)2048 * PQROW * 2 <= WS_SLAB && WS_SLAB + (size_t)(64 << 20) <= WS_OF, "aliases fit");

constexpr int LDS_BYTES = 147456;
constexpr int LDS_XCH = 131072;
constexpr int LDS_MISC = 131072 + 8192;

__device__ __forceinline__ unsigned f2bf(float f) { unsigned u = __builtin_bit_cast(unsigned, f); return (u + 0x7fffu + ((u >> 16) & 1u)) >> 16; }
__device__ __forceinline__ unsigned pk2(float lo, float hi) { unsigned r; asm("v_cvt_pk_bf16_f32 %0, %1, %2" : "=v"(r) : "v"(lo), "v"(hi)); return r; }
__device__ __forceinline__ float bflo(unsigned w) { return __builtin_bit_cast(float, w << 16); }
__device__ __forceinline__ float bfhi(unsigned w) { return __builtin_bit_cast(float, w & 0xffff0000u); }
typedef _Float16 f16x2 __attribute__((ext_vector_type(2)));
__device__ __forceinline__ unsigned pkh2(float a, float b) { f16x2 v; v[0] = (_Float16)a; v[1] = (_Float16)b; return __builtin_bit_cast(unsigned, v); }
__device__ __forceinline__ float bf2f(bf16_t b) { return __builtin_bit_cast(float, (unsigned)b << 16); }
__device__ __forceinline__ float wave_sum(float v) {
#pragma unroll
    for (int o = 1; o < 64; o <<= 1) v += __shfl_xor(v, o);
    return v;
}
__device__ __forceinline__ float fast_sigmoid(float x) { return __builtin_amdgcn_rcpf(1.0f + __expf(-x)); }
__device__ __forceinline__ float silu_f(float x) { return x * fast_sigmoid(x); }
__device__ __forceinline__ float gelu_tanh_f(float x) { const float u = 1.5957691216057308f * (x + 0.044715f * x * x * x); return x * fast_sigmoid(u); }
__device__ __forceinline__ int row_bi(int pm) { return pm < 16 ? 0 : 1 + ((pm - 16) >> 2); }
#define LDS_WAIT() asm volatile("s_waitcnt lgkmcnt(0)" ::: "memory")

namespace pg8 {
constexpr int BM = 256, BK = 64, HALF = 128, HTB = HALF * BK * 2, NXCD = 8, WGM = 8;
__device__ __forceinline__ int lds_byte(int r, int c) { const int st = (r >> 4) * 2 + (c >> 5), rr = r & 15, cc = c & 31, ob = rr * 64 + cc * 2; return st * 1024 + (ob ^ (((ob >> 9) & 1) << 5)); }
__device__ __forceinline__ void stage_rc(int b, int& R, int& C) { const int st = b / 1024, sb = b % 1024, swz = sb ^ (((sb >> 9) & 1) << 5); R = (st >> 1) * 16 + swz / 64; C = (st & 1) * 32 + (swz % 64) / 2; }
__device__ __forceinline__ int perm32(int rho) { const int n = rho >> 4, i = rho & 15; return 8 * (i >> 2) + 4 * n + (i & 3); }
__device__ __forceinline__ int permA_conv(int R) { return 8 * (16 * (R >> 6) + (R & 15)) + ((R >> 4) & 3); }

struct Unit { const char* A; const char* B; int e0, e1, e2, nt, sp; };

__device__ __forceinline__ void tile_order(int L, int nM, int nN, int& pm, int& pn) {
    const int nwg = nM * nN; int wgid = L;
    { const int q = nwg / NXCD, r = nwg % NXCD, xcd = wgid % NXCD, off = wgid / NXCD; wgid = (xcd < r ? xcd * (q + 1) : r * (q + 1) + (xcd - r) * q) + off; }
    const int nig = WGM * nN, gid = wgid / nig, fm = gid * WGM, gsz = (nM - fm) < WGM ? (nM - fm) : WGM;
    pm = fm + ((wgid % nig) % gsz); pn = (wgid % nig) / gsz;
}

template <class Epi, class Sched, bool SP2, int PERMA, bool SPLIT = false, bool HM = false>
__device__ __forceinline__ void gemm_phase(LAS unsigned char* lds, const int lda, const int ldb, const size_t hstepA, const size_t hstepB, const Sched& S, const Epi& E, float* slabs = nullptr, unsigned* scnt = nullptr) {
    const int tid = threadIdx.x, wid = __builtin_amdgcn_readfirstlane(tid >> 6), lane = tid & 63, wr = wid >> 2, wc = wid & 3, fr = lane & 15, fq = lane >> 4;
    unsigned voffA[2], voffB[2];
#pragma unroll
    for (int i = 0; i < 2; ++i) { int R, C; stage_rc(tid * 16 + i * 8192, R, C); const int Ra = PERMA ? permA_conv(R) : R; const int Rb = (R & ~31) + perm32(R & 31);
        voffA[i] = (unsigned)(Ra * lda + C) * 2u; voffB[i] = (unsigned)(Rb * ldb + C) * 2u; }
    const size_t kstep = (size_t)(BK * 2);
    const unsigned ldsw = (unsigned)wid * 1024u;
    const int aoff = lds_byte(wr * 64 + fr, fq * 8), boff = lds_byte(wc * 32 + fr, fq * 8);
#define PG8_SA(b, h) (((b) * 2 + (h)) * HTB)
#define PG8_SB(b, h) ((4 + (b) * 2 + (h)) * HTB)
#define PG8_STAGE(bufoff, gbase, voff) do { _Pragma("unroll") for (int _i = 0; _i < 2; ++_i) \
        __builtin_amdgcn_global_load_lds((const unsigned*)((const char*)(gbase) + (voff)[_i]), (LAS unsigned*)(lds + (bufoff) + ldsw + _i * 8192), 16, 0, 0); } while (0)
#define PG8_LDA(dst, b, h) do { _Pragma("unroll") for (int m = 0; m < 4; ++m) _Pragma("unroll") for (int k = 0; k < 2; ++k) dst[m][k] = *(const LAS bf16x8*)(lds + PG8_SA(b, h) + aoff + m * 2048 + k * 1024); } while (0)
#define PG8_LDB(dst, b, h) do { _Pragma("unroll") for (int n = 0; n < 2; ++n) _Pragma("unroll") for (int k = 0; k < 2; ++k) dst[n][k] = *(const LAS bf16x8*)(lds + PG8_SB(b, h) + boff + n * 2048 + k * 1024); } while (0)
#define PG8_MMA(ai, bj, At, Bt) do { __builtin_amdgcn_s_setprio(1); _Pragma("unroll") for (int m = 0; m < 4; ++m) _Pragma("unroll") for (int n = 0; n < 2; ++n) _Pragma("unroll") for (int k = 0; k < 2; ++k) \
        acc[ai][bj][m][n] = __builtin_amdgcn_mfma_f32_16x16x32_bf16(Bt[n][k], At[m][k], acc[ai][bj][m][n], 0, 0, 0); __builtin_amdgcn_s_setprio(0); } while (0)
#define PG8_WAIT_V(n) asm volatile("s_waitcnt vmcnt(" #n ")" ::: "memory")
#define PG8_WAIT_L(n) asm volatile("s_waitcnt lgkmcnt(" #n ")" ::: "memory")
#define PG8_BAR __builtin_amdgcn_s_barrier()
#define PG8_SCHED __builtin_amdgcn_sched_barrier(0)
    Unit cur, nxt; int ui = 0;
    if (!S.next(0, cur)) return;
    f32x4 acc[2][2][4][2];
#pragma unroll
    for (int a = 0; a < 2; ++a)
#pragma unroll
        for (int b = 0; b < 2; ++b)
#pragma unroll
            for (int m = 0; m < 4; ++m)
#pragma unroll
                for (int n = 0; n < 2; ++n) acc[a][b][m][n] = (f32x4){0.f, 0.f, 0.f, 0.f};
    bf16x8 At[4][2], B0[2][2], B1[2][2];
    const char* cA = cur.A; const char* cB = cur.B;
    if constexpr (SP2) {
        PG8_STAGE(PG8_SB(0, 0), cB, voffB); PG8_STAGE(PG8_SB(0, 1), cB + hstepB, voffB); PG8_STAGE(PG8_SA(0, 0), cA, voffA); PG8_STAGE(PG8_SA(0, 1), cA + hstepA, voffA);
        if (wr == 1) PG8_BAR;
        PG8_WAIT_V(2); PG8_BAR;
        PG8_STAGE(PG8_SB(1, 0), cB + kstep, voffB); PG8_STAGE(PG8_SA(1, 0), cA + kstep, voffA); PG8_STAGE(PG8_SB(1, 1), cB + hstepB + kstep, voffB);
        PG8_WAIT_V(6); PG8_BAR;
    } else {
        PG8_STAGE(PG8_SB(0, 0), cB, voffB); PG8_STAGE(PG8_SA(0, 0), cA, voffA); PG8_STAGE(PG8_SB(0, 1), cB + hstepB, voffB); PG8_STAGE(PG8_SA(0, 1), cA + hstepA, voffA);
        if (wr == 1) PG8_BAR;
        PG8_WAIT_V(4); PG8_BAR;
        PG8_STAGE(PG8_SB(1, 0), cB + kstep, voffB); PG8_STAGE(PG8_SA(1, 0), cA + kstep, voffA); PG8_STAGE(PG8_SB(1, 1), cB + hstepB + kstep, voffB);
        PG8_WAIT_V(6); PG8_BAR;
    }
    for (;;) {
        const bool has_next = S.next(ui + 1, nxt);
        const char* nA = has_next ? nxt.A : cA; const char* nB = has_next ? nxt.B : cB;
        const int nt = SPLIT ? cur.nt : S.nt;
        const bool hm = HM && cur.e2 != 0;
        for (int t = 0; t < nt; t += 2) {
            const bool last = (t == nt - 2);
            const char* a1 = cA + (size_t)(t + 1) * kstep;
            const char* a2 = last ? nA : cA + (size_t)(t + 2) * kstep; const char* b2 = last ? nB : cB + (size_t)(t + 2) * kstep;
            const char* a3 = a2 + kstep; const char* b3 = b2 + kstep;
            if constexpr (SP2) {
            PG8_LDB(B0, 0, 0); PG8_LDB(B1, 0, 1); PG8_SCHED; PG8_LDA(At, 0, 0); PG8_STAGE(PG8_SA(1, 1), a1 + hstepA, voffA);
            PG8_WAIT_V(8); PG8_WAIT_L(0); PG8_BAR; PG8_MMA(0, 0, At, B0); PG8_MMA(0, 1, At, B1); PG8_BAR; PG8_SCHED;
            PG8_LDA(At, 0, 1); PG8_STAGE(PG8_SB(0, 0), b2, voffB); PG8_STAGE(PG8_SB(0, 1), b2 + hstepB, voffB); PG8_STAGE(PG8_SA(0, 0), a2, voffA);
            PG8_WAIT_V(8); PG8_WAIT_L(0); PG8_BAR; if constexpr (HM) { if (!hm) { PG8_MMA(1, 0, At, B0); PG8_MMA(1, 1, At, B1); } } else { PG8_MMA(1, 0, At, B0); PG8_MMA(1, 1, At, B1); } PG8_BAR; PG8_SCHED;
            PG8_LDB(B0, 1, 0); PG8_LDB(B1, 1, 1); PG8_SCHED; PG8_LDA(At, 1, 0); PG8_STAGE(PG8_SA(0, 1), a2 + hstepA, voffA);
            PG8_WAIT_V(8); PG8_WAIT_L(0); PG8_BAR; PG8_MMA(0, 0, At, B0); PG8_MMA(0, 1, At, B1); PG8_BAR; PG8_SCHED;
            PG8_LDA(At, 1, 1); PG8_STAGE(PG8_SB(1, 0), b3, voffB); PG8_STAGE(PG8_SB(1, 1), b3 + hstepB, voffB); PG8_STAGE(PG8_SA(1, 0), a3, voffA);
            PG8_WAIT_V(8); PG8_WAIT_L(0); PG8_BAR; if constexpr (HM) { if (!hm) { PG8_MMA(1, 0, At, B0); PG8_MMA(1, 1, At, B1); } } else { PG8_MMA(1, 0, At, B0); PG8_MMA(1, 1, At, B1); } PG8_BAR; PG8_SCHED;
            } else {
            PG8_LDB(B0, 0, 0); PG8_SCHED; PG8_LDA(At, 0, 0); PG8_STAGE(PG8_SA(1, 1), a1 + hstepA, voffA);
            PG8_WAIT_L(8); PG8_BAR; PG8_WAIT_L(0); PG8_MMA(0, 0, At, B0); PG8_BAR; PG8_SCHED;
            PG8_LDB(B1, 0, 1); PG8_STAGE(PG8_SB(0, 0), b2, voffB);
            PG8_BAR; PG8_WAIT_L(0); PG8_MMA(0, 1, At, B1); PG8_BAR;
            PG8_LDA(At, 0, 1); PG8_STAGE(PG8_SA(0, 0), a2, voffA);
            PG8_BAR; PG8_WAIT_L(0); PG8_MMA(1, 0, At, B0); PG8_BAR; PG8_SCHED;
            PG8_STAGE(PG8_SB(0, 1), b2 + hstepB, voffB);
            PG8_WAIT_V(6); PG8_BAR; PG8_MMA(1, 1, At, B1); PG8_BAR;
            PG8_LDB(B0, 1, 0); PG8_SCHED; PG8_LDA(At, 1, 0); PG8_STAGE(PG8_SA(0, 1), a2 + hstepA, voffA);
            PG8_WAIT_L(8); PG8_BAR; PG8_WAIT_L(0); PG8_MMA(0, 0, At, B0); PG8_BAR; PG8_SCHED;
            PG8_LDB(B1, 1, 1); PG8_STAGE(PG8_SB(1, 0), b3, voffB);
            PG8_BAR; PG8_WAIT_L(0); PG8_MMA(0, 1, At, B1); PG8_BAR;
            PG8_LDA(At, 1, 1); PG8_STAGE(PG8_SA(1, 0), a3, voffA);
            PG8_BAR; PG8_WAIT_L(0); PG8_MMA(1, 0, At, B0); PG8_BAR; PG8_SCHED;
            PG8_STAGE(PG8_SB(1, 1), b3 + hstepB, voffB);
            PG8_WAIT_V(6); PG8_BAR; PG8_MMA(1, 1, At, B1); PG8_BAR;
            }
        }
        if (wr == 0) PG8_BAR;
        bool do_epi = true;
        if constexpr (SPLIT) if (cur.sp) {
            const int pair = (cur.sp - 1) >> 1;
            LAS unsigned* flag = (LAS unsigned*)(lds + 131072 + 8192 + 64);
            if (tid == 0) *flag = __hip_atomic_fetch_add(scnt + pair, 1u, __ATOMIC_RELAXED, __HIP_MEMORY_SCOPE_AGENT);
            asm volatile("s_waitcnt lgkmcnt(0)" ::: "memory");
            PG8_BAR;
            asm volatile("" ::: "memory");
            do_epi = (*(volatile LAS unsigned*)flag != 0u);
            {
                const __amdgpu_buffer_rsrc_t rs = __builtin_amdgcn_make_buffer_rsrc((void*)slabs, (short)0, do_epi ? 0 : 128 * 32 * 512 * 16, 0x00020000);
                const unsigned v0 = (unsigned)((pair * 32 * 512 + tid) * 16);
#pragma unroll
                for (int r = 0; r < 32; ++r) __builtin_amdgcn_raw_buffer_store_b128(__builtin_bit_cast(u32x4, acc[r >> 4][(r >> 3) & 1][(r >> 1) & 3][r & 1]), rs, v0 + (unsigned)r * 8192u, 0, 16);
            }
            asm volatile("s_waitcnt vmcnt(0)" ::: "memory");
            PG8_BAR;
            if (tid == 0) {
                if (!do_epi) __hip_atomic_store(scnt + 512 + pair, 1u, __ATOMIC_RELAXED, __HIP_MEMORY_SCOPE_AGENT);
                else {
                    unsigned sp_ = 0;
                    while (__hip_atomic_load(scnt + 512 + pair, __ATOMIC_RELAXED, __HIP_MEMORY_SCOPE_AGENT) == 0u) { __builtin_amdgcn_s_sleep(1); if (++sp_ > (1u << 22)) break; }
                    __builtin_amdgcn_fence(__ATOMIC_ACQUIRE, "agent"); asm volatile("s_waitcnt vmcnt(0)" ::: "memory");
                }
            }
            PG8_BAR;
            asm volatile("" ::: "memory");
            if (do_epi) {
                int tid_o = tid; asm volatile("" : "+v"(tid_o));
                const float* s1 = slabs + ((size_t)pair * 32 * 512 + tid_o) * 4;
                constexpr int CB = PERMA ? 8 : 16;
#pragma unroll
                for (int rb = 0; rb < 32; rb += CB) {
                    f32x4 t[CB];
#pragma unroll
                    for (int r = 0; r < CB; ++r) t[r] = *(const f32x4*)(s1 + (size_t)(rb + r) * 2048);
                    asm volatile("" ::: "memory");
#pragma unroll
                    for (int r = 0; r < CB; ++r) acc[(rb + r) >> 4][((rb + r) >> 3) & 1][((rb + r) >> 1) & 3][(rb + r) & 1] += t[r];
                    asm volatile("" ::: "memory");
                }
            }
        }
        if (do_epi) E(acc, cur, wr, wc, fr, fq);
        if (!has_next) break;
#pragma unroll
        for (int a = 0; a < 2; ++a)
#pragma unroll
            for (int b = 0; b < 2; ++b)
#pragma unroll
                for (int m = 0; m < 4; ++m)
#pragma unroll
                    for (int n = 0; n < 2; ++n) acc[a][b][m][n] = (f32x4){0.f, 0.f, 0.f, 0.f};
        cur = nxt; cA = nA; cB = nB; ++ui;
        if (wr == 1) PG8_BAR;
    }
    PG8_WAIT_V(0);
    PG8_BAR;
#undef PG8_SA
#undef PG8_SB
#undef PG8_STAGE
#undef PG8_LDA
#undef PG8_LDB
#undef PG8_MMA
#undef PG8_WAIT_V
#undef PG8_WAIT_L
#undef PG8_BAR
#undef PG8_SCHED
}
}
using pg8::Unit;
typedef f32x4 Acc[2][2][4][2];

struct SchedDense {
    int nM, nN, G, c; const char* A; const char* B; size_t astep, bstep; int reps, nt;
    __device__ __forceinline__ bool next(int i, Unit& u) const {
        long L = (long)i * G + c; if (L >= (long)reps * nM * nN) return false; L %= (long)nM * nN;
        int pm, pn; pg8::tile_order((int)L, nM, nN, pm, pn);
        u.A = A + (size_t)pm * astep; u.B = B + (size_t)pn * bstep; u.e0 = pm; u.e1 = pn; u.e2 = 0; u.nt = nt; u.sp = 0; return true;
    }
};
struct SchedSplit2 {
    int G, c; const char* A; const char* B; size_t astep, bstep; int nt, dense;
    __device__ __forceinline__ bool next(int i, Unit& u) const {
        int L = c, kpart = 0, sp = 0, n = nt; size_t koff = 0;
        if (G != 256 || dense) { L = i * G + c; if (L >= 384) return false; }
        else if (i > 1) return false;
        else if (i == 1) { const int x = c & 7, t = c >> 3, j = t >> 1; kpart = t & 1; L = 256 + 8 * j + x; sp = 1 + 2 * (8 * j + x) + kpart; n = nt / 2; koff = (size_t)kpart * n * 128; }
        int pm, pn; pg8::tile_order(L, 48, 8, pm, pn);
        u.A = A + (size_t)pm * astep + koff; u.B = B + (size_t)pn * bstep + koff; u.e0 = pm; u.e1 = pn; u.e2 = 0; u.nt = n; u.sp = sp; return true;
    }
};
struct SchedHalfM {
    int G, c; const char* A; const char* B; size_t astep, bstep; int nt;
    __device__ __forceinline__ bool next(int i, Unit& u) const {
        int L = c, hm = 0; size_t roff = 0;
        if (G != 256) { L = i * G + c; if (L >= 384) return false; }
        else if (i > 1) return false;
        else if (i == 1) { const int x = c & 7, t = c >> 3; L = 256 + 8 * (t >> 1) + x; hm = 1 + (t & 1); roff = (size_t)(t & 1) * (astep / 2); }
        int pm, pn; pg8::tile_order(L, 48, 8, pm, pn);
        u.A = A + (size_t)pm * astep + roff; u.B = B + (size_t)pn * bstep; u.e0 = pm; u.e1 = pn; u.e2 = hm; u.nt = nt; u.sp = 0; return true;
    }
};
struct SchedConvTail {
    int G, c; const char* A; const char* B; size_t astep, bstep; int nt;
    __device__ __forceinline__ bool next(int i, Unit& u) const {
        int L = i * G + c, kpart = 0, sp = 0, n = nt; size_t koff = 0;
        if (G != 256) { if (L >= 2112) return false; }
        else if (i > 8) return false;
        else if (i == 8) { if (c >= 128) return false; const int x = c & 7, t = c >> 3, j = t >> 1; kpart = t & 1; L = 2048 + 8 * j + x; sp = 1 + 2 * (8 * j + x) + kpart; n = nt / 2; koff = (size_t)kpart * n * 128; }
        int pm, pn; pg8::tile_order(L, 48, DFF / 128, pm, pn);
        u.A = A + (size_t)pm * astep + koff; u.B = B + (size_t)pn * bstep + koff; u.e0 = pm; u.e1 = pn; u.e2 = 0; u.nt = n; u.sp = sp; return true;
    }
};
struct SchedF1 {
    int G, c; const char* A; const char* B; int nt;
    __device__ __forceinline__ bool next(int i, Unit& u) const {
        const long L = (long)i * G + c; if (L >= 512) return false;
        int g, pmd, pn;
        if (L < 256) { const int l = (int)L; pn = l & 15; pmd = (l >> 4) & 3; g = l >> 6; }
        else { const int l = (int)L - 256, t = l & 31; pn = 16 + t; pmd = ((t & 3) >> 1) * 2 + ((l >> 5) & 1); g = l >> 6; }
        u.A = A + (size_t)pmd * 256 * 512 * 2; u.B = B + ((size_t)pn * 256 * D + (size_t)g * 512) * 2; u.e0 = pmd; u.e1 = pn; u.e2 = g; u.nt = 8; u.sp = 0; return true;
    }
};
struct SchedF2 {
    int G, c, smp; const char* A; const char* B; int nt;
    __device__ __forceinline__ bool next(int i, Unit& u) const {
        const long L = (long)i * G + c;
        if (smp) { if (L >= 256) return false; const int l = (int)L, pn2 = l & 1, pm = (l >> 1) & 3, g = (l >> 3) & 3, s = l >> 5;
            u.A = A + (size_t)pm * 256 * PQSS * 2; u.B = B + (((size_t)(g * 512 + pn2 * 256)) * PQROW + PQS0 + PQSS * s) * 2;
            u.e0 = (TCTX + 1024 * s + 256 * pm) >> 8; u.e1 = g * 2 + pn2; u.e2 = 0; u.nt = PQSS / 64; u.sp = 0; return true; }
        if (L >= 128) return false; const int l = (int)L, pn2 = l & 1, g = (l >> 1) & 3, s = l >> 3;
        u.A = A; u.B = B + (((size_t)(g * 512 + pn2 * 256)) * PQROW + 512 * s) * 2;
        u.e0 = s; u.e1 = g * 2 + pn2; u.e2 = 0; u.nt = 8; u.sp = 0; return true;
    }
};

struct EpiInProj {
    bf16_t *Q, *V, *GA, *U, *VV; _Float16* LF; const float* lbraw;
    __device__ __forceinline__ void operator()(Acc& acc, const Unit& u, int wr, int wc, int fr, int fq) const {
        const int pm = u.e0, pn = u.e1, seg = pn >> 2;
        const int row0 = pm * 256 + wr * 64 + fr, cs0 = (pn & 3) * 256 + wc * 32 + 8 * fq;
#pragma unroll
        for (int bj = 0; bj < 2; ++bj) {
            const int col = cs0 + bj * 128;
            if (seg == 1 || seg == 2) {
                const float* l0 = lbraw + (seg - 1) * 2048 + col;
                float lb[8];
#pragma unroll
                for (int j = 0; j < 8; ++j) lb[j] = fast_sigmoid(l0[j] - l0[1024 + j]);
#pragma unroll
                for (int ai = 0; ai < 2; ++ai)
#pragma unroll
                    for (int m = 0; m < 4; ++m) {
                        const int row = row0 + ai * 128 + m * 16;
                        f32x4 o0, o1;
#pragma unroll
                        for (int e = 0; e < 4; ++e) { o0[e] = __logf(lb[e] + (1.f - lb[e]) * fast_sigmoid(acc[ai][bj][m][0][e])); o1[e] = __logf(lb[4 + e] + (1.f - lb[4 + e]) * fast_sigmoid(acc[ai][bj][m][1][e])); }
                        u32x4 w; w.x = pkh2(o0[0], o0[1]); w.y = pkh2(o0[2], o0[3]); w.z = pkh2(o1[0], o1[1]); w.w = pkh2(o1[2], o1[3]);
                        *(u32x4*)(LF + (size_t)row * 2048 + (seg - 1) * 1024 + col) = w;
                    }
            } else {
                bf16_t* base = seg == 0 ? Q : seg == 3 ? V : seg == 4 ? GA : seg == 5 ? U : VV;
#pragma unroll
                for (int ai = 0; ai < 2; ++ai)
#pragma unroll
                    for (int m = 0; m < 4; ++m) {
                        const int row = row0 + ai * 128 + m * 16;
                        f32x4 v0 = acc[ai][bj][m][0], v1 = acc[ai][bj][m][1];
                        if (seg == 0) {
#pragma unroll
                            for (int e = 0; e < 4; ++e) { v0[e] = silu_f(v0[e]) * 0.08838834764831845f; v1[e] = silu_f(v1[e]) * 0.08838834764831845f; }
                        } else if (seg == 4) {
#pragma unroll
                            for (int e = 0; e < 4; ++e) { v0[e] = silu_f(v0[e]); v1[e] = silu_f(v1[e]); }
                        } else if (seg >= 5) {
#pragma unroll
                            for (int e = 0; e < 4; ++e) { v0[e] = gelu_tanh_f(v0[e]); v1[e] = gelu_tanh_f(v1[e]); }
                        }
                        u32x4 w; w.x = pk2(v0[0], v0[1]); w.y = pk2(v0[2], v0[3]); w.z = pk2(v1[0], v1[1]); w.w = pk2(v1[2], v1[3]);
                        *(u32x4*)(base + (size_t)row * 1024 + col) = w;
                    }
            }
        }
    }
};
template <bool XF32, bool HM = false> struct EpiResidT {
    const float* xin0; const float* xin1; const bf16_t* xb; bf16_t* xout; const float* gate;
    __device__ __forceinline__ void operator()(Acc& acc, const Unit& u, int wr, int wc, int fr, int fq) const {
        const int pm = u.e0, pn = u.e1; const int nai = (HM && u.e2) ? 1 : 2;
        const int row0 = pm * 256 + ((HM && u.e2 == 2) ? 128 : 0) + wr * 64 + fr, col0 = pn * 256 + wc * 32 + 8 * fq;
        const float* g = gate + (size_t)row_bi(pm) * 12288 + col0;
        f32x4 gv[2][2];
#pragma unroll
        for (int bj = 0; bj < 2; ++bj) { gv[bj][0] = *(const f32x4*)(g + bj * 128); gv[bj][1] = *(const f32x4*)(g + bj * 128 + 4); }
        if constexpr (XF32) {
            const float* xin = pm < 16 ? xin0 : xin1 - (size_t)TCTX * D;
#pragma unroll
            for (int ai = 0; ai < 2; ++ai) {
                if (ai < nai) {
                f32x4 xv[4][2][2];
#pragma unroll
                for (int m = 0; m < 4; ++m)
#pragma unroll
                    for (int bj = 0; bj < 2; ++bj) { const float* p = xin + (size_t)(row0 + ai * 128 + m * 16) * D + col0 + bj * 128; xv[m][bj][0] = *(const f32x4*)p; xv[m][bj][1] = *(const f32x4*)(p + 4); }
                asm volatile("" ::: "memory");
#pragma unroll
                for (int m = 0; m < 4; ++m)
#pragma unroll
                    for (int bj = 0; bj < 2; ++bj) { bf16_t* p = xout + (size_t)(row0 + ai * 128 + m * 16) * D + col0 + bj * 128;
                        const f32x4 o0 = xv[m][bj][0] + gv[bj][0] * acc[ai][bj][m][0], o1 = xv[m][bj][1] + gv[bj][1] * acc[ai][bj][m][1];
                        u32x4 w; w.x = pk2(o0[0], o0[1]); w.y = pk2(o0[2], o0[3]); w.z = pk2(o1[0], o1[1]); w.w = pk2(o1[2], o1[3]);
                        *(u32x4*)p = w; }
                asm volatile("" ::: "memory");
                }
            }
        } else {
            u32x4 xw[2][4][2];
#pragma unroll
            for (int ai = 0; ai < 2; ++ai) { if (ai < nai)
#pragma unroll
                for (int m = 0; m < 4; ++m)
#pragma unroll
                    for (int bj = 0; bj < 2; ++bj) xw[ai][m][bj] = *(const u32x4*)(xb + (size_t)(row0 + ai * 128 + m * 16) * D + col0 + bj * 128); }
            asm volatile("" ::: "memory");
#pragma unroll
            for (int ai = 0; ai < 2; ++ai) { if (ai < nai)
#pragma unroll
                for (int m = 0; m < 4; ++m)
#pragma unroll
                    for (int bj = 0; bj < 2; ++bj) { bf16_t* p = xout + (size_t)(row0 + ai * 128 + m * 16) * D + col0 + bj * 128;
                        const u32x4 x = xw[ai][m][bj]; const f32x4 a0 = acc[ai][bj][m][0], a1 = acc[ai][bj][m][1];
                        u32x4 w;
                        w.x = pk2(bflo(x.x) + gv[bj][0][0] * a0[0], bfhi(x.x) + gv[bj][0][1] * a0[1]); w.y = pk2(bflo(x.y) + gv[bj][0][2] * a0[2], bfhi(x.y) + gv[bj][0][3] * a0[3]);
                        w.z = pk2(bflo(x.z) + gv[bj][1][0] * a1[0], bfhi(x.z) + gv[bj][1][1] * a1[1]); w.w = pk2(bflo(x.w) + gv[bj][1][2] * a1[2], bfhi(x.w) + gv[bj][1][3] * a1[3]);
                        *(u32x4*)p = w; } }
            asm volatile("" ::: "memory");
        }
    }
};
__device__ __forceinline__ float dpp_shr1(float src, float old) { return __builtin_bit_cast(float, __builtin_amdgcn_update_dpp(__builtin_bit_cast(int, old), __builtin_bit_cast(int, src), 0x111, 0xf, 0xf, false)); }
__device__ __forceinline__ float dpp_shl1(float src, float old) { return __builtin_bit_cast(float, __builtin_amdgcn_update_dpp(__builtin_bit_cast(int, old), __builtin_bit_cast(int, src), 0x101, 0xf, 0xf, false)); }
struct EpiConv {
    bf16_t* ACT; const float* cw; const float* cb; LAS float* xch;
    __device__ __forceinline__ void operator()(Acc& acc, const Unit& u, int wr, int wc, int fr, int fq) const {
        const int pm = u.e0, pn = u.e1; const bool ctx = pm < 16;
        LAS float* mine = xch + (wr * 4 + wc) * 128; const LAS float* other = xch + ((wr ^ 1) * 4 + wc) * 128 + (wr == 0 ? 64 : 0);
        if (fr == 15) {
#pragma unroll
            for (int bj = 0; bj < 2; ++bj)
#pragma unroll
                for (int n = 0; n < 2; ++n) *(LAS f32x4*)(mine + ((bj * 2 + n) * 4 + fq) * 4) = acc[1][bj][3][n]; }
        if (fr == 0) {
#pragma unroll
            for (int bj = 0; bj < 2; ++bj)
#pragma unroll
                for (int n = 0; n < 2; ++n) *(LAS f32x4*)(mine + 64 + ((bj * 2 + n) * 4 + fq) * 4) = acc[0][bj][0][n]; }
        LDS_WAIT(); __builtin_amdgcn_s_barrier(); asm volatile("" ::: "memory");
        const bool zl = !ctx && fr == 8, zr = !ctx && fr == 7;
        const int wcol0 = 128 * pn + 32 * wc + 8 * fq;
#pragma unroll
        for (int bj = 0; bj < 2; ++bj)
#pragma unroll
            for (int n = 0; n < 2; ++n) {
                const float* wp = cw + bj * DFF + wcol0 + 4 * n; const float* bp = cb + bj * DFF + wcol0 + 4 * n;
                f32x4 hv = *(const LAS f32x4*)(other + ((bj * 2 + n) * 4 + fq) * 4); if (!ctx) hv = (f32x4){0.f, 0.f, 0.f, 0.f};
#pragma unroll
                for (int e = 0; e < 4; ++e) {
                    const float w0 = wp[e], w1 = wp[DFF2 + e], w2 = wp[2 * DFF2 + e], bb = bp[e];
                    float x[8];
#pragma unroll
                    for (int j = 0; j < 8; ++j) x[j] = acc[j >> 2][bj][j & 3][n][e];
                    float left = dpp_shr1(x[7], wr == 1 ? hv[e] : 0.f);
                    float right = dpp_shl1(x[0], wr == 0 ? hv[e] : 0.f);
                    if (zl) left = 0.f; if (zr) right = 0.f;
#pragma unroll
                    for (int j = 0; j < 8; ++j) {
                        const float xm = j == 0 ? left : x[j - 1], xp = j == 7 ? right : x[j + 1];
                        acc[j >> 2][bj][j & 3][n][e] = w0 * xm + w1 * x[j] + w2 * xp + bb;
                    }
                }
                asm volatile("" ::: "memory");
            }
#pragma unroll
        for (int ai = 0; ai < 2; ++ai)
#pragma unroll
            for (int m = 0; m < 4; ++m) {
                const int tok = pm * 256 + 8 * (16 * wr + fr) + 4 * ai + m;
                f32x4 o0, o1;
#pragma unroll
                for (int e = 0; e < 4; ++e) { o0[e] = silu_f(acc[ai][0][m][0][e]) * acc[ai][1][m][0][e]; o1[e] = silu_f(acc[ai][0][m][1][e]) * acc[ai][1][m][1][e]; }
                u32x4 w; w.x = pk2(o0[0], o0[1]); w.y = pk2(o0[2], o0[3]); w.z = pk2(o1[0], o1[1]); w.w = pk2(o1[2], o1[3]);
                *(u32x4*)(ACT + (size_t)tok * DFF + wcol0) = w;
                asm volatile("" ::: "memory");
            }
    }
};
struct EpiF1 {
    bf16_t* PQT;
    __device__ __forceinline__ void operator()(Acc& acc, const Unit& u, int wr, int wc, int fr, int fq) const {
        const int pmd = u.e0, pn = u.e1, g = u.e2, which = pmd >> 1;
        int slot0;
        if (pn < 16) slot0 = 512 * pn + which * 256;
        else slot0 = PQS0 + PQSS * ((pn - 16) >> 2) + 256 * ((pn - 16) & 3);
        const int c0 = g * 512 + (pmd & 1) * 256 + wr * 64 + fr;
        bf16_t* base = PQT + (size_t)slot0 + wc * 32 + 8 * fq;
        const bool nyq = pn >= 16 && ((pn - 16) & 3) == 2 && wc == 0 && fq == 0;
#pragma unroll
        for (int ai = 0; ai < 2; ++ai)
#pragma unroll
            for (int m = 0; m < 4; ++m) {
                bf16_t* rowp = base + (size_t)(c0 + ai * 128 + m * 16) * PQROW;
#pragma unroll
                for (int bj = 0; bj < 2; ++bj) { const f32x4 v0 = acc[ai][bj][m][0], v1 = acc[ai][bj][m][1];
                    u32x4 w; w.x = pk2(v0[0], v0[1]); w.y = pk2(v0[2], v0[3]); w.z = pk2(v1[0], v1[1]); w.w = pk2(v1[2], v1[3]);
                    if (bj == 0 && nyq) { bf16_t* q = rowp; q[1] = (bf16_t)(w.x >> 16); *(unsigned*)(q + 2) = w.y; *(u32x2*)(q + 4) = (u32x2){w.z, w.w}; }
                    else *(u32x4*)(rowp + bj * 128) = w; }
            }
    }
};
struct EpiBf16 {
    bf16_t* O; int ldo;
    __device__ __forceinline__ void operator()(Acc& acc, const Unit& u, int wr, int wc, int fr, int fq) const {
        const int row0 = u.e0 * 256 + wr * 64 + fr, col0 = u.e1 * 256 + wc * 32 + 8 * fq;
#pragma unroll
        for (int ai = 0; ai < 2; ++ai)
#pragma unroll
            for (int m = 0; m < 4; ++m) {
                bf16_t* rowp = O + (size_t)(row0 + ai * 128 + m * 16) * ldo + col0;
#pragma unroll
                for (int bj = 0; bj < 2; ++bj) { const f32x4 v0 = acc[ai][bj][m][0], v1 = acc[ai][bj][m][1];
                    u32x4 w; w.x = pk2(v0[0], v0[1]); w.y = pk2(v0[2], v0[3]); w.z = pk2(v1[0], v1[1]); w.w = pk2(v1[2], v1[3]);
                    *(u32x4*)(rowp + bj * 128) = w; }
            }
    }
};

struct Args { const float* in[30]; float* out; unsigned char* ws; int ph_lo, ph_hi; };
typedef const __attribute__((address_space(4))) Args* KA;
__device__ __forceinline__ KA kargs() { auto kp = __builtin_amdgcn_kernarg_segment_ptr(); asm volatile("" : "+s"(kp)); return (KA)kp; }

#ifdef PROBE_T
#define PSTAMPB(a, i, blk) do { if (blockIdx.x == (blk) && threadIdx.x == 0) ((unsigned long long*)((a)->ws + WS_CTL + 32768))[i] = __builtin_amdgcn_s_memrealtime(); } while (0)
#else
#define PSTAMPB(a, i, blk) do {} while (0)
#endif
struct CvtSrc { const float* W; bf16_t* WT; int K, N, up, item; };
__device__ __forceinline__ void cvt_load(const CvtSrc& c, int lane, f32x4 (&r)[16]) {
    const int nblk = c.N / 64, kb = c.item / nblk, nb = c.item % nblk, k0 = 64 * kb, n0 = 64 * nb;
    const int cc = lane & 15, q = lane >> 4;
#pragma unroll
    for (int i = 0; i < 16; ++i) { const int kk = 8 * (i >> 1) + 2 * q + (i & 1); r[i] = __builtin_nontemporal_load((const f32x4*)(c.W + (size_t)(k0 + kk) * c.N + n0 + 4 * cc)); }
}
__device__ __forceinline__ void cvt_store(const CvtSrc& c, int lane, const f32x4 (&r)[16], LAS unsigned* scr) {
    const int nblk = c.N / 64, kb = c.item / nblk, nb = c.item % nblk, k0 = 64 * kb, n0 = 64 * nb;
    const int cc = lane & 15, q = lane >> 4;
#pragma unroll
    for (int ip = 0; ip < 8; ++ip)
#pragma unroll
        for (int e = 0; e < 4; ++e) scr[(4 * cc + e) * 33 + 4 * ip + q] = pk2(r[2 * ip][e], r[2 * ip + 1][e]);
    LDS_WAIT(); asm volatile("" ::: "memory");
    const int c8 = lane & 7;
#pragma unroll
    for (int j = 0; j < 8; ++j) { const int n = (lane >> 3) + 8 * j; const LAS unsigned* sp = scr + n * 33 + 4 * c8;
        u32x4 o; o.x = sp[0]; o.y = sp[1]; o.z = sp[2]; o.w = sp[3];
        int nn = n0 + n;
        if (c.up) { const int bjj = nn >= DFF ? 1 : 0, cgc = nn - bjj * DFF; nn = (cgc >> 7) * 256 + bjj * 128 + (cgc & 127); }
        *(u32x4*)(c.WT + (size_t)nn * c.K + k0 + 8 * c8) = o; }
    LDS_WAIT(); asm volatile("" ::: "memory");
}
__device__ __forceinline__ bool cvt_pick(KA a, int set, int it, CvtSrc& c) {
    unsigned char* ws = a->ws;
    constexpr int I_IN = 32 * (INW / 64), I_O = 32 * (D / 64), I_UP = 32 * (DFF2 / 64), I_DN = (DFF / 64) * (D / 64);
    if (set == 0) { if (it >= I_IN) return false; c.W = a->in[8]; c.WT = (bf16_t*)(ws + WS_WIN); c.K = D; c.N = INW; c.up = 0; c.item = it; return true; }
    if (it >= I_O + I_UP + I_DN) return false;
    int r = it;
    if (r < I_O) { c.W = a->in[set == 1 ? 14 : 23]; c.WT = (bf16_t*)(ws + (set == 1 ? WS_WOUT0 : WS_WOUT1)); c.K = D; c.N = D; c.up = 0; c.item = r; return true; } r -= I_O;
    if (r < I_UP) { c.W = a->in[set == 1 ? 16 : 25]; c.WT = (bf16_t*)(ws + (set == 1 ? WS_WUP0 : WS_WUP1)); c.K = D; c.N = DFF2; c.up = 1; c.item = r; return true; } r -= I_UP;
    c.W = a->in[set == 1 ? 19 : 28]; c.WT = (bf16_t*)(ws + (set == 1 ? WS_WDN0 : WS_WDN1)); c.K = DFF; c.N = D; c.up = 0; c.item = r; return true;
}
__device__ __forceinline__ void convert_set(KA a, LAS unsigned char* lds, int set, int gw, int NGW, int i0 = 0, int i1 = 1 << 30) {
    const int lane = threadIdx.x & 63, wave = __builtin_amdgcn_readfirstlane(threadIdx.x >> 6);
    LAS unsigned* scr = (LAS unsigned*)(lds + wave * 8448);
    CvtSrc cur, nxt; f32x4 r0[16], r1[16];
    int it = i0 + gw;
    if (it >= i1 || !cvt_pick(a, set, it, cur)) return;
    cvt_load(cur, lane, r0);
    for (;;) {
        it += NGW; const bool h1 = it < i1 && cvt_pick(a, set, it, nxt);
        if (h1) cvt_load(nxt, lane, r1);
        cvt_store(cur, lane, r0, scr);
        if (!h1) break;
        it += NGW; const bool h2 = it < i1 && cvt_pick(a, set, it, cur);
        if (h2) cvt_load(cur, lane, r0);
        cvt_store(nxt, lane, r1, scr);
        if (!h2) break;
    }
}
__device__ __forceinline__ void dft_tables(unsigned char* ws, int gt, int GT) {
    bf16_t* DC = (bf16_t*)(ws + WS_DFTC); bf16_t* D256 = (bf16_t*)(ws + WS_DFT256); bf16_t* D1024 = (bf16_t*)(ws + WS_DFT1024);
    for (int i = gt; i < 1024 * 512; i += GT) { const int r = i >> 9, k = i & 511, c = r & 511; const float ang = 2.0f * (float)((c * k) & 511) * (1.0f / 512.0f);
        const float v = (r < 512 ? cospif(ang) : sinpif(ang)) * 0.04419417382415922f; DC[i] = (bf16_t)f2bf(v); }
    for (int i = gt; i < 256 * 512; i += GT) { const int p = i >> 9, k = i & 511, n = k & 255; const float ang = 2.0f * (float)((p * n) & 255) * (1.0f / 256.0f);
        const float v = (k < 256 ? cospif(ang) : -sinpif(ang)) * 0.0625f; D256[i] = (bf16_t)f2bf(v); }
    for (int i = gt; i < 1024 * PQSS; i += GT) { const int p = i / PQSS, k = i % PQSS; float v = 0.f;
        if (k < 512) v = cospif(2.0f * (float)((p * k) & 1023) * (1.0f / 1024.0f));
        else if (k > 512) v = -sinpif(2.0f * (float)((p * (1024 - k)) & 1023) * (1.0f / 1024.0f));
        else v = (p & 1) ? -1.0f : 1.0f;
        D1024[i] = (bf16_t)f2bf(v * 0.03125f); }
}
template <int NC> __device__ __forceinline__ void mod_gemv(KA a, LAS unsigned char* lds, int l, int cb) {
    constexpr int L4 = NC / 4, NRG = NT / L4, NIT = 2048 / NRG;
    int tid = threadIdx.x; asm volatile("" : "+v"(tid));
    const int n0 = cb * NC;
    const float* Wm = a->in[l ? 20 : 5]; const float* bm = a->in[l ? 21 : 6];
    LAS float* S = (LAS float*)lds;
    __syncthreads();
    {
        const float* cc = a->in[4]; const float* cs = a->in[3];
        float cv[4][9];
#pragma unroll
        for (int j = 0; j < 4; ++j) { const int k = tid + NT * j; cv[j][0] = cc[k];
#pragma unroll
            for (int bi = 1; bi < 9; ++bi) cv[j][bi] = cs[(bi - 1) * 2048 + k]; }
#pragma unroll
        for (int j = 0; j < 4; ++j) { const int k = tid + NT * j;
#pragma unroll
            for (int bi = 0; bi < 9; ++bi) S[k * 12 + bi] = silu_f(cv[j][bi]); }
    }
    __syncthreads();
    const int l4 = tid % L4, rg = tid / L4;
    f32x4 accm[9];
#pragma unroll
    for (int bi = 0; bi < 9; ++bi) accm[bi] = (f32x4){0.f, 0.f, 0.f, 0.f};
#pragma unroll 8
    for (int kk = 0; kk < NIT; ++kk) {
        const int k = rg + NRG * kk;
        const f32x4 w = __builtin_nontemporal_load((const f32x4*)(Wm + (size_t)k * 12288 + n0 + 4 * l4));
        const f32x4 s0 = *(const LAS f32x4*)(S + k * 12), s1 = *(const LAS f32x4*)(S + k * 12 + 4); const float s8 = S[k * 12 + 8];
        accm[0] += s0[0] * w; accm[1] += s0[1] * w; accm[2] += s0[2] * w; accm[3] += s0[3] * w;
        accm[4] += s1[0] * w; accm[5] += s1[1] * w; accm[6] += s1[2] * w; accm[7] += s1[3] * w; accm[8] += s8 * w;
    }
    __syncthreads();
    LAS float* red = (LAS float*)lds;
#pragma unroll
    for (int bi = 0; bi < 9; ++bi) *(LAS f32x4*)(red + (rg * 9 + bi) * NC + 4 * l4) = accm[bi];
    __syncthreads();
    float* MOD = (float*)(a->ws + WS_MOD) + (size_t)l * 9 * 12288;
    for (int o = tid; o < 9 * NC; o += NT) { const int bi = o / NC, n = o % NC; float s = bm[n0 + n];
        for (int r = 0; r < NRG; ++r) s += red[(r * 9 + bi) * NC + n];
        MOD[(size_t)bi * 12288 + n0 + n] = s; }
    __syncthreads();
}
__device__ __forceinline__ void phase_prologue(KA a, LAS unsigned char* lds, int vcu, int G) {
    const int tid = threadIdx.x, wave = __builtin_amdgcn_readfirstlane(tid >> 6);
    unsigned char* ws = a->ws;
    if (G == 256) {
        if (vcu < 192) { mod_gemv<64>(a, lds, 0, vcu); convert_set(a, lds, 0, vcu * 8 + wave, 192 * 8, 2560); }
        else convert_set(a, lds, 0, (vcu - 192) * 8 + wave, 64 * 8, 0, 2560);
    } else {
        for (int cb = vcu; cb < 192; cb += G) mod_gemv<128>(a, lds, cb / 96, cb % 96);
        __syncthreads();
        convert_set(a, lds, 0, vcu * 8 + wave, G * 8); convert_set(a, lds, 1, vcu * 8 + wave, G * 8); convert_set(a, lds, 2, vcu * 8 + wave, G * 8); dft_tables(ws, vcu * NT + tid, G * NT);
    }
}

__device__ __forceinline__ void phase_norm_mod(const float* x0, const float* x1, const float* nw, const float* sh, const float* sc, bf16_t* H, int vcu, int G, int rend = T) {
    const int lane = threadIdx.x & 63, wave = __builtin_amdgcn_readfirstlane(threadIdx.x >> 6);
    const int gw = vcu * 8 + wave, NGW = G * 8;
    const int chunk = (rend + NGW - 1) / NGW, r0 = gw * chunk, r1 = (r0 + chunk < rend) ? r0 + chunk : rend;
    if (r0 >= r1) return;
    f32x4 wv[8], av[8], vn[8]; int bi_cur = -1;
#define NRM_LOAD(r) do { const int r_ = (r); const float* xr = r_ < TCTX ? x0 + (size_t)r_ * D : x1 + (size_t)(r_ - TCTX) * D; \
        _Pragma("unroll") for (int j = 0; j < 8; ++j) vn[j] = __builtin_nontemporal_load((const f32x4*)(xr + 4 * lane + 256 * j)); } while (0)
    NRM_LOAD(r0);
    for (int row = r0; row < r1; ++row) {
        f32x4 v[8];
#pragma unroll
        for (int j = 0; j < 8; ++j) v[j] = vn[j];
        NRM_LOAD(row + 1 < r1 ? row + 1 : row);
        const int bi = row < TCTX ? 0 : 1 + ((row - TCTX) >> 10);
        if (bi != bi_cur) { bi_cur = bi; const float* shp = sh + (size_t)bi * 12288; const float* scp = sc + (size_t)bi * 12288;
#pragma unroll
            for (int j = 0; j < 8; ++j) { const int c = 4 * lane + 256 * j; wv[j] = *(const f32x4*)(nw + c) * (*(const f32x4*)(scp + c) + 1.0f); av[j] = *(const f32x4*)(shp + c); } }
        float s = 0.f;
#pragma unroll
        for (int j = 0; j < 8; ++j) s += (v[j][0] * v[j][0] + v[j][1] * v[j][1]) + (v[j][2] * v[j][2] + v[j][3] * v[j][3]);
        const float rstd = rsqrtf(wave_sum(s) * (1.0f / D) + 1e-6f);
#pragma unroll
        for (int j = 0; j < 8; ++j) { const int c = 4 * lane + 256 * j;
            const f32x4 o = v[j] * rstd * wv[j] + av[j];
            u32x2 p; p.x = pk2(o[0], o[1]); p.y = pk2(o[2], o[3]);
            *(u32x2*)(H + (size_t)row * D + c) = p; }
    }
#undef NRM_LOAD
}
__device__ __forceinline__ void f1_fixup(KA a, int gw, int NGW) {
    const int lane = threadIdx.x & 63;
    const bf16_t* DC = (const bf16_t*)(a->ws + WS_DFTC); const bf16_t* H = (const bf16_t*)(a->ws + WS_H); bf16_t* PQ = (bf16_t*)(a->ws + WS_PQT);
    for (int j0 = gw; j0 < 8 * 4 * 512; j0 += 4 * NGW) {
        u32x4 hv[4], tv[4];
#pragma unroll
        for (int u = 0; u < 4; ++u) { const int j = j0 + u * NGW; if (j < 8 * 4 * 512) { const int sq = j >> 11, g = (j >> 9) & 3, c = j & 511;
            hv[u] = *(const u32x4*)(H + (size_t)(TCTX + 1024 * sq + 512) * D + 512 * g + 8 * lane); tv[u] = *(const u32x4*)(DC + (size_t)c * 512 + 8 * lane); } }
#pragma unroll
        for (int u = 0; u < 4; ++u) { const int j = j0 + u * NGW; if (j < 8 * 4 * 512) { const int sq = j >> 11, g = (j >> 9) & 3, c = j & 511;
            float d = 0.f;
#pragma unroll
            for (int e = 0; e < 4; ++e) d += bflo(hv[u][e]) * bflo(tv[u][e]) + bfhi(hv[u][e]) * bfhi(tv[u][e]);
            d = wave_sum(d);
            if (lane == 0) PQ[(size_t)(g * 512 + c) * PQROW + PQS0 + PQSS * sq + 512] = (bf16_t)f2bf(d); } }
    }
}
#define XB_UNPACK(v, r) do { _Pragma("unroll") for (int j = 0; j < 4; ++j) { \
        v[2 * j][0] = bflo(r[j].x); v[2 * j][1] = bfhi(r[j].x); v[2 * j][2] = bflo(r[j].y); v[2 * j][3] = bfhi(r[j].y); \
        v[2 * j + 1][0] = bflo(r[j].z); v[2 * j + 1][1] = bfhi(r[j].z); v[2 * j + 1][2] = bflo(r[j].w); v[2 * j + 1][3] = bfhi(r[j].w); } } while (0)
#define XB_MODLOAD(bi_) do { const float* shp = sh + (size_t)(bi_) * 12288; const float* scp = sc + (size_t)(bi_) * 12288; \
        _Pragma("unroll") for (int j = 0; j < 8; ++j) { const int c = 8 * lane + 512 * (j >> 1) + 4 * (j & 1); wv[j] = *(const f32x4*)(nw + c) * (*(const f32x4*)(scp + c) + 1.0f); av[j] = *(const f32x4*)(shp + c); } } while (0)
__device__ __forceinline__ void phase_norm_mod_b(const bf16_t* X, const float* nw, const float* sh, const float* sc, bf16_t* H, int vcu, int G, int rend = T, int wlo = 0, int wn = 0) {
    const int lane = threadIdx.x & 63, wave = __builtin_amdgcn_readfirstlane(threadIdx.x >> 6);
    int gw = vcu * 8 + wave, NGW = G * 8, r0, r1;
    if (wn > 0) { gw -= wlo; NGW = wn; if (gw < 0 || gw >= NGW) return; r0 = (int)((long)gw * rend / NGW); r1 = (int)((long)(gw + 1) * rend / NGW); }
    else { const int chunk = (rend + NGW - 1) / NGW; r0 = gw * chunk; r1 = (r0 + chunk < rend) ? r0 + chunk : rend; }
    if (r0 >= r1) return;
    f32x4 wv[8], av[8]; u32x4 vn[4]; int bi_cur = -1;
#define NRM_LOAD(r) do { const bf16_t* xr = X + (size_t)(r) * D; _Pragma("unroll") for (int j = 0; j < 4; ++j) vn[j] = *(const u32x4*)(xr + 8 * lane + 512 * j); } while (0)
    NRM_LOAD(r0);
    for (int row = r0; row < r1; ++row) {
        f32x4 v[8];
        XB_UNPACK(v, vn);
        NRM_LOAD(row + 1 < r1 ? row + 1 : row);
        const int bi = row < TCTX ? 0 : 1 + ((row - TCTX) >> 10);
        if (bi != bi_cur) { bi_cur = bi; XB_MODLOAD(bi); }
        float s = 0.f;
#pragma unroll
        for (int j = 0; j < 8; ++j) s += (v[j][0] * v[j][0] + v[j][1] * v[j][1]) + (v[j][2] * v[j][2] + v[j][3] * v[j][3]);
        const float rstd = rsqrtf(wave_sum(s) * (1.0f / D) + 1e-6f);
#pragma unroll
        for (int j = 0; j < 4; ++j) {
            const f32x4 o0 = v[2 * j] * rstd * wv[2 * j] + av[2 * j], o1 = v[2 * j + 1] * rstd * wv[2 * j + 1] + av[2 * j + 1];
            u32x4 p; p.x = pk2(o0[0], o0[1]); p.y = pk2(o0[2], o0[3]); p.z = pk2(o1[0], o1[1]); p.w = pk2(o1[2], o1[3]);
            *(u32x4*)(H + (size_t)row * D + 8 * lane + 512 * j) = p; }
    }
#undef NRM_LOAD
}
__device__ __forceinline__ void phase_norm_fold_b(const bf16_t* X, const float* nw, const float* sh, const float* sc, bf16_t* H, int vcu, int G, int wlo = 0, int wn = 0) {
    const int lane = threadIdx.x & 63, wave = __builtin_amdgcn_readfirstlane(threadIdx.x >> 6);
    int gw = vcu * 8 + wave, NGW = G * 8, q0, q1;
    if (wn > 0) { gw -= wlo; NGW = wn; if (gw < 0 || gw >= NGW) return; q0 = (int)((long)gw * (8 * 512) / NGW); q1 = (int)((long)(gw + 1) * (8 * 512) / NGW); }
    else { const int chunk = (8 * 512 + NGW - 1) / NGW; q0 = gw * chunk; q1 = (q0 + chunk < 8 * 512) ? q0 + chunk : 8 * 512; }
    if (q0 >= q1) return;
    f32x4 wv[8], av[8]; u32x4 na[4], nb[4]; int s_cur = -1;
#define FOLD_ROWS(q, rA, rB) const int sq_ = (q) >> 9, n_ = (q) & 511, base_ = TCTX + 1024 * sq_; const int rA = base_ + n_, rB = n_ ? base_ + 1024 - n_ : base_ + 512
#define FOLD_LOAD(q) do { FOLD_ROWS(q, ra_, rb_); const bf16_t* xa = X + (size_t)ra_ * D; const bf16_t* xb_ = X + (size_t)rb_ * D; \
        _Pragma("unroll") for (int j = 0; j < 4; ++j) { na[j] = *(const u32x4*)(xa + 8 * lane + 512 * j); nb[j] = *(const u32x4*)(xb_ + 8 * lane + 512 * j); } } while (0)
    FOLD_LOAD(q0);
    for (int q = q0; q < q1; ++q) {
        FOLD_ROWS(q, rA, rB);
        f32x4 va[8], vb[8];
        XB_UNPACK(va, na); XB_UNPACK(vb, nb);
        FOLD_LOAD(q + 1 < q1 ? q + 1 : q);
        if (sq_ != s_cur) { s_cur = sq_; XB_MODLOAD(1 + sq_); }
        float sa = 0.f, sb = 0.f;
#pragma unroll
        for (int j = 0; j < 8; ++j) { sa += (va[j][0] * va[j][0] + va[j][1] * va[j][1]) + (va[j][2] * va[j][2] + va[j][3] * va[j][3]); sb += (vb[j][0] * vb[j][0] + vb[j][1] * vb[j][1]) + (vb[j][2] * vb[j][2] + vb[j][3] * vb[j][3]); }
        const float ra = rsqrtf(wave_sum(sa) * (1.0f / D) + 1e-6f), rb = rsqrtf(wave_sum(sb) * (1.0f / D) + 1e-6f);
#pragma unroll
        for (int j = 0; j < 4; ++j) {
            u32x4 pa, pb;
#pragma unroll
            for (int hh = 0; hh < 2; ++hh) {
                const f32x4 ha = va[2 * j + hh] * ra * wv[2 * j + hh] + av[2 * j + hh], hb = vb[2 * j + hh] * rb * wv[2 * j + hh] + av[2 * j + hh];
                const f32x4 oa = n_ ? ha + hb : ha, ob = n_ ? ha - hb : hb;
                pa[2 * hh] = pk2(oa[0], oa[1]); pa[2 * hh + 1] = pk2(oa[2], oa[3]); pb[2 * hh] = pk2(ob[0], ob[1]); pb[2 * hh + 1] = pk2(ob[2], ob[3]);
            }
            *(u32x4*)(H + (size_t)rA * D + 8 * lane + 512 * j) = pa; *(u32x4*)(H + (size_t)rB * D + 8 * lane + 512 * j) = pb; }
    }
#undef FOLD_ROWS
#undef FOLD_LOAD
}
__device__ __forceinline__ void phase_final_norm(const bf16_t* X, float* Y, const float* nw, int vcu, int G) {
    const int lane = threadIdx.x & 63, wave = __builtin_amdgcn_readfirstlane(threadIdx.x >> 6);
    const int gw = vcu * 8 + wave, NGW = G * 8;
    const int chunk = (T + NGW - 1) / NGW, r0 = gw * chunk, r1 = (r0 + chunk < T) ? r0 + chunk : T;
    if (r0 >= r1) return;
    f32x4 wv[8]; u32x4 vn[4];
#pragma unroll
    for (int j = 0; j < 8; ++j) wv[j] = *(const f32x4*)(nw + 8 * lane + 512 * (j >> 1) + 4 * (j & 1));
#define NRM_LOAD(r) do { const bf16_t* xr = X + (size_t)(r) * D; _Pragma("unroll") for (int j = 0; j < 4; ++j) vn[j] = *(const u32x4*)(xr + 8 * lane + 512 * j); } while (0)
    NRM_LOAD(r0);
    for (int row = r0; row < r1; ++row) {
        f32x4 v[8];
        XB_UNPACK(v, vn);
        NRM_LOAD(row + 1 < r1 ? row + 1 : row);
        float s = 0.f;
#pragma unroll
        for (int j = 0; j < 8; ++j) s += (v[j][0] * v[j][0] + v[j][1] * v[j][1]) + (v[j][2] * v[j][2] + v[j][3] * v[j][3]);
        const float rstd = rsqrtf(wave_sum(s) * (1.0f / D) + 1e-6f);
        float* yr = Y + (size_t)row * D;
#pragma unroll
        for (int j = 0; j < 8; ++j) *(f32x4*)(yr + 8 * lane + 512 * (j >> 1) + 4 * (j & 1)) = v[j] * rstd * wv[j];
    }
#undef NRM_LOAD
}

constexpr int P128 = 136, P64 = 72;
constexpr int SC_QS = 0, SC_KS = SC_QS + 64 * P128 * 2, SC_QI = SC_KS + 64 * P128 * 2, SC_KO = SC_QI + 64 * P128 * 2, SC_VT = SC_KO + 128 * P64 * 2,
              SC_SC = SC_VT + 128 * P64 * 2, SC_ST = SC_SC + 64 * P64 * 2, SC_TOT = SC_ST + 128 * P128 * 2, SC_DEC = SC_TOT + 4 * 128 * 4, SC_END = SC_DEC + 128 * 4;
static_assert(SC_END <= LDS_BYTES, "scan LDS");
__device__ __forceinline__ void scan_item(KA a, LAS unsigned char* lds, int seqbase, int N, int b_state, int h, int dir, bool ctx, int b_out) {
    int tid = threadIdx.x; asm volatile("" : "+v"(tid));
    const int lane = tid & 63, w = __builtin_amdgcn_readfirstlane(tid >> 6), fr = lane & 15, fq = lane >> 4;
    unsigned char* ws = a->ws;
    const bf16_t* Qg = (const bf16_t*)(ws + WS_Q) + h * 128; const bf16_t* Vg = (const bf16_t*)(ws + WS_V) + h * 128;
    const _Float16* LFg = (const _Float16*)(ws + WS_LF) + dir * 1024 + h * 128;
    bf16_t* Og = (bf16_t*)(ws + (dir ? WS_OB : WS_OF)) + h * 128;
    LAS bf16_t* QS = (LAS bf16_t*)(lds + SC_QS); LAS bf16_t* KS = (LAS bf16_t*)(lds + SC_KS); LAS bf16_t* QI = (LAS bf16_t*)(lds + SC_QI);
    LAS bf16_t* KO = (LAS bf16_t*)(lds + SC_KO); LAS bf16_t* VT = (LAS bf16_t*)(lds + SC_VT); LAS bf16_t* SCm = (LAS bf16_t*)(lds + SC_SC);
    LAS bf16_t* ST = (LAS bf16_t*)(lds + SC_ST); LAS float* TOT = (LAS float*)(lds + SC_TOT); LAS float* DEC = (LAS float*)(lds + SC_DEC);
    const int cp = tid & 63, seg = tid >> 6;
    f32x4 accS[8];
    if (ctx) {
#pragma unroll
        for (int kt = 0; kt < 8; ++kt) accS[kt] = (f32x4){0.f, 0.f, 0.f, 0.f};
    } else {
        const float* s0 = a->in[2] + ((size_t)(b_state * 2 + dir) * 8 + h) * 16384;
#pragma unroll
        for (int kt = 0; kt < 8; ++kt)
#pragma unroll
            for (int e = 0; e < 4; ++e) accS[kt][e] = s0[(16 * kt + 4 * fq + e) * 128 + 16 * w + fr];
    }
    __syncthreads();
#pragma unroll
    for (int kt = 0; kt < 8; ++kt) { u32x2 p; p.x = pk2(accS[kt][0], accS[kt][1]); p.y = pk2(accS[kt][2], accS[kt][3]); *(LAS u32x2*)(ST + (16 * w + fr) * P128 + 16 * kt + 4 * fq) = p; }
    const int nc = N >> 6;
    f32x2 lfN[8]; unsigned qN[8], vN[8];
#define SCAN_LOAD(cc) do { _Pragma("unroll") for (int ii = 0; ii < 8; ++ii) { \
            const int i = 64 * (cc) + 8 * seg + ii; const int tok = seqbase + (dir ? N - 1 - i : i); \
            { const f16x2 l2 = *(const f16x2*)(LFg + ((unsigned)tok * 2048u + 2u * (unsigned)cp)); lfN[ii] = (f32x2){(float)l2[0], (float)l2[1]}; } qN[ii] = *(const unsigned*)(Qg + ((unsigned)tok * 1024u + 2u * (unsigned)cp)); vN[ii] = *(const unsigned*)(Vg + ((unsigned)tok * 1024u + 2u * (unsigned)cp)); } } while (0)
    SCAN_LOAD(0);
    for (int c = 0; c < nc; ++c) {
        f32x2 lf[8]; unsigned qq[8], vq[8];
#pragma unroll
        for (int ii = 0; ii < 8; ++ii) { lf[ii] = lfN[ii]; qq[ii] = qN[ii]; vq[ii] = vN[ii]; }
        { const int cn = c + 1 < nc ? c + 1 : c; SCAN_LOAD(cn); }
        f32x2 run = (f32x2){0.f, 0.f};
#pragma unroll
        for (int ii = 0; ii < 8; ++ii) run += lf[ii];
        *(LAS f32x2*)(TOT + seg * 128 + 2 * cp) = run;
        __syncthreads();
        f32x2 offs = (f32x2){0.f, 0.f}, ref = (f32x2){0.f, 0.f}, blast = (f32x2){0.f, 0.f};
#pragma unroll
        for (int sg = 0; sg < 8; ++sg) { const f32x2 t = *(const LAS f32x2*)(TOT + sg * 128 + 2 * cp); if (sg < seg) offs += t; if (sg < 4) ref += t; blast += t; }
        if (seg == 0) *(LAS f32x2*)(DEC + 2 * cp) = (f32x2){__expf(blast[0]), __expf(blast[1])};
        const f32x2 eref = (f32x2){__expf(ref[0]), __expf(ref[1])}, ebr = (f32x2){__expf(blast[0] - ref[0]), __expf(blast[1] - ref[1])};
        f32x2 brun = offs;
        unsigned kow[2][4], vtw[2][4];
#pragma unroll
        for (int ii = 0; ii < 8; ii += 2) {
            float ko2[2][2];
#pragma unroll
            for (int d = 0; d < 2; ++d) {
                const int i2 = ii + d, i = 8 * seg + i2; brun += lf[i2];
                float qs[2], ks[2];
#pragma unroll
                for (int x = 0; x < 2; ++x) {
                    const float kf = 1.0f - __expf(lf[i2][x]);
                    const float e1 = __expf(brun[x] - ref[x]), e2 = __builtin_amdgcn_rcpf(e1);
                    qs[x] = (x ? bfhi(qq[i2]) : bflo(qq[i2])) * e1; ks[x] = kf * e2; ko2[x][d] = ks[x] * ebr[x];
                }
                *(LAS unsigned*)(QS + i * P128 + 2 * cp) = pk2(qs[0], qs[1]);
                *(LAS unsigned*)(KS + i * P128 + 2 * cp) = pk2(ks[0], ks[1]);
                *(LAS unsigned*)(QI + i * P128 + 2 * cp) = pk2(qs[0] * eref[0], qs[1] * eref[1]);
            }
            kow[0][ii >> 1] = pk2(ko2[0][0], ko2[0][1]); kow[1][ii >> 1] = pk2(ko2[1][0], ko2[1][1]);
            vtw[0][ii >> 1] = (vq[ii] & 0xffffu) | (vq[ii + 1] << 16); vtw[1][ii >> 1] = (vq[ii] >> 16) | (vq[ii + 1] & 0xffff0000u);
        }
#pragma unroll
        for (int x = 0; x < 2; ++x) {
            *(LAS u32x4*)(KO + (2 * cp + x) * P64 + 8 * seg) = (u32x4){kow[x][0], kow[x][1], kow[x][2], kow[x][3]};
            *(LAS u32x4*)(VT + (2 * cp + x) * P64 + 8 * seg) = (u32x4){vtw[x][0], vtw[x][1], vtw[x][2], vtw[x][3]};
        }
        __syncthreads();
        {
            const int it = w >> 1;
#pragma unroll
            for (int jj = 0; jj < 2; ++jj) {
                const int jt = 2 * (w & 1) + jj;
                f32x4 d = (f32x4){0.f, 0.f, 0.f, 0.f};
                if (jt <= it) {
#pragma unroll
                    for (int ks = 0; ks < 4; ++ks) {
                        const bf16x8 af = *(const LAS bf16x8*)(KS + (16 * jt + fr) * P128 + 32 * ks + 8 * fq);
                        const bf16x8 bf = *(const LAS bf16x8*)(QS + (16 * it + fr) * P128 + 32 * ks + 8 * fq);
                        d = __builtin_amdgcn_mfma_f32_16x16x32_bf16(af, bf, d, 0, 0, 0);
                    }
                }
                const int i = 16 * it + fr, j0 = 16 * jt + 4 * fq;
#pragma unroll
                for (int e = 0; e < 4; ++e) if (j0 + e > i) d[e] = 0.f;
                u32x2 p; p.x = pk2(d[0], d[1]); p.y = pk2(d[2], d[3]);
                *(LAS u32x2*)(SCm + i * P64 + j0) = p;
            }
        }
        __syncthreads();
        f32x4 oacc[4];
#pragma unroll
        for (int it = 0; it < 4; ++it) oacc[it] = (f32x4){0.f, 0.f, 0.f, 0.f};
        {
            bf16x8 stf[4], vtf[2];
#pragma unroll
            for (int ks = 0; ks < 4; ++ks) stf[ks] = *(const LAS bf16x8*)(ST + (16 * w + fr) * P128 + 32 * ks + 8 * fq);
#pragma unroll
            for (int ks = 0; ks < 2; ++ks) vtf[ks] = *(const LAS bf16x8*)(VT + (16 * w + fr) * P64 + 32 * ks + 8 * fq);
#pragma unroll
            for (int it = 0; it < 4; ++it) {
#pragma unroll
                for (int ks = 0; ks < 4; ++ks) { const bf16x8 qf = *(const LAS bf16x8*)(QI + (16 * it + fr) * P128 + 32 * ks + 8 * fq); oacc[it] = __builtin_amdgcn_mfma_f32_16x16x32_bf16(stf[ks], qf, oacc[it], 0, 0, 0); }
#pragma unroll
                for (int ks = 0; ks < 2; ++ks) { const bf16x8 sf = *(const LAS bf16x8*)(SCm + (16 * it + fr) * P64 + 32 * ks + 8 * fq); oacc[it] = __builtin_amdgcn_mfma_f32_16x16x32_bf16(vtf[ks], sf, oacc[it], 0, 0, 0); }
            }
#pragma unroll
            for (int kt = 0; kt < 8; ++kt) {
                const f32x4 dc = *(const LAS f32x4*)(DEC + 16 * kt + 4 * fq);
                accS[kt] = accS[kt] * dc;
#pragma unroll
                for (int ks = 0; ks < 2; ++ks) { const bf16x8 kf = *(const LAS bf16x8*)(KO + (16 * kt + fr) * P64 + 32 * ks + 8 * fq); accS[kt] = __builtin_amdgcn_mfma_f32_16x16x32_bf16(kf, vtf[ks], accS[kt], 0, 0, 0); }
            }
        }
#pragma unroll
        for (int it = 0; it < 4; ++it) { const int i = 64 * c + 16 * it + fr; const int tok = seqbase + (dir ? N - 1 - i : i); u32x2 p; p.x = pk2(oacc[it][0], oacc[it][1]); p.y = pk2(oacc[it][2], oacc[it][3]); *(u32x2*)(Og + (size_t)tok * 1024 + 16 * w + 4 * fq) = p; }
#pragma unroll
        for (int kt = 0; kt < 8; ++kt) { u32x2 p; p.x = pk2(accS[kt][0], accS[kt][1]); p.y = pk2(accS[kt][2], accS[kt][3]); *(LAS u32x2*)(ST + (16 * w + fr) * P128 + 16 * kt + 4 * fq) = p; }
    }
    if (ctx) {
        float* so = a->out + (size_t)T * D + ((size_t)(b_out * 2 + dir) * 8 + h) * 16384;
#pragma unroll
        for (int kt = 0; kt < 8; ++kt)
#pragma unroll
            for (int e = 0; e < 4; ++e) so[(16 * kt + 4 * fq + e) * 128 + 16 * w + fr] = accS[kt][e];
    }
}

constexpr int MB_WS = 0, MB_BV = 128 * P128 * 2, MB_END = MB_BV + 256 * P128 * 2;
static_assert(MB_END <= LDS_BYTES, "mixer-B LDS");
__device__ __forceinline__ void mixb_item(KA a, LAS unsigned char* lds, int cbk, int g, bool load_ws) {
    int tid = threadIdx.x; asm volatile("" : "+v"(tid));
    const int lane = tid & 63, w = __builtin_amdgcn_readfirstlane(tid >> 6), fr = lane & 15, fq = lane >> 4;
    unsigned char* ws = a->ws;
    LAS bf16_t* WSl = (LAS bf16_t*)(lds + MB_WS); LAS bf16_t* BV = (LAS bf16_t*)(lds + MB_BV);
    const bf16_t* VVg = (const bf16_t*)(ws + WS_VV) + (size_t)cbk * 128 * 1024 + g * 256;
    const bf16_t* Ug = (const bf16_t*)(ws + WS_U) + (size_t)cbk * 128 * 1024 + g * 256;
    bf16_t* CAT = (bf16_t*)(ws + WS_CAT) + (size_t)cbk * 128 * D + 1024 + g * 256;
    const float* wsg = a->in[12] + (size_t)g * 16384; const float* vn = a->in[11] + g * 256; const float* bsg = a->in[13] + g * 128;
    const int q = tid >> 2, qt = tid & 3;
    u32x4 raw[8];
#pragma unroll
    for (int j = 0; j < 8; ++j) raw[j] = *(const u32x4*)(VVg + (size_t)q * 1024 + qt * 64 + 8 * j);
    __syncthreads();
    if (load_ws) {
#pragma unroll
        for (int j = 0; j < 8; ++j) { const int idx = (tid + j * NT) * 4, p = idx >> 7, qq = idx & 127; const f32x4 v = *(const f32x4*)(wsg + idx);
            u32x2 o; o.x = pk2(v[0], v[1]); o.y = pk2(v[2], v[3]); *(LAS u32x2*)(WSl + p * P128 + qq) = o; }
    }
    {
        float ss = 0.f;
#pragma unroll
        for (int j = 0; j < 8; ++j)
#pragma unroll
            for (int e = 0; e < 4; ++e) { const float lo = bflo(raw[j][e]), hi = bfhi(raw[j][e]); ss += lo * lo + hi * hi; }
        ss += __shfl_xor(ss, 1); ss += __shfl_xor(ss, 2);
        const float rstd = rsqrtf(ss * (1.0f / 256.0f) + 1e-6f);
        const int qs = q ^ (16 * qt);
#pragma unroll
        for (int j = 0; j < 8; ++j)
#pragma unroll
            for (int e = 0; e < 4; ++e) { const int c = qt * 64 + 8 * j + 2 * e; const float lo = bflo(raw[j][e]) * rstd, hi = bfhi(raw[j][e]) * rstd;
                BV[c * P128 + qs] = (bf16_t)pk2(lo, lo); BV[(c + 1) * P128 + qs] = (bf16_t)pk2(hi, hi); }
    }
    const int wr2 = w >> 2, wc2 = w & 3;
    u32x2 uu[4][4];
#pragma unroll
    for (int mt = 0; mt < 4; ++mt)
#pragma unroll
        for (int nt = 0; nt < 4; ++nt) uu[mt][nt] = *(const u32x2*)(Ug + (size_t)(64 * wr2 + 16 * mt + fr) * 1024 + 64 * wc2 + 16 * nt + 4 * fq);
    __syncthreads();
    f32x4 acc[4][4];
#pragma unroll
    for (int mt = 0; mt < 4; ++mt)
#pragma unroll
        for (int nt = 0; nt < 4; ++nt) acc[mt][nt] = (f32x4){0.f, 0.f, 0.f, 0.f};
#pragma unroll
    for (int ks = 0; ks < 4; ++ks) {
        bf16x8 wf[4], vf[4];
#pragma unroll
        for (int mt = 0; mt < 4; ++mt) wf[mt] = *(const LAS bf16x8*)(WSl + (64 * wr2 + 16 * mt + fr) * P128 + 32 * ks + 8 * fq);
#pragma unroll
        for (int nt = 0; nt < 4; ++nt) vf[nt] = *(const LAS bf16x8*)(BV + (64 * wc2 + 16 * nt + fr) * P128 + ((32 * ks + 8 * fq) ^ (16 * wc2)));
#pragma unroll
        for (int mt = 0; mt < 4; ++mt)
#pragma unroll
            for (int nt = 0; nt < 4; ++nt) acc[mt][nt] = __builtin_amdgcn_mfma_f32_16x16x32_bf16(vf[nt], wf[mt], acc[mt][nt], 0, 0, 0);
    }
#pragma unroll
    for (int nt = 0; nt < 4; ++nt) {
        const int c = 64 * wc2 + 16 * nt + 4 * fq; const f32x4 vnv = *(const f32x4*)(vn + c);
#pragma unroll
        for (int mt = 0; mt < 4; ++mt) { const int p = 64 * wr2 + 16 * mt + fr; const float bsv = bsg[p];
            u32x2 o; o.x = pk2(bflo(uu[mt][nt].x) * (acc[mt][nt][0] * vnv[0] + bsv), bfhi(uu[mt][nt].x) * (acc[mt][nt][1] * vnv[1] + bsv));
            o.y = pk2(bflo(uu[mt][nt].y) * (acc[mt][nt][2] * vnv[2] + bsv), bfhi(uu[mt][nt].y) * (acc[mt][nt][3] * vnv[3] + bsv));
            *(u32x2*)(CAT + (size_t)p * D + c) = o; }
    }
}
__device__ __forceinline__ void mixer_work(KA a, LAS unsigned char* lds, int it, bool mixb_reload = true) {
    if (it < 128) { const int s = it >> 4, h = (it >> 1) & 7, dir = it & 1; scan_item(a, lds, TCTX + 1024 * s, 1024, s, h, dir, false, 0); }
    else if (it < 384) { const int j = it - 128, s = j >> 4, h = (j >> 1) & 7, dir = j & 1; scan_item(a, lds, 256 * s, 256, 0, h, dir, true, s); }
    else { const int j = it - 384, blk = j / 3, q = j % 3; mixb_item(a, lds, 3 * (blk & 31) + q, blk >> 5, mixb_reload || q == 0); }
}
__device__ __forceinline__ void phase_mixers(KA a, LAS unsigned char* lds, int vcu, int G) {
    PSTAMPB(a, 30, 0); PSTAMPB(a, 32, 4);
    if (G == 256) {
        const int j = vcu - 128, n = vcu < 128 ? 1 : 5;
        for (int q = 0; q < n; ++q) { const int it = vcu < 128 ? vcu : (q < 2 ? 128 + 2 * j + q : 384 + 3 * j + (q - 2)); mixer_work(a, lds, it, false); if (q == 1) PSTAMPB(a, 33, 4); }
    } else { for (int it = vcu; it < 768; it += G) mixer_work(a, lds, it); }
    __syncthreads();
    PSTAMPB(a, 31, 0); PSTAMPB(a, 34, 4);
}
__device__ __forceinline__ void phase_finalize_a(KA a, int vcu, int G) {
    const int lane = threadIdx.x & 63, wave = __builtin_amdgcn_readfirstlane(threadIdx.x >> 6);
    const int gw = vcu * 8 + wave, NGW = G * 8;
    const int chunk = (T + NGW - 1) / NGW, r0 = gw * chunk, r1 = (r0 + chunk < T) ? r0 + chunk : T;
    if (r0 >= r1) return;
    unsigned char* ws = a->ws;
    const bf16_t* OF = (const bf16_t*)(ws + WS_OF); const bf16_t* OB = (const bf16_t*)(ws + WS_OB); const bf16_t* GA = (const bf16_t*)(ws + WS_GA); bf16_t* CAT = (bf16_t*)(ws + WS_CAT);
    const int col = (lane >> 3) * 128 + (lane & 7) * 16, vc = (lane & 7) * 16;
    f32x4 gn[4];
#pragma unroll
    for (int j = 0; j < 4; ++j) gn[j] = *(const f32x4*)(a->in[10] + vc + 4 * j);
    u32x4 fn[2], bn[2]; u32x4 g0n, g1n;
#define FIN_LOAD(r) do { const size_t o_ = (size_t)(r) * 1024 + col; _Pragma("unroll") for (int j = 0; j < 2; ++j) { fn[j] = *(const u32x4*)(OF + o_ + 8 * j); bn[j] = *(const u32x4*)(OB + o_ + 8 * j); } \
        g0n = *(const u32x4*)(GA + o_); g1n = *(const u32x4*)(GA + o_ + 8); } while (0)
    FIN_LOAD(r0);
    for (int row = r0; row < r1; ++row) {
        f32x4 v[4]; const u32x4 g0 = g0n, g1 = g1n; float ss = 0.f;
#pragma unroll
        for (int j = 0; j < 4; ++j) {
#pragma unroll
            for (int k = 0; k < 4; k += 2) { const unsigned fw = fn[j >> 1][(j & 1) * 2 + (k >> 1)], bw = bn[j >> 1][(j & 1) * 2 + (k >> 1)]; v[j][k] = bflo(fw) + bflo(bw); v[j][k + 1] = bfhi(fw) + bfhi(bw); }
            ss += (v[j][0] * v[j][0] + v[j][1] * v[j][1]) + (v[j][2] * v[j][2] + v[j][3] * v[j][3]);
        }
        FIN_LOAD(row + 1 < r1 ? row + 1 : row);
        ss += __shfl_xor(ss, 1); ss += __shfl_xor(ss, 2); ss += __shfl_xor(ss, 4);
        const float rstd = rsqrtf(ss * (1.0f / 128.0f) + 1e-6f);
        u32x4 o0, o1;
#pragma unroll
        for (int e = 0; e < 4; ++e) {
            const int j = e >> 1, k = (e & 1) * 2;
            o0[e] = pk2(v[j][k] * rstd * gn[j][k] * bflo(g0[e]), v[j][k + 1] * rstd * gn[j][k + 1] * bfhi(g0[e]));
            o1[e] = pk2(v[2 + j][k] * rstd * gn[2 + j][k] * bflo(g1[e]), v[2 + j][k + 1] * rstd * gn[2 + j][k + 1] * bfhi(g1[e]));
        }
        *(u32x4*)(CAT + (size_t)row * D + col) = o0; *(u32x4*)(CAT + (size_t)row * D + col + 8) = o1;
    }
#undef FIN_LOAD
}

#define XB_TMO      128
#define XB_XCNT(j)  (256  + 64 * (j))
#define XB_XSUB(j)  (1280 + 64 * (j))
#define XB_XGEN(j)  (2304 + 64 * (j))
#define XB_TOP      3328
#define XB_TOPGEN   3392
#define XCD_BAR_WORDS 3456
#define XB_SPIN_CAP (1u << 18)
__device__ __forceinline__ unsigned xb_ld(unsigned* p)              { return __hip_atomic_load(p, __ATOMIC_RELAXED, __HIP_MEMORY_SCOPE_AGENT); }
__device__ __forceinline__ unsigned xb_add(unsigned* p, unsigned v) { return __hip_atomic_fetch_add(p, v, __ATOMIC_RELAXED, __HIP_MEMORY_SCOPE_AGENT); }
__device__ __forceinline__ unsigned xb_xcc_id() { return (unsigned)__builtin_amdgcn_s_getreg((3 << 11) | 20) & 0xFu; }
#define XB_SPIN(cond, bar) do { unsigned _sp = 0; while (cond) { __builtin_amdgcn_s_sleep(1); \
    if ((++_sp & 255u) == 0u) { if (xb_ld(&(bar)[XB_TMO])) break; if (_sp > XB_SPIN_CAP) { atomicAdd(&(bar)[XB_TMO], 1u); break; } } } } while (0)
struct XcdBarrier { unsigned* bar; unsigned x; volatile LAS unsigned* st; };
__device__ __forceinline__ XcdBarrier xcd_barrier_post(unsigned* bar, volatile LAS unsigned* st) {
    XcdBarrier b; b.bar = bar; b.x = xb_xcc_id(); b.st = st;
    if (threadIdx.x == 0) (void)xb_add(&bar[XB_XCNT(b.x)], 1u);
    return b;
}
__device__ __forceinline__ void xcd_barrier_complete(unsigned* bar, unsigned x, unsigned& nloc, unsigned& nx) {
    const unsigned G = gridDim.x * gridDim.y * gridDim.z;
    unsigned sum, cnt, mine, sp = 0u;
    for (;;) {
        sum = 0u; cnt = 0u; mine = 0u;
#pragma unroll
        for (unsigned j = 0; j < 16; ++j) { const unsigned c = xb_ld(&bar[XB_XCNT(j)]); sum += c; cnt += (c > 0u) ? 1u : 0u; mine = (j == x) ? c : mine; }
        if (sum == G) break;
        __builtin_amdgcn_s_sleep(1);
        if ((++sp & 255u) == 0u) { if (xb_ld(&bar[XB_TMO])) break; if (sp > XB_SPIN_CAP) { atomicAdd(&bar[XB_TMO], 1u); break; } }
    }
    nloc = mine > 0u ? mine : 1u; nx = cnt > 0u ? cnt : 1u;
}
__device__ __forceinline__ void xcd_barrier(const XcdBarrier& b) {
    asm volatile("s_waitcnt vmcnt(0)" ::: "memory");
    __syncthreads();
    if (threadIdx.x == 0) {
        unsigned* bar = b.bar;
        __builtin_amdgcn_s_waitcnt(0);
        unsigned nloc = b.st[0], nx = b.st[1];
        if (nloc == 0u) { xcd_barrier_complete(bar, b.x, nloc, nx); b.st[0] = nloc; b.st[1] = nx; }
        const unsigned old = xb_add(&bar[XB_XSUB(b.x)], 1u);
        const unsigned gen = old / nloc;
        if (old + 1u == (gen + 1u) * nloc) {
            __builtin_amdgcn_fence(__ATOMIC_RELEASE, "agent");
            asm volatile("s_waitcnt vmcnt(0)" ::: "memory");
            const unsigned og = xb_add(&bar[XB_TOP], 1u);
            const unsigned tg = og / nx;
            if (og + 1u == (tg + 1u) * nx) xb_add(&bar[XB_TOPGEN], 1u);
            else XB_SPIN(xb_ld(&bar[XB_TOPGEN]) == tg, bar);
            __builtin_amdgcn_fence(__ATOMIC_ACQUIRE, "agent");
            asm volatile("s_waitcnt vmcnt(0)" ::: "memory");
        } else {
            XB_SPIN(xb_ld(&bar[XB_TOPGEN]) == gen, bar);
            __builtin_amdgcn_fence(__ATOMIC_ACQUIRE, "agent");
            asm volatile("s_waitcnt vmcnt(0)" ::: "memory");
        }
    }
    __syncthreads();
}

#ifndef DENSE_G2
#define DENSE_G2 1
#endif
#ifndef DENSE_G4
#define DENSE_G4 0
#endif
#ifndef PG8_SP2
#ifndef PG8_SP2
#define PG8_SP2 true
#endif
#endif
__global__ void __launch_bounds__(NT, 2) mk_fwd(Args a_) {
    KA a = kargs();
    extern __shared__ __attribute__((aligned(16))) unsigned char lds_raw[];
    LAS unsigned char* lds = (LAS unsigned char*)lds_raw;
    cg::grid_group grid = cg::this_grid();
    const int G = gridDim.x, bx = blockIdx.x;
    const int vcu = (G % 8 == 0) ? (bx % 8) * (G / 8) + bx / 8 : bx;
#define ws (a->ws)
    const int lo = a->ph_lo, hi = a->ph_hi;
#ifdef CODE_PAD
    asm volatile(".fill " CODE_PAD ", 4, 0xbf800000");
#endif
    if (threadIdx.x < 16) ((LAS unsigned*)(lds + LDS_MISC))[threadIdx.x] = 0u;
    __syncthreads();
    (void)xcd_barrier_post((unsigned*)(ws + WS_CTL), (volatile LAS unsigned*)(lds + LDS_MISC));
    if (lo == -12345) grid.sync();
#define X ((bf16_t*)(ws + WS_X))
#define MOD0 ((const float*)(ws + WS_MOD))
#define MOD1 (MOD0 + 9 * 12288)
#define Hb ((bf16_t*)(ws + WS_H))
#define CAT ((bf16_t*)(ws + WS_CAT))
#define ACT ((bf16_t*)(ws + WS_ACT))
#define PQT ((bf16_t*)(ws + WS_PQT))
#ifndef PHMASK
#define PHMASK 0x1FFFF
#endif
#define IN(k) (((PHMASK >> (k)) & 1) && lo <= (k) && (k) < hi)
#ifndef REPMASK
#define REPMASK 0
#endif
#ifndef REPN
#define REPN 2
#endif
#define REPS(k) for (int rep_ = 0; rep_ < (((REPMASK >> (k)) & 1) ? REPN : 1); ++rep_)
#ifdef PROBE_T
#define PROBE_STAMP(i) do { if (blockIdx.x == 0 && threadIdx.x == 0) ((unsigned long long*)(ws + WS_CTL + 32768))[i] = __builtin_amdgcn_s_memrealtime(); } while (0)
#else
#define PROBE_STAMP(i) do {} while (0)
#endif
#define SEAM(k) do { if (IN(k) && IN((k) + 1)) { XcdBarrier b_; b_.bar = (unsigned*)(ws + WS_CTL); b_.x = xb_xcc_id(); b_.st = (volatile LAS unsigned*)(lds + LDS_MISC); xcd_barrier(b_); PROBE_STAMP((k) + 1); } a = kargs(); } while (0)

    PROBE_STAMP(0);
    if (IN(0)) REPS(0) phase_prologue(a, lds, vcu, G);
    SEAM(0);
    if (IN(1)) REPS(1) phase_norm_mod(a->in[0], a->in[1], a->in[7], MOD0, MOD0 + D, Hb, vcu, G);
    SEAM(1);
    if (IN(2)) {
        const int GG = G == 256 ? 224 : G;
        if (bx < GG) {
            SchedDense S{48, INW / 256, GG, bx, (const char*)Hb, (const char*)(ws + WS_WIN), (size_t)256 * D * 2, (size_t)256 * D * 2, ((REPMASK >> 2) & 1) ? REPN : 1, D / 64};
            EpiInProj E{(bf16_t*)(ws + WS_Q), (bf16_t*)(ws + WS_V), (bf16_t*)(ws + WS_GA), (bf16_t*)(ws + WS_U), (bf16_t*)(ws + WS_VV), (_Float16*)(ws + WS_LF), a->in[9]};
            pg8::gemm_phase<EpiInProj, SchedDense, PG8_SP2, 0>(lds, D, D, (size_t)128 * D * 2, (size_t)128 * D * 2, S, E);
        } else {
            const int hw = (bx - GG) * 8 + __builtin_amdgcn_readfirstlane(threadIdx.x >> 6);
            convert_set(a, lds, 1, hw, (G - GG) * 8);
            convert_set(a, lds, 2, hw, (G - GG) * 8, 0, 4096);
            dft_tables(ws, (bx - GG) * NT + threadIdx.x, (G - GG) * NT);
        }
    }
    SEAM(2);
    if (IN(3)) REPS(3) phase_mixers(a, lds, vcu, G);
    SEAM(3);
    if (IN(4)) REPS(4) phase_finalize_a(a, vcu, G);
    SEAM(4);
    if (IN(5)) {
        SchedHalfM S{G, bx, (const char*)CAT, (const char*)(ws + WS_WOUT0), (size_t)256 * D * 2, (size_t)256 * D * 2, D / 64};
        EpiResidT<true, true> E{a->in[0], a->in[1], nullptr, X, MOD0 + 2 * D};
        pg8::gemm_phase<EpiResidT<true, true>, SchedHalfM, PG8_SP2, 0, false, true>(lds, D, D, (size_t)128 * D * 2, (size_t)128 * D * 2, S, E);
    }
    SEAM(5);
    if (IN(6)) REPS(6) phase_norm_mod_b(X, a->in[15], MOD0 + 3 * D, MOD0 + 4 * D, Hb, vcu, G);
    SEAM(6);
    if (IN(7)) {
        const int GG = G == 256 ? 240 : G;
        if (bx < GG) {
            SchedDense S{48, DFF / 128, GG, bx, (const char*)Hb, (const char*)(ws + WS_WUP0), (size_t)256 * D * 2, (size_t)256 * D * 2, ((REPMASK >> 7) & 1) ? REPN : 1, D / 64};
            EpiConv E{ACT, a->in[17], a->in[18], (LAS float*)(lds + LDS_XCH)};
            pg8::gemm_phase<EpiConv, SchedDense, PG8_SP2, 1>(lds, D, D, (size_t)4 * D * 2, (size_t)128 * D * 2, S, E);
        } else { convert_set(a, lds, 2, (bx - GG) * 8 + __builtin_amdgcn_readfirstlane(threadIdx.x >> 6), (G - GG) * 8, 4096);
            for (int cb = bx - GG; cb < 96; cb += G - GG) mod_gemv<128>(a, lds, 1, cb); }
    }
    SEAM(7);
    if (IN(8)) {
        SchedSplit2 S{G, bx, (const char*)ACT, (const char*)(ws + WS_WDN0), (size_t)256 * DFF * 2, (size_t)256 * DFF * 2, DFF / 64, DENSE_G4};
        EpiResidT<false> E{nullptr, nullptr, X, X, MOD0 + 5 * D};
        pg8::gemm_phase<EpiResidT<false>, SchedSplit2, PG8_SP2, 0, true>(lds, DFF, DFF, (size_t)128 * DFF * 2, (size_t)128 * DFF * 2, S, E, (float*)(ws + WS_SLAB), (unsigned*)(ws + WS_CTL) + 4096 + 1 * 128);
    }
    SEAM(8);
    if (IN(9)) { const int nwv = G * 8, nctx = (nwv + 2) / 3;
        phase_norm_mod_b(X, a->in[22], MOD1, MOD1 + D, Hb, vcu, G, TCTX, 0, nctx);
        phase_norm_fold_b(X, a->in[22], MOD1, MOD1 + D, Hb, vcu, G, nctx, nwv - nctx); }
    SEAM(9);
    if (IN(10)) REPS(10) {
        SchedF1 S{G, bx, (const char*)(ws + WS_DFTC), (const char*)Hb, 8};
        EpiF1 E{PQT};
        pg8::gemm_phase<EpiF1, SchedF1, PG8_SP2, 0>(lds, 512, D, (size_t)128 * 512 * 2, (size_t)128 * D * 2, S, E);
        f1_fixup(a, bx * 8 + __builtin_amdgcn_readfirstlane(threadIdx.x >> 6), G * 8);
    }
    SEAM(10);
    if (IN(11)) REPS(11) {
        { SchedF2 S{G, bx, 1, (const char*)(ws + WS_DFT1024), (const char*)PQT, PQSS / 64}; EpiBf16 E{CAT, D};
          pg8::gemm_phase<EpiBf16, SchedF2, PG8_SP2, 0>(lds, PQSS, PQROW, (size_t)128 * PQSS * 2, (size_t)128 * PQROW * 2, S, E); }
        { SchedF2 S{G, bx, 0, (const char*)(ws + WS_DFT256), (const char*)PQT, 8}; EpiBf16 E{CAT, D};
          pg8::gemm_phase<EpiBf16, SchedF2, PG8_SP2, 0>(lds, 512, PQROW, (size_t)128 * 512 * 2, (size_t)128 * PQROW * 2, S, E); }
    }
    SEAM(11);
    if (IN(12)) {
        SchedHalfM S{G, bx, (const char*)CAT, (const char*)(ws + WS_WOUT1), (size_t)256 * D * 2, (size_t)256 * D * 2, D / 64};
        EpiResidT<false, true> E{nullptr, nullptr, X, X, MOD1 + 2 * D};
        pg8::gemm_phase<EpiResidT<false, true>, SchedHalfM, PG8_SP2, 0, false, true>(lds, D, D, (size_t)128 * D * 2, (size_t)128 * D * 2, S, E);
    }
    SEAM(12);
    if (IN(13)) REPS(13) phase_norm_mod_b(X, a->in[24], MOD1 + 3 * D, MOD1 + 4 * D, Hb, vcu, G);
    SEAM(13);
    if (IN(14)) {
        SchedConvTail S{G, bx, (const char*)Hb, (const char*)(ws + WS_WUP1), (size_t)256 * D * 2, (size_t)256 * D * 2, D / 64};
        EpiConv E{ACT, a->in[26], a->in[27], (LAS float*)(lds + LDS_XCH)};
        pg8::gemm_phase<EpiConv, SchedConvTail, PG8_SP2, 1, true>(lds, D, D, (size_t)4 * D * 2, (size_t)128 * D * 2, S, E, (float*)(ws + WS_SLAB), (unsigned*)(ws + WS_CTL) + 4096 + 1024);
    }
    SEAM(14);
    if (IN(15)) {
        SchedSplit2 S{G, bx, (const char*)ACT, (const char*)(ws + WS_WDN1), (size_t)256 * DFF * 2, (size_t)256 * DFF * 2, DFF / 64, DENSE_G4};
        EpiResidT<false> E{nullptr, nullptr, X, X, MOD1 + 5 * D};
        pg8::gemm_phase<EpiResidT<false>, SchedSplit2, PG8_SP2, 0, true>(lds, DFF, DFF, (size_t)128 * DFF * 2, (size_t)128 * DFF * 2, S, E, (float*)(ws + WS_SLAB), (unsigned*)(ws + WS_CTL) + 4096 + 3 * 128);
    }
    SEAM(15);
    if (IN(16)) REPS(16) phase_final_norm(X, a->out, a->in[29], vcu, G);
#ifdef PROBE_T
    if (bx == 0 && threadIdx.x == 0) { PROBE_STAMP(18);
      const unsigned long long* tsb = (const unsigned long long*)(ws + WS_CTL + 32768);
      const unsigned long long dt = tsb[PROBE_B] - tsb[PROBE_A]; const unsigned long long t0 = __builtin_amdgcn_s_memrealtime();
      while (__builtin_amdgcn_s_memrealtime() - t0 < 8ull * dt) __builtin_amdgcn_s_sleep(32); }
#endif
#undef IN
#undef SEAM
#undef ws
#undef X
#undef MOD0
#undef MOD1
#undef Hb
#undef CAT
#undef ACT
#undef PQT
}

extern "C" void kernel_launch(void* const* d_in, const int* in_sizes, int n_in, void* d_out, int out_size, void* d_ws, size_t ws_size, hipStream_t stream) {
    static int grid = 0;
    if (grid == 0) {
        if (n_in != 30 || ws_size < WS_END) { fprintf(stderr, "kernel_launch: need 30 inputs and %zu bytes of workspace (got %d, %zu)\n", (size_t)WS_END, n_in, ws_size); grid = -1; return; }
        int dev = 0, cus = 0, per_cu = 0;
        if (hipGetDevice(&dev) != hipSuccess || hipDeviceGetAttribute(&cus, hipDeviceAttributeMultiprocessorCount, dev) != hipSuccess) { grid = -1; return; }
        if (hipFuncSetAttribute((const void*)mk_fwd, hipFuncAttributeMaxDynamicSharedMemorySize, LDS_BYTES) != hipSuccess) { fprintf(stderr, "kernel_launch: hipFuncSetAttribute failed\n"); grid = -1; return; }
        if (hipOccupancyMaxActiveBlocksPerMultiprocessor(&per_cu, (const void*)mk_fwd, NT, LDS_BYTES) != hipSuccess || per_cu < 1) { fprintf(stderr, "kernel_launch: occupancy query says %d blocks per CU\n", per_cu); grid = -1; return; }
        grid = cus;
    }
    if (grid < 0) return;
    if (hipMemsetAsync((char*)d_ws + WS_CTL, 0, 65536, stream) != hipSuccess) { fprintf(stderr, "kernel_launch: hipMemsetAsync failed\n"); return; }
    Args a{};
    for (int i = 0; i < 30; ++i) a.in[i] = (const float*)d_in[i];
    a.out = (float*)d_out; a.ws = (unsigned char*)d_ws;
#if MK_FUSED
    a.ph_lo = 0; a.ph_hi = NPH;
    void* args[] = {&a};
    hipError_t e = hipLaunchCooperativeKernel((const void*)mk_fwd, dim3(grid), dim3(NT), args, LDS_BYTES, stream);
    if (e != hipSuccess) fprintf(stderr, "cooperative launch failed: %s (grid %d)\n", hipGetErrorString(e), grid);
#else
    for (int p = 0; p < NPH; ++p) {
        a.ph_lo = p; a.ph_hi = p + 1;
        void* args[] = {&a};
        hipError_t e = hipLaunchCooperativeKernel((const void*)mk_fwd, dim3(grid), dim3(NT), args, LDS_BYTES, stream);
        if (e != hipSuccess) { fprintf(stderr, "launch %d failed: %s (grid %d)\n", p, hipGetErrorString(e), grid); break; }
    }
#endif
}
```
